# Optimizing an MI355X kernel written in HIP

```python
import math
import jax, jax.numpy as jnp
from jax import lax
import numpy as np

D_MODEL = 1024
BATCH = 2
SEQ = 8192
DEPTH = 2

HY_WIDTH = 768
HY_EMB = 33
HY_FFN = 64
HY_FAST_DECAY_PCT = 0.3
HY_SLOW_DECAY_PCT = 1.5
HY_TARGET = 1e-2

HEAD_DIM = 64
ATT_GROUPS = ((128, 1), (512, 4), (2048, 16))
HEADS_PER_GROUP = 4
N_HEADS = HEADS_PER_GROUP * len(ATT_GROUPS)
ATT_WIDTH = N_HEADS * HEAD_DIM
ATT_OUT = HEADS_PER_GROUP * HEAD_DIM
ROPE_THETA = 10000.0

N_BRANCHES = 2
IN_SPLITS = (3 * HY_WIDTH, ATT_WIDTH, ATT_WIDTH, ATT_WIDTH, D_MODEL, D_MODEL)
IN_COLS = sum(IN_SPLITS)

N_EXPERTS = 16
N_GROUPS = 4
EXPERTS_PER_GROUP = N_EXPERTS // N_GROUPS
TOP_K = 2
D_EXPERT = 512

NORM_EPS = 1e-6
MASK_VALUE = -1e30

kernel_name = "hybrid_hyena_dilated_attn_grouped_moe_encoder"


def rms_norm(x, g):
    xf = x.astype(jnp.float32)
    y = xf * lax.rsqrt(jnp.mean(xf * xf, axis=-1, keepdims=True) + NORM_EPS)
    return (y * g.astype(jnp.float32)).astype(x.dtype)


def modulate(h, shift, scale):
    return h * (1 + scale[:, None, :]) + shift[:, None, :]


def short_conv(u, w, b):
    L = u.shape[1]
    up = jnp.pad(u, ((0, 0), (1, 1), (0, 0)))
    return up[:, :L] * w[0] + up[:, 1:L + 1] * w[1] + up[:, 2:] * w[2] + b


def hyena_filters(L, w1, b1, w2, b2, w3, b3, w4, freq):
    f32 = jnp.float32
    t = jnp.linspace(0.0, 1.0, L, dtype=f32)[:, None]
    bands = (HY_EMB - 1) // 2
    w = 2.0 * math.pi * jnp.arange(L, dtype=f32)[:, None] / L
    f = jnp.linspace(1e-4, bands - 1, bands, dtype=f32)[None, :]
    z = jnp.concatenate([t, jnp.cos(f * w), -jnp.sin(f * w)], axis=-1)
    fr = freq.astype(f32)
    h = jnp.sin(fr * (z @ w1.astype(f32) + b1.astype(f32)))
    h = jnp.sin(fr * (h @ w2.astype(f32) + b2.astype(f32)))
    h = jnp.sin(fr * (h @ w3.astype(f32) + b3.astype(f32)))
    k = (h @ w4.astype(f32)).reshape(L, 2, HY_WIDTH)
    max_decay = math.log(HY_TARGET) / HY_FAST_DECAY_PCT
    min_decay = math.log(HY_TARGET) / HY_SLOW_DECAY_PCT
    deltas = jnp.linspace(min_decay, max_decay, HY_WIDTH, dtype=f32)
    decay = jnp.exp(-t * jnp.abs(deltas)[None, :])
    k = k * decay[:, None, :]
    return k[:, 0], k[:, 1]


def bidir_long_conv(z, k_fwd, k_bwd):
    L, C = k_fwd.shape
    kern = jnp.concatenate([k_fwd, jnp.zeros((1, C), jnp.float32), k_bwd[:0:-1]], axis=0)
    kf = jnp.fft.rfft(kern, axis=0)
    zf = jnp.fft.rfft(z.astype(jnp.float32), n=2 * L, axis=1)
    y = jnp.fft.irfft(zf * kf[None], n=2 * L, axis=1)[:, :L]
    return y.astype(z.dtype)


def hyena_mixer(u, w_sc, b_sc, w1, b1, w2, b2, w3, b3, w4, freq, hy_bias):
    L = u.shape[1]
    u = short_conv(u, w_sc, b_sc)
    x0, x1, v = jnp.split(u, 3, axis=-1)
    zv = v * x1
    k_fwd, k_bwd = hyena_filters(L, w1, b1, w2, b2, w3, b3, w4, freq)
    y = bidir_long_conv(zv, k_fwd, k_bwd) + zv * hy_bias
    return y * x0


def rope(x, pos):
    half = HEAD_DIM // 2
    inv = ROPE_THETA ** (-jnp.arange(half, dtype=jnp.float32) / half)
    ang = pos.astype(jnp.float32)[:, None] * inv[None, :]
    cos = jnp.cos(ang)[None, :, None, :]
    sin = jnp.sin(ang)[None, :, None, :]
    xf = x.astype(jnp.float32)
    a, b = xf[..., :half], xf[..., half:]
    return jnp.concatenate([a * cos - b * sin, b * cos + a * sin], axis=-1).astype(x.dtype)


def dilated_band_attention(q, k, v, dil, radius):
    B, L, H, Dh = q.shape
    Ls = L // dil
    nb = -(-Ls // radius)
    Lp = nb * radius

    def strided(t):
        return t.reshape(B, Ls, dil, H, Dh).transpose(0, 2, 3, 1, 4)

    pad4 = ((0, 0), (0, 0), (0, 0))
    qs = jnp.pad(strided(q), pad4 + ((0, Lp - Ls), (0, 0))).reshape(B, dil, H, nb, radius, Dh)
    kp = jnp.pad(strided(k), pad4 + ((radius, Lp - Ls + radius), (0, 0))).reshape(B, dil, H, nb + 2, radius, Dh)
    vp = jnp.pad(strided(v), pad4 + ((radius, Lp - Ls + radius), (0, 0))).reshape(B, dil, H, nb + 2, radius, Dh)

    def band(t):
        return jnp.concatenate([t[:, :, :, 0:nb], t[:, :, :, 1:nb + 1], t[:, :, :, 2:nb + 2]], axis=4)

    kb, vb = band(kp), band(vp)
    s = jnp.einsum('bghnqd,bghnkd->bghnqk', qs, kb, preferred_element_type=jnp.float32) * (Dh ** -0.5)
    blk = jnp.arange(nb)[:, None] * radius
    qpos = blk + jnp.arange(radius)[None, :]
    kpos = blk - radius + jnp.arange(3 * radius)[None, :]
    mask = ((jnp.abs(qpos[:, :, None] - kpos[:, None, :]) <= radius)
            & (kpos[:, None, :] >= 0) & (kpos[:, None, :] < Ls))
    s = jnp.where(mask, s, MASK_VALUE)
    m = jnp.max(s, axis=-1, keepdims=True)
    p = jnp.where(mask, jnp.exp(s - m), 0.0)
    den = jnp.maximum(jnp.sum(p, axis=-1, keepdims=True), 1e-30)
    o = jnp.einsum('bghnqk,bghnkd->bghnqd', (p / den).astype(v.dtype), vb)
    lse = (m + jnp.log(den))[..., 0]
    o = o.reshape(B, dil, H, Lp, Dh)[:, :, :, :Ls].transpose(0, 3, 1, 2, 4).reshape(B, L, H, Dh)
    lse = lse.reshape(B, dil, H, Lp)[:, :, :, :Ls].transpose(0, 3, 1, 2).reshape(B, L, H)
    return o, lse


def dilated_attention_mixer(q, k, v):
    B, L = q.shape[:2]
    outs, lses = [], []
    for g, (win, dil) in enumerate(ATT_GROUPS):
        sl = slice(g * HEADS_PER_GROUP, (g + 1) * HEADS_PER_GROUP)
        o, l = dilated_band_attention(q[:, :, sl], k[:, :, sl], v[:, :, sl], dil, win // (2 * dil))
        outs.append(o)
        lses.append(l)
    alpha = jax.nn.softmax(jnp.stack(lses, axis=0), axis=0)
    o = jnp.sum(alpha[..., None].astype(q.dtype) * jnp.stack(outs, axis=0), axis=0)
    return o.reshape(B, L, ATT_OUT)


def grouped_moe(h, router_w, router_bias, w1, w3, w2):
    B, L, D = h.shape
    t = h.reshape(B * L, D)
    scores = jax.nn.sigmoid(jnp.matmul(t, router_w, preferred_element_type=jnp.float32))
    biased = scores + router_bias.astype(jnp.float32)
    grp = biased.reshape(-1, N_GROUPS, EXPERTS_PER_GROUP)
    grp_score = jnp.sum(lax.top_k(grp, TOP_K)[0], axis=-1)
    sel = jnp.argmax(grp_score, axis=-1)
    in_grp = jnp.arange(N_GROUPS)[None, :] == sel[:, None]
    masked = jnp.where(in_grp[:, :, None], grp, MASK_VALUE).reshape(-1, N_EXPERTS)
    _, idx = lax.top_k(masked, TOP_K)
    wts = jnp.take_along_axis(scores, idx, axis=-1)
    wts = wts / jnp.sum(wts, axis=-1, keepdims=True)
    gates = jnp.sum(jax.nn.one_hot(idx, N_EXPERTS, dtype=jnp.float32) * wts[..., None], axis=1)
    gates = gates.astype(t.dtype)
    y = jnp.zeros_like(t)
    for e in range(N_EXPERTS):
        a = jax.nn.silu(t @ w1[e]) * (t @ w3[e])
        y = y + gates[:, e:e + 1] * (a @ w2[e])
    return y.reshape(B, L, D)


def setup_inputs(seed: int = 0) -> dict:
    key = jax.random.key(seed)
    ks = iter(jax.random.split(key, 32))

    def nrm(shape, scale):
        return jax.random.normal(next(ks), shape, jnp.float32) * scale

    D, E, F = D_MODEL, N_EXPERTS, D_EXPERT
    C3 = 3 * HY_WIDTH
    return {
        "x": nrm((BATCH, SEQ, D), 1.0),
        "c": nrm((BATCH, D), 1.0),
        "norm1_g": 1.0 + nrm((DEPTH, D), 0.02),
        "norm2_g": 1.0 + nrm((DEPTH, D), 0.02),
        "w_ada": nrm((DEPTH, D, 6 * D), D ** -0.5),
        "b_ada": nrm((DEPTH, 6 * D), 0.02),
        "w_in": nrm((DEPTH, D, IN_COLS), D ** -0.5),
        "w_sc": nrm((DEPTH, 3, C3), 3 ** -0.5),
        "b_sc": nrm((DEPTH, C3), 0.02),
        "hf_w1": nrm((DEPTH, HY_EMB, HY_FFN), HY_EMB ** -0.5),
        "hf_b1": nrm((DEPTH, HY_FFN), 0.1),
        "hf_w2": nrm((DEPTH, HY_FFN, HY_FFN), HY_FFN ** -0.5),
        "hf_b2": nrm((DEPTH, HY_FFN), 0.1),
        "hf_w3": nrm((DEPTH, HY_FFN, HY_FFN), HY_FFN ** -0.5),
        "hf_b3": nrm((DEPTH, HY_FFN), 0.1),
        "hf_w4": nrm((DEPTH, HY_FFN, 2 * HY_WIDTH), 0.01),
        "hf_freq": 1.0 + nrm((DEPTH, HY_FFN), 0.01),
        "hy_bias": nrm((DEPTH, HY_WIDTH), 0.5),
        "w_br_h": nrm((DEPTH, HY_WIDTH, D), HY_WIDTH ** -0.5),
        "w_br_a": nrm((DEPTH, ATT_OUT, D), ATT_OUT ** -0.5),
        "w_out": nrm((DEPTH, D, D), D ** -0.5),
        "router_w": nrm((D, E), D ** -0.5),
        "router_bias": nrm((E,), 0.01),
        "moe_w1": nrm((DEPTH, E, D, F), D ** -0.5),
        "moe_w3": nrm((DEPTH, E, D, F), D ** -0.5),
        "moe_w2": nrm((DEPTH, E, F, D), F ** -0.5),
        "final_g": 1.0 + nrm((D,), 0.02),
    }


def reference(x, c, norm1_g, norm2_g, w_ada, b_ada, w_in, w_sc, b_sc,
              hf_w1, hf_b1, hf_w2, hf_b2, hf_w3, hf_b3, hf_w4, hf_freq, hy_bias,
              w_br_h, w_br_a, w_out, router_w, router_bias, moe_w1, moe_w3, moe_w2, final_g):
    B, L, D = x.shape
    pos = jnp.arange(L)
    split_idx = [int(v) for v in np.cumsum(IN_SPLITS)[:-1]]
    c_act = jax.nn.silu(c)
    for i in range(DEPTH):
        mod = c_act @ w_ada[i] + b_ada[i]
        sh1, sc1, g1, sh2, sc2, g2 = jnp.split(mod, 6, axis=-1)

        h = modulate(rms_norm(x, norm1_g[i]), sh1, sc1)
        proj = h @ w_in[i]
        u_hy, q, k, v, gate_hy, gate_at = jnp.split(proj, split_idx, axis=-1)
        y_hy = hyena_mixer(u_hy, w_sc[i], b_sc[i], hf_w1[i], hf_b1[i], hf_w2[i], hf_b2[i],
                           hf_w3[i], hf_b3[i], hf_w4[i], hf_freq[i], hy_bias[i])
        q = rope(q.reshape(B, L, N_HEADS, HEAD_DIM), pos)
        k = rope(k.reshape(B, L, N_HEADS, HEAD_DIM), pos)
        v = v.reshape(B, L, N_HEADS, HEAD_DIM)
        y_at = dilated_attention_mixer(q, k, v)
        merged = (jax.nn.sigmoid(gate_hy) * (y_hy @ w_br_h[i])
                  + jax.nn.sigmoid(gate_at) * (y_at @ w_br_a[i]))
        x = x + g1[:, None, :] * (merged @ w_out[i])

        h = modulate(rms_norm(x, norm2_g[i]), sh2, sc2)
        x = x + g2[:, None, :] * grouped_moe(h, router_w, router_bias, moe_w1[i], moe_w3[i], moe_w2[i])
    return rms_norm(x, final_g)
```

```cpp
#include <hip/hip_runtime.h>
#include <cstdio>
#include <cstdint>
#include <cmath>

typedef unsigned short bf16_t;

namespace {
constexpr int D = 1024, NB = 2, L = 8192, T = NB * L, DEPTH = 2;
constexpr int HYW = 768, C3 = 2304, NH = 12, HD = 64, ATT_OUT = 256, INC = 6656;
constexpr int HY_EMB = 33, HY_FFN = 64;
constexpr int NE = 16, DEXP = 512;
constexpr float NORM_EPS = 1e-6f;
constexpr float QSCALE = 0.125f * 1.4426950408889634f;

constexpr size_t MiB = 1u << 20;
constexpr size_t WS_CTL = 0;
constexpr size_t WS_MOD = 1 * MiB;
constexpr size_t WS_ROPE = 2 * MiB;
constexpr size_t WS_H3 = 4 * MiB;
constexpr size_t WS_SEL = 8 * MiB;
constexpr size_t WS_WTS = WS_SEL + 256 * 1024;
constexpr size_t WS_POS = WS_WTS + 256 * 1024;
constexpr size_t WS_FILT = 10 * MiB;
constexpr size_t WS_XN = 34 * MiB;
constexpr size_t WS_UT = 66 * MiB;
constexpr size_t WS_QS = 138 * MiB;
constexpr size_t WS_KS = 162 * MiB;
constexpr size_t WS_VT = 186 * MiB;
constexpr size_t WS_GATES = 210 * MiB;
constexpr size_t WS_YT = 274 * MiB;
constexpr size_t WS_OG = 298 * MiB;
constexpr size_t WS_LSE = 322 * MiB;
constexpr size_t WS_YCAT = 324 * MiB;
constexpr size_t WS_END = 356 * MiB;
constexpr size_t WS_MERGED = WS_UT;
constexpr size_t WS_Z = WS_QS;
constexpr size_t WS_X0 = WS_VT;
constexpr size_t WS_ACT = WS_QS;
constexpr size_t WS_YB = WS_UT;

__device__ __forceinline__ float bf2f(bf16_t v) { return __uint_as_float((unsigned)v << 16); }
__device__ __forceinline__ bf16_t f2bf(float f) { unsigned u = __float_as_uint(f); return (bf16_t)((u + 0x7fffu + ((u >> 16) & 1u)) >> 16); }
__device__ __forceinline__ float sigmoidf_(float x) { return 1.f / (1.f + __expf(-x)); }
__device__ __forceinline__ float siluf_(float x) { return x / (1.f + __expf(-x)); }
__host__ __device__ __forceinline__ int dil_of_head(int h) { const int g = h >> 2; return g == 0 ? 1 : (g == 1 ? 4 : 16); }
__device__ __forceinline__ size_t qk_row(int b, int h, int t) { const int d = dil_of_head(h), Ls = L / d; return (size_t)(b * NH + h) * L + (size_t)(t % d) * Ls + (t / d); }
__device__ __forceinline__ size_t vt_off(int b, int h, int t, int dv) { const int d = dil_of_head(h), Ls = L / d; return (size_t)(b * NH + h) * L * 64 + (size_t)((t % d) * 64 + dv) * Ls + (t / d); }
__device__ __forceinline__ int permd(int d) { return d < 32 ? 2 * d : 2 * (d - 32) + 1; }

__device__ __forceinline__ float sin_rev(float r) { r = r - rintf(r); return __builtin_amdgcn_sinf(r); }
__device__ __forceinline__ float cos_rev(float r) { r = r - rintf(r); return __builtin_amdgcn_cosf(r); }
__device__ __forceinline__ float sin_rad(float x) { return sin_rev(x * 0.15915494309189535f); }
struct RopeInv { double inv[32]; };
__device__ __forceinline__ float wave_sum(float v) {
#pragma unroll
    for (int o = 1; o < 64; o <<= 1) v += __shfl_xor(v, o);
    return v;
}

__global__ void __launch_bounds__(256) k_mod(const float* c, const float* w_ada, const float* b_ada, float* mod) {
    const int idx = blockIdx.x * blockDim.x + threadIdx.x; if (idx >= DEPTH * NB * 6144) return;
    const int n = idx % 6144, b = (idx / 6144) % NB, l = idx / (6144 * NB);
    float acc = b_ada[l * 6144 + n];
    const float* w = w_ada + (size_t)l * 1024 * 6144 + n;
    for (int k = 0; k < 1024; ++k) acc += siluf_(c[b * 1024 + k]) * w[(size_t)k * 6144];
    mod[idx] = acc;
}
__global__ void __launch_bounds__(256) k_rope(float* rope, RopeInv ri) {
    const int idx = blockIdx.x * blockDim.x + threadIdx.x; if (idx >= L * 32) return;
    const int j = idx % 32, pos = idx / 32;
    double rev = (double)pos * ri.inv[j] * 0.15915494309189535; rev -= floor(rev);
    rope[idx * 2] = cos_rev((float)rev); rope[idx * 2 + 1] = sin_rev((float)rev);
}
__global__ void __launch_bounds__(256) k_h3(const float* w1, const float* b1, const float* w2, const float* b2, const float* w3, const float* b3, const float* freq, float* h3) {
    __shared__ float zs[4][64]; __shared__ float hs[4][64];
    const int wv = threadIdx.x >> 6, j = threadIdx.x & 63;
    const int gi = blockIdx.x * 4 + wv; const int layer = gi / L, l = gi % L;
    const float tpos = (float)l / (float)(L - 1);
    const float wrev = (float)l / (float)L;
    if (j < HY_EMB) {
        float z;
        if (j == 0) z = tpos;
        else { const int i = (j - 1) % 16; const float f = 1e-4f + (15.0f - 1e-4f) * (float)i / 15.0f; z = (j <= 16) ? cos_rev(f * wrev) : -sin_rev(f * wrev); }
        zs[wv][j] = z;
    }
    __syncthreads();
    const float fr = freq[layer * 64 + j];
    float a = b1[layer * 64 + j];
    for (int i = 0; i < HY_EMB; ++i) a += zs[wv][i] * w1[(layer * HY_EMB + i) * 64 + j];
    float h = sin_rad(fr * a);
    hs[wv][j] = h; __syncthreads();
    a = b2[layer * 64 + j];
    for (int i = 0; i < 64; ++i) a += hs[wv][i] * w2[(layer * 64 + i) * 64 + j];
    h = sin_rad(fr * a); __syncthreads();
    hs[wv][j] = h; __syncthreads();
    a = b3[layer * 64 + j];
    for (int i = 0; i < 64; ++i) a += hs[wv][i] * w3[(layer * 64 + i) * 64 + j];
    h = sin_rad(fr * a);
    h3[(size_t)gi * 64 + j] = h;
}
__global__ void __launch_bounds__(256) k_filt(const float* h3  , const float* w4  , _Float16* filt) {
    const int n = blockIdx.x * blockDim.x + threadIdx.x; const int c = blockIdx.y;
    float v = 0.f;
    if (n != 8192) {
        const int l = n < 8192 ? n : 16384 - n, dir = n < 8192 ? 0 : 1;
        float a = 0.f;
        for (int j = 0; j < 64; ++j) a += h3[(size_t)l * 64 + j] * w4[j * 1536 + dir * 768 + c];
        const float tpos = (float)l / (float)(L - 1);
        const float dl = 3.0701134573253945f + (15.350567286626972f - 3.0701134573253945f) * (float)c / 767.0f;
        v = a * expf(-tpos * dl);
    }
    filt[(size_t)c * 16384 + n] = (_Float16)v;
}
__global__ void __launch_bounds__(256) k_norm(const float* x_in, float* x_out, const float* g, const float* mod_l  , int sh_idx, bf16_t* XN,
                       int combine, const bf16_t* YB, const int* POS, const float* WTS, const float* mod_prev) {
    const int row = blockIdx.x * 4 + (threadIdx.x >> 6), lane = threadIdx.x & 63; const int b = row / L;
    float v[16]; float ss = 0.f;
#pragma unroll
    for (int j = 0; j < 4; ++j) {
        const int col = j * 256 + lane * 4;
        const float4 xv = *(const float4*)(x_in + (size_t)row * D + col);
        float t4[4] = {xv.x, xv.y, xv.z, xv.w};
        if (combine) {
            const int p0 = POS[row * 2], p1 = POS[row * 2 + 1]; const float w0 = WTS[row * 2], w1 = WTS[row * 2 + 1];
#pragma unroll
            for (int i = 0; i < 4; ++i) { const float y = w0 * bf2f(YB[(size_t)p0 * D + col + i]) + w1 * bf2f(YB[(size_t)p1 * D + col + i]); t4[i] += mod_prev[b * 6144 + 5 * 1024 + col + i] * y; }
        }
#pragma unroll
        for (int i = 0; i < 4; ++i) { v[j * 4 + i] = t4[i]; ss += t4[i] * t4[i]; }
        *(float4*)(x_out + (size_t)row * D + col) = make_float4(t4[0], t4[1], t4[2], t4[3]);
    }
    ss = wave_sum(ss);
    const float rstd = rsqrtf(ss * (1.0f / D) + NORM_EPS);
    if (XN) {
#pragma unroll
        for (int j = 0; j < 4; ++j)
#pragma unroll
            for (int i = 0; i < 4; ++i) { const int col = j * 256 + lane * 4 + i;
                const float y = v[j * 4 + i] * rstd * g[col];
                XN[(size_t)row * D + col] = f2bf(y * (1.f + mod_l[b * 6144 + (sh_idx + 1) * 1024 + col]) + mod_l[b * 6144 + sh_idx * 1024 + col]); }
    }
}
__global__ void __launch_bounds__(256) k_final(const float* x_in, float* out, const float* g, const float* mod_l, const bf16_t* YB, const int* POS, const float* WTS) {
    const int row = blockIdx.x * 4 + (threadIdx.x >> 6), lane = threadIdx.x & 63; const int b = row / L;
    float v[16]; float ss = 0.f;
    const int p0 = POS[row * 2], p1 = POS[row * 2 + 1]; const float w0 = WTS[row * 2], w1 = WTS[row * 2 + 1];
#pragma unroll
    for (int j = 0; j < 4; ++j)
#pragma unroll
        for (int i = 0; i < 4; ++i) { const int col = j * 256 + lane * 4 + i;
            const float y = w0 * bf2f(YB[(size_t)p0 * D + col]) + w1 * bf2f(YB[(size_t)p1 * D + col]);
            const float t = x_in[(size_t)row * D + col] + mod_l[b * 6144 + 5 * 1024 + col] * y; v[j * 4 + i] = t; ss += t * t; }
    ss = wave_sum(ss);
    const float rstd = rsqrtf(ss * (1.0f / D) + NORM_EPS);
#pragma unroll
    for (int j = 0; j < 4; ++j)
#pragma unroll
        for (int i = 0; i < 4; ++i) { const int col = j * 256 + lane * 4 + i; out[(size_t)row * D + col] = v[j * 4 + i] * rstd * g[col]; }
}
__global__ void __launch_bounds__(256) k_gemm1(const bf16_t* XN, const float* w_in, const float* rope, bf16_t* UT, bf16_t* QS, bf16_t* KS, bf16_t* VT, bf16_t* GATES) {
    __shared__ float sm[8][256];
    const int n = blockIdx.x * 256 + threadIdx.x, t0 = blockIdx.y * 8;
    float acc[8];
#pragma unroll
    for (int i = 0; i < 8; ++i) acc[i] = 0.f;
    for (int k = 0; k < D; ++k) { const float w = w_in[(size_t)k * INC + n];
#pragma unroll
        for (int i = 0; i < 8; ++i) acc[i] += bf2f(XN[(size_t)(t0 + i) * D + k]) * w; }
#pragma unroll
    for (int i = 0; i < 8; ++i) sm[i][threadIdx.x] = acc[i];
    __syncthreads();
#pragma unroll
    for (int i = 0; i < 8; ++i) {
        const int tt = t0 + i, b = tt / L, t = tt % L;
        if (n < C3) UT[(size_t)n * T + tt] = f2bf(acc[i]);
        else if (n < C3 + 2 * HYW) {
            const int isk = n >= C3 + HYW; const int cc = n - C3 - isk * HYW; const int h = cc / 64, d = cc % 64;
            if (d < 32) {
                const float a = acc[i], bb = sm[i][threadIdx.x + 32];
                const float cs = rope[(t * 32 + d) * 2], sn = rope[(t * 32 + d) * 2 + 1];
                float o1 = a * cs - bb * sn, o2 = bb * cs + a * sn;
                if (!isk) { o1 *= QSCALE; o2 *= QSCALE; }
                bf16_t* dst = (isk ? KS : QS) + qk_row(b, h, t) * 64;
                dst[permd(d)] = f2bf(o1); dst[permd(d + 32)] = f2bf(o2);
            }
        } else if (n < C3 + 3 * HYW) { const int cc = n - C3 - 2 * HYW; VT[vt_off(b, cc / 64, t, cc % 64)] = f2bf(acc[i]); }
        else GATES[(size_t)tt * 2048 + (n - (C3 + 3 * HYW))] = f2bf(sigmoidf_(acc[i]));
    }
}
__global__ void __launch_bounds__(128) k_attn(const bf16_t* QS, const bf16_t* KS, const bf16_t* VT, bf16_t* OG, float* LSE) {
    const int idx = blockIdx.x * blockDim.x + threadIdx.x; if (idx >= NB * NH * L) return;
    const int t = idx % L, h = (idx / L) % NH, b = idx / (L * NH);
    const int d = dil_of_head(h), Ls = L / d, r = t % d, m = t / d, g = h >> 2, hh = h & 3;
    const size_t rowbase = (size_t)(b * NH + h) * L + (size_t)r * Ls;
    float q[64];
#pragma unroll
    for (int i = 0; i < 64; ++i) q[i] = bf2f(QS[(rowbase + m) * 64 + i]);
    float mx = -1e30f;
    for (int j = -64; j <= 64; ++j) { const int mm = m + j; if (mm < 0 || mm >= Ls) continue;
        float s = 0.f;
#pragma unroll
        for (int i = 0; i < 64; ++i) s += q[i] * bf2f(KS[(rowbase + mm) * 64 + i]);
        mx = fmaxf(mx, s); }
    float o[64];
#pragma unroll
    for (int i = 0; i < 64; ++i) o[i] = 0.f;
    float l = 0.f;
    const bf16_t* vb = VT + (size_t)(b * NH + h) * L * 64 + (size_t)(r * 64) * Ls;
    for (int j = -64; j <= 64; ++j) { const int mm = m + j; if (mm < 0 || mm >= Ls) continue;
        float s = 0.f;
#pragma unroll
        for (int i = 0; i < 64; ++i) s += q[i] * bf2f(KS[(rowbase + mm) * 64 + i]);
        const float p = exp2f(s - mx); l += p;
#pragma unroll
        for (int i = 0; i < 64; ++i) o[i] += p * bf2f(vb[(size_t)i * Ls + mm]); }
    const float il = 1.f / l; const int tt = b * L + t;
#pragma unroll
    for (int i = 0; i < 64; ++i) OG[((size_t)g * T + tt) * 256 + hh * 64 + i] = f2bf(o[i] * il);
    LSE[((size_t)g * T + tt) * 4 + hh] = mx + log2f(l);
}
__global__ void __launch_bounds__(256) k_z(const bf16_t* UT, const float* w_sc  , const float* b_sc, float* Z, bf16_t* X0) {
    const int tt = blockIdx.x * blockDim.x + threadIdx.x, c = blockIdx.y; const int t = tt % L;
    float r[3];
#pragma unroll
    for (int s = 0; s < 3; ++s) { const int ch = s * 768 + c; const bf16_t* u = UT + (size_t)ch * T + tt;
        const float um = t > 0 ? bf2f(u[-1]) : 0.f, u0 = bf2f(u[0]), up = t < L - 1 ? bf2f(u[1]) : 0.f;
        r[s] = um * w_sc[ch] + u0 * w_sc[C3 + ch] + up * w_sc[2 * C3 + ch] + b_sc[ch]; }
    X0[(size_t)c * T + tt] = f2bf(r[0]); Z[(size_t)c * T + tt] = r[2] * r[1];
}
__global__ void __launch_bounds__(256) k_conv(const _Float16* filt, const float* Z, const bf16_t* X0, const float* hy_bias, bf16_t* YT) {
    __shared__ float zs[256]; __shared__ float ks[512];
    const int c = blockIdx.y, b = blockIdx.z, t0 = blockIdx.x * 256, t = t0 + threadIdx.x;
    const float* z = Z + (size_t)c * T + (size_t)b * L; const _Float16* kf = filt + (size_t)c * 16384;
    float acc = 0.f;
    for (int s0 = 0; s0 < L; s0 += 256) {
        __syncthreads();
        zs[threadIdx.x] = z[s0 + threadIdx.x];
        const int base = t0 - s0 - 255;
        ks[threadIdx.x] = (float)kf[(base + (int)threadIdx.x) & 16383]; ks[threadIdx.x + 256] = (float)kf[(base + (int)threadIdx.x + 256) & 16383];
        __syncthreads();
#pragma unroll 8
        for (int i = 0; i < 256; ++i) acc += ks[(int)threadIdx.x - i + 255] * zs[i];
    }
    const size_t o = (size_t)c * T + (size_t)b * L + t;
    YT[o] = f2bf((acc + z[t] * hy_bias[c]) * bf2f(X0[o]));
}
__global__ void __launch_bounds__(256) k_ycat(const bf16_t* YT, const bf16_t* OG, const float* LSE, bf16_t* YCAT) {
    const int col = blockIdx.x * 256 + threadIdx.x; const int tt = blockIdx.y;
    if (col < 768) { YCAT[(size_t)tt * D + col] = YT[(size_t)col * T + tt]; return; }
    const int cc = col - 768, hh = cc / 64;
    const float l0 = LSE[((size_t)0 * T + tt) * 4 + hh], l1 = LSE[((size_t)1 * T + tt) * 4 + hh], l2 = LSE[((size_t)2 * T + tt) * 4 + hh];
    const float mx = fmaxf(l0, fmaxf(l1, l2)); const float e0 = exp2f(l0 - mx), e1 = exp2f(l1 - mx), e2 = exp2f(l2 - mx); const float inv = 1.f / (e0 + e1 + e2);
    const float o = e0 * bf2f(OG[((size_t)0 * T + tt) * 256 + cc]) + e1 * bf2f(OG[((size_t)1 * T + tt) * 256 + cc]) + e2 * bf2f(OG[((size_t)2 * T + tt) * 256 + cc]);
    YCAT[(size_t)tt * D + col] = f2bf(o * inv);
}
__global__ void __launch_bounds__(256) k_merge(const bf16_t* YCAT, const float* w_br_h, const float* w_br_a, const bf16_t* GATES, bf16_t* MERGED) {
    const int n = blockIdx.x * 256 + threadIdx.x, t0 = blockIdx.y * 8;
    float a1[8], a2[8];
#pragma unroll
    for (int i = 0; i < 8; ++i) { a1[i] = 0.f; a2[i] = 0.f; }
    for (int k = 0; k < 768; ++k) { const float w = w_br_h[(size_t)k * D + n];
#pragma unroll
        for (int i = 0; i < 8; ++i) a1[i] += bf2f(YCAT[(size_t)(t0 + i) * D + k]) * w; }
    for (int k = 0; k < 256; ++k) { const float w = w_br_a[(size_t)k * D + n];
#pragma unroll
        for (int i = 0; i < 8; ++i) a2[i] += bf2f(YCAT[(size_t)(t0 + i) * D + 768 + k]) * w; }
#pragma unroll
    for (int i = 0; i < 8; ++i) { const size_t tt = t0 + i; MERGED[tt * D + n] = f2bf(bf2f(GATES[tt * 2048 + n]) * a1[i] + bf2f(GATES[tt * 2048 + 1024 + n]) * a2[i]); }
}
__global__ void __launch_bounds__(256) k_out(const bf16_t* MERGED, const float* w_out, const float* mod_l, float* x) {
    const int n = blockIdx.x * 256 + threadIdx.x, t0 = blockIdx.y * 8;
    float a[8];
#pragma unroll
    for (int i = 0; i < 8; ++i) a[i] = 0.f;
    for (int k = 0; k < D; ++k) { const float w = w_out[(size_t)k * D + n];
#pragma unroll
        for (int i = 0; i < 8; ++i) a[i] += bf2f(MERGED[(size_t)(t0 + i) * D + k]) * w; }
#pragma unroll
    for (int i = 0; i < 8; ++i) { const size_t tt = t0 + i; const int b = (int)(tt / L); x[tt * D + n] += mod_l[b * 6144 + 2 * 1024 + n] * a[i]; }
}
__global__ void __launch_bounds__(256) k_norm2_route(const float* x, const float* g, const float* mod_l, bf16_t* XN, const float* router_w, const float* router_bias, int* SEL, float* WTS, int* POS) {
    const int row = blockIdx.x * 4 + (threadIdx.x >> 6), lane = threadIdx.x & 63; const int b = row / L;
    float v[16]; float ss = 0.f;
#pragma unroll
    for (int j = 0; j < 4; ++j) { const float4 xv = *(const float4*)(x + (size_t)row * D + j * 256 + lane * 4); v[j * 4] = xv.x; v[j * 4 + 1] = xv.y; v[j * 4 + 2] = xv.z; v[j * 4 + 3] = xv.w; ss += xv.x * xv.x + xv.y * xv.y + xv.z * xv.z + xv.w * xv.w; }
    ss = wave_sum(ss);
    const float rstd = rsqrtf(ss * (1.0f / D) + NORM_EPS);
    float lg[16];
#pragma unroll
    for (int e = 0; e < 16; ++e) lg[e] = 0.f;
#pragma unroll
    for (int j = 0; j < 4; ++j)
#pragma unroll
        for (int i = 0; i < 4; ++i) { const int col = j * 256 + lane * 4 + i;
            const float y = v[j * 4 + i] * rstd * g[col];
            const float h = y * (1.f + mod_l[b * 6144 + 4 * 1024 + col]) + mod_l[b * 6144 + 3 * 1024 + col];
            XN[(size_t)row * D + col] = f2bf(h);
            const float4* rw = (const float4*)(router_w + (size_t)col * 16);
#pragma unroll
            for (int q4 = 0; q4 < 4; ++q4) { const float4 w = rw[q4]; lg[q4 * 4] += h * w.x; lg[q4 * 4 + 1] += h * w.y; lg[q4 * 4 + 2] += h * w.z; lg[q4 * 4 + 3] += h * w.w; } }
#pragma unroll
    for (int e = 0; e < 16; ++e) lg[e] = wave_sum(lg[e]);
    if (lane == 0) {
        float sc[16], bi[16];
#pragma unroll
        for (int e = 0; e < 16; ++e) { sc[e] = 1.f / (1.f + expf(-lg[e])); bi[e] = sc[e] + router_bias[e]; }
        int sel = 0; float best = -1e30f;
#pragma unroll
        for (int gq = 0; gq < 4; ++gq) { float m1 = -1e30f, m2 = -1e30f;
#pragma unroll
            for (int i = 0; i < 4; ++i) { const float vv = bi[gq * 4 + i]; if (vv > m1) { m2 = m1; m1 = vv; } else if (vv > m2) m2 = vv; }
            const float gs = m1 + m2; if (gs > best) { best = gs; sel = gq; } }
        float gv[4], gsc[4];
#pragma unroll
        for (int i = 0; i < 4; ++i) { gv[i] = 0.f; gsc[i] = 0.f; }
#pragma unroll
        for (int gq = 0; gq < 4; ++gq)
#pragma unroll
            for (int i = 0; i < 4; ++i) { if (gq == sel) { gv[i] = bi[gq * 4 + i]; gsc[i] = sc[gq * 4 + i]; } }
        int i1 = 0; float m1 = gv[0];
#pragma unroll
        for (int i = 1; i < 4; ++i) { if (gv[i] > m1) { m1 = gv[i]; i1 = i; } }
        int i2 = 0; float m2 = -1e30f;
#pragma unroll
        for (int i = 0; i < 4; ++i) { if (i != i1 && gv[i] > m2) { m2 = gv[i]; i2 = i; } }
        float s1 = 0.f, s2 = 0.f;
#pragma unroll
        for (int i = 0; i < 4; ++i) { s1 = (i == i1) ? gsc[i] : s1; s2 = (i == i2) ? gsc[i] : s2; }
        const int e1 = sel * 4 + i1, e2 = sel * 4 + i2; const float s = s1 + s2;
        SEL[row * 2] = e1; SEL[row * 2 + 1] = e2; WTS[row * 2] = s1 / s; WTS[row * 2 + 1] = s2 / s;
        POS[row * 2] = row * 2; POS[row * 2 + 1] = row * 2 + 1;
    }
}
__global__ void __launch_bounds__(512) k_moe_up(const bf16_t* XN, const int* SEL, const float* w1, const float* w3, bf16_t* ACT) {
    const int rs = blockIdx.x; const int tok = rs >> 1; const int e = SEL[rs];
    const float* W1 = w1 + (size_t)e * D * DEXP; const float* W3 = w3 + (size_t)e * D * DEXP;
    const int f = threadIdx.x;
    float a1 = 0.f, a3 = 0.f;
    for (int k = 0; k < D; ++k) { const float h = bf2f(XN[(size_t)tok * D + k]); a1 += h * W1[(size_t)k * DEXP + f]; a3 += h * W3[(size_t)k * DEXP + f]; }
    ACT[(size_t)rs * DEXP + f] = f2bf(siluf_(a1) * a3);
}
__global__ void __launch_bounds__(512) k_moe_down(const bf16_t* ACT, const int* SEL, const float* w2, bf16_t* YB) {
    const int rs = blockIdx.x; const int e = SEL[rs];
    const float* W2 = w2 + (size_t)e * DEXP * D;
    float a[2] = {0.f, 0.f};
    for (int k = 0; k < DEXP; ++k) { const float h = bf2f(ACT[(size_t)rs * DEXP + k]); a[0] += h * W2[(size_t)k * D + threadIdx.x]; a[1] += h * W2[(size_t)k * D + 512 + threadIdx.x]; }
    YB[(size_t)rs * D + threadIdx.x] = f2bf(a[0]); YB[(size_t)rs * D + 512 + threadIdx.x] = f2bf(a[1]);
}
}

extern "C" void kernel_launch(void* const* d_in, const int* in_sizes, int n_in, void* d_out, int out_size, void* d_ws, size_t ws_size, hipStream_t stream) {
    if (n_in != 27 || in_sizes[0] != T * D || out_size != T * D || ws_size < WS_END) {
        fprintf(stderr, "kernel_launch: unexpected shapes / workspace (n_in %d, in0 %d, out %d, ws %zu need %zu); nothing launched\n", n_in, n_in > 0 ? in_sizes[0] : -1, out_size, ws_size, (size_t)WS_END);
        return;
    }
    const float* x = (const float*)d_in[0]; const float* c = (const float*)d_in[1]; const float* norm1_g = (const float*)d_in[2]; const float* norm2_g = (const float*)d_in[3];
    const float* w_ada = (const float*)d_in[4]; const float* b_ada = (const float*)d_in[5]; const float* w_in = (const float*)d_in[6]; const float* w_sc = (const float*)d_in[7]; const float* b_sc = (const float*)d_in[8];
    const float* hf_w1 = (const float*)d_in[9]; const float* hf_b1 = (const float*)d_in[10]; const float* hf_w2 = (const float*)d_in[11]; const float* hf_b2 = (const float*)d_in[12];
    const float* hf_w3 = (const float*)d_in[13]; const float* hf_b3 = (const float*)d_in[14]; const float* hf_w4 = (const float*)d_in[15]; const float* hf_freq = (const float*)d_in[16];
    const float* hy_bias = (const float*)d_in[17]; const float* w_br_h = (const float*)d_in[18]; const float* w_br_a = (const float*)d_in[19]; const float* w_out = (const float*)d_in[20];
    const float* router_w = (const float*)d_in[21]; const float* router_bias = (const float*)d_in[22]; const float* moe_w1 = (const float*)d_in[23]; const float* moe_w3 = (const float*)d_in[24];
    const float* moe_w2 = (const float*)d_in[25]; const float* final_g = (const float*)d_in[26];
    unsigned char* ws = (unsigned char*)d_ws; float* out = (float*)d_out;
    float* MOD = (float*)(ws + WS_MOD); float* ROPE = (float*)(ws + WS_ROPE); float* H3 = (float*)(ws + WS_H3);
    int* SEL = (int*)(ws + WS_SEL); float* WTS = (float*)(ws + WS_WTS); int* POS = (int*)(ws + WS_POS);
    _Float16* FILT = (_Float16*)(ws + WS_FILT); bf16_t* XN = (bf16_t*)(ws + WS_XN); bf16_t* UT = (bf16_t*)(ws + WS_UT);
    bf16_t* QS = (bf16_t*)(ws + WS_QS); bf16_t* KS = (bf16_t*)(ws + WS_KS); bf16_t* VT = (bf16_t*)(ws + WS_VT); bf16_t* GATES = (bf16_t*)(ws + WS_GATES);
    bf16_t* YT = (bf16_t*)(ws + WS_YT); bf16_t* OG = (bf16_t*)(ws + WS_OG); float* LSE = (float*)(ws + WS_LSE); bf16_t* YCAT = (bf16_t*)(ws + WS_YCAT);
    bf16_t* MERGED = (bf16_t*)(ws + WS_MERGED); float* Z = (float*)(ws + WS_Z); bf16_t* X0 = (bf16_t*)(ws + WS_X0); bf16_t* ACT = (bf16_t*)(ws + WS_ACT); bf16_t* YB = (bf16_t*)(ws + WS_YB);

    (void)hipMemsetAsync(ws + WS_CTL, 0, 1 * MiB, stream);
    k_mod<<<(DEPTH * NB * 6144 + 255) / 256, 256, 0, stream>>>(c, w_ada, b_ada, MOD);
    RopeInv ri{}; for (int j = 0; j < 32; ++j) ri.inv[j] = pow(10000.0, -(double)j / 32.0);
    k_rope<<<(L * 32 + 255) / 256, 256, 0, stream>>>(ROPE, ri);
    k_h3<<<DEPTH * L / 4, 256, 0, stream>>>(hf_w1, hf_b1, hf_w2, hf_b2, hf_w3, hf_b3, hf_freq, H3);
    for (int l = 0; l < DEPTH; ++l) {
        const float* mod_l = MOD + (size_t)l * NB * 6144;
        k_filt<<<dim3(16384 / 256, 768), 256, 0, stream>>>(H3 + (size_t)l * L * 64, hf_w4 + (size_t)l * 64 * 1536, FILT);
        k_norm<<<T / 4, 256, 0, stream>>>(l == 0 ? x : out, out, norm1_g + l * D, mod_l, 0, XN, l > 0, YB, POS, WTS, l > 0 ? mod_l - NB * 6144 : mod_l);
        k_gemm1<<<dim3(INC / 256, T / 8), 256, 0, stream>>>(XN, w_in + (size_t)l * D * INC, ROPE, UT, QS, KS, VT, GATES);
        k_attn<<<(NB * NH * L + 127) / 128, 128, 0, stream>>>(QS, KS, VT, OG, LSE);
        k_z<<<dim3(T / 256, 768), 256, 0, stream>>>(UT, w_sc + (size_t)l * 3 * C3, b_sc + (size_t)l * C3, Z, X0);
        k_conv<<<dim3(L / 256, 768, NB), 256, 0, stream>>>(FILT, Z, X0, hy_bias + l * HYW, YT);
        k_ycat<<<dim3(4, T), 256, 0, stream>>>(YT, OG, LSE, YCAT);
        k_merge<<<dim3(D / 256, T / 8), 256, 0, stream>>>(YCAT, w_br_h + (size_t)l * HYW * D, w_br_a + (size_t)l * ATT_OUT * D, GATES, MERGED);
        k_out<<<dim3(D / 256, T / 8), 256, 0, stream>>>(MERGED, w_out + (size_t)l * D * D, mod_l, out);
        k_norm2_route<<<T / 4, 256, 0, stream>>>(out, norm2_g + l * D, mod_l, XN, router_w, router_bias, SEL, WTS, POS);
        k_moe_up<<<T * 2, 512, 0, stream>>>(XN, SEL, moe_w1 + (size_t)l * NE * D * DEXP, moe_w3 + (size_t)l * NE * D * DEXP, ACT);
        k_moe_down<<<T * 2, 512, 0, stream>>>(ACT, SEL, moe_w2 + (size_t)l * NE * DEXP * D, YB);
    }
    k_final<<<T / 4, 256, 0, stream>>>(out, out, final_g, MOD + (size_t)(DEPTH - 1) * NB * 6144, YB, POS, WTS);
}
```

```cpp
#include <hip/hip_runtime.h>
#include <hip/hip_cooperative_groups.h>
#include <cstdio>
#include <cstdint>
#include <cmath>

typedef unsigned short bf16_t;

namespace {
constexpr int D = 1024, NB = 2, L = 8192, T = NB * L, DEPTH = 2;
constexpr int HYW = 768, C3 = 2304, NH = 12, HD = 64, ATT_OUT = 256, INC = 6656;
constexpr int HY_EMB = 33, HY_FFN = 64;
constexpr int NE = 16, DEXP = 512;
constexpr float NORM_EPS = 1e-6f;
constexpr float QSCALE = 0.125f * 1.4426950408889634f;

constexpr size_t MiB = 1u << 20;
constexpr size_t WS_CTL = 0;
constexpr size_t WS_MOD = 1 * MiB;
constexpr size_t WS_ROPE = 2 * MiB;
constexpr size_t WS_H3 = 4 * MiB;
constexpr size_t WS_SEL = 8 * MiB;
constexpr size_t WS_WTS = WS_SEL + 256 * 1024;
constexpr size_t WS_POS = WS_WTS + 256 * 1024;
constexpr size_t WS_FILT = 10 * MiB;
constexpr size_t WS_XN = 34 * MiB;
constexpr size_t WS_UT = 66 * MiB;
constexpr size_t WS_QS = 138 * MiB;
constexpr size_t WS_KS = 162 * MiB;
constexpr size_t WS_VT = 186 * MiB;
constexpr size_t WS_GATES = 210 * MiB;
constexpr size_t WS_YT = 274 * MiB;
constexpr size_t WS_OG = 298 * MiB;
constexpr size_t WS_LSE = 322 * MiB;
constexpr size_t WS_YCAT = 324 * MiB;
constexpr size_t WS_END = 356 * MiB;
constexpr size_t WS_MERGED = WS_UT;
constexpr size_t WS_Z = WS_QS;
constexpr size_t WS_X0 = WS_VT;
constexpr size_t WS_ACT = WS_QS;
constexpr size_t WS_YB = WS_UT;

__device__ __forceinline__ float bf2f(bf16_t v) { return __uint_as_float((unsigned)v << 16); }
__device__ __forceinline__ bf16_t f2bf(float f) { unsigned u = __float_as_uint(f); return (bf16_t)((u + 0x7fffu + ((u >> 16) & 1u)) >> 16); }
__device__ __forceinline__ float sigmoidf_(float x) { return 1.f / (1.f + __expf(-x)); }
__device__ __forceinline__ float siluf_(float x) { return x / (1.f + __expf(-x)); }
__host__ __device__ __forceinline__ int dil_of_head(int h) { const int g = h >> 2; return g == 0 ? 1 : (g == 1 ? 4 : 16); }
__device__ __forceinline__ size_t qk_row(int b, int h, int t) { const int d = dil_of_head(h), Ls = L / d; return (size_t)(b * NH + h) * L + (size_t)(t % d) * Ls + (t / d); }
__device__ __forceinline__ size_t vt_off(int b, int h, int t, int dv) { const int d = dil_of_head(h), Ls = L / d; return (size_t)(b * NH + h) * L * 64 + (size_t)((t % d) * 64 + dv) * Ls + (t / d); }
__device__ __forceinline__ int permd(int d) { return d < 32 ? 2 * d : 2 * (d - 32) + 1; }

__device__ __forceinline__ float sin_rev(float r) { r = r - rintf(r); return __builtin_amdgcn_sinf(r); }
__device__ __forceinline__ float cos_rev(float r) { r = r - rintf(r); return __builtin_amdgcn_cosf(r); }
__device__ __forceinline__ float sin_rad(float x) { return sin_rev(x * 0.15915494309189535f); }
struct RopeInv { double inv[32]; };
__device__ __forceinline__ float wave_sum(float v) {
#pragma unroll
    for (int o = 1; o < 64; o <<= 1) v += __shfl_xor(v, o);
    return v;
}


struct P {
    const float *x, *c, *norm1_g, *norm2_g, *w_ada, *b_ada, *w_in, *w_sc, *b_sc, *hf_w1, *hf_b1, *hf_w2, *hf_b2, *hf_w3, *hf_b3, *hf_w4, *hf_freq, *hy_bias,
                *w_br_h, *w_br_a, *w_out, *router_w, *router_bias, *moe_w1, *moe_w3, *moe_w2, *final_g;
    float* out; unsigned char* ws;
    RopeInv ri;
    int ph_lo, ph_hi;
};
#define VT_ ((int)(threadIdx.x & 255))
#define VLOOP(NVB) for (int vb = (int)blockIdx.x * 2 + (int)(threadIdx.x >> 8); vb < (NVB); vb += (int)gridDim.x * 2)

__device__ __forceinline__ void nv_mod(const P& p, float* mod) {
    VLOOP(96) { const int idx = vb * 256 + VT_;
        const int n = idx % 6144, b = (idx / 6144) % NB, l = idx / (6144 * NB);
        float acc = p.b_ada[l * 6144 + n];
        const float* w = p.w_ada + (size_t)l * 1024 * 6144 + n;
        for (int k = 0; k < 1024; ++k) acc += siluf_(p.c[b * 1024 + k]) * w[(size_t)k * 6144];
        mod[idx] = acc; }
}
__device__ __forceinline__ void nv_rope(const P& p, float* rope) {
    VLOOP(1024) { const int idx = vb * 256 + VT_; const int j = idx % 32, pos = idx / 32;
        double rev = (double)pos * p.ri.inv[j] * 0.15915494309189535; rev -= floor(rev);
        rope[idx * 2] = cos_rev((float)rev); rope[idx * 2 + 1] = sin_rev((float)rev); }
}
__device__ __forceinline__ void nv_h3(const P& p, float* h3, unsigned char* sm) {
    float (*zs)[64] = (float (*)[64])sm; float (*hs)[64] = (float (*)[64])(sm + 1024);
    VLOOP(DEPTH * L / 4) {
        const int wv = VT_ >> 6, j = VT_ & 63;
        const int gi = vb * 4 + wv; const int layer = gi / L, l = gi % L;
        const float tpos = (float)l / (float)(L - 1);
        const float wrev = (float)l / (float)L;
        __syncthreads();
        if (j < HY_EMB) {
            float z;
            if (j == 0) z = tpos;
            else { const int i = (j - 1) % 16; const float f = 1e-4f + (15.0f - 1e-4f) * (float)i / 15.0f; z = (j <= 16) ? cos_rev(f * wrev) : -sin_rev(f * wrev); }
            zs[wv][j] = z;
        }
        __syncthreads();
        const float fr = p.hf_freq[layer * 64 + j];
        float a = p.hf_b1[layer * 64 + j];
        for (int i = 0; i < HY_EMB; ++i) a += zs[wv][i] * p.hf_w1[(layer * HY_EMB + i) * 64 + j];
        float h = sin_rad(fr * a);
        hs[wv][j] = h; __syncthreads();
        a = p.hf_b2[layer * 64 + j];
        for (int i = 0; i < 64; ++i) a += hs[wv][i] * p.hf_w2[(layer * 64 + i) * 64 + j];
        h = sin_rad(fr * a); __syncthreads();
        hs[wv][j] = h; __syncthreads();
        a = p.hf_b3[layer * 64 + j];
        for (int i = 0; i < 64; ++i) a += hs[wv][i] * p.hf_w3[(layer * 64 + i) * 64 + j];
        h = sin_rad(fr * a);
        h3[(size_t)gi * 64 + j] = h;
    }
}
__device__ __forceinline__ void nv_filt(const float* h3, const float* w4, _Float16* filt) {
    VLOOP(64 * 768) { const int n = (vb % 64) * 256 + VT_, c = vb / 64;
        float v = 0.f;
        if (n != 8192) {
            const int l = n < 8192 ? n : 16384 - n, dir = n < 8192 ? 0 : 1;
            float a = 0.f;
            for (int j = 0; j < 64; ++j) a += h3[(size_t)l * 64 + j] * w4[j * 1536 + dir * 768 + c];
            const float tpos = (float)l / (float)(L - 1);
            const float dl = 3.0701134573253945f + (15.350567286626972f - 3.0701134573253945f) * (float)c / 767.0f;
            v = a * expf(-tpos * dl);
        }
        filt[(size_t)c * 16384 + n] = (_Float16)v; }
}
__device__ __forceinline__ void nv_norm(const float* x_in, float* x_out, const float* g, const float* mod_l, bf16_t* XN, int combine, const bf16_t* YB, const int* POS, const float* WTS, const float* mod_prev) {
    VLOOP(T / 4) {
        const int row = vb * 4 + (VT_ >> 6), lane = VT_ & 63; const int b = row / L;
        float v[16]; float ss = 0.f;
#pragma unroll
        for (int j = 0; j < 4; ++j) {
            const int col = j * 256 + lane * 4;
            const float4 xv = *(const float4*)(x_in + (size_t)row * D + col);
            float t4[4] = {xv.x, xv.y, xv.z, xv.w};
            if (combine) {
                const int p0 = POS[row * 2], p1 = POS[row * 2 + 1]; const float w0 = WTS[row * 2], w1 = WTS[row * 2 + 1];
#pragma unroll
                for (int i = 0; i < 4; ++i) { const float y = w0 * bf2f(YB[(size_t)p0 * D + col + i]) + w1 * bf2f(YB[(size_t)p1 * D + col + i]); t4[i] += mod_prev[b * 6144 + 5 * 1024 + col + i] * y; }
            }
#pragma unroll
            for (int i = 0; i < 4; ++i) { v[j * 4 + i] = t4[i]; ss += t4[i] * t4[i]; }
            *(float4*)(x_out + (size_t)row * D + col) = make_float4(t4[0], t4[1], t4[2], t4[3]);
        }
        ss = wave_sum(ss);
        const float rstd = rsqrtf(ss * (1.0f / D) + NORM_EPS);
#pragma unroll
        for (int j = 0; j < 4; ++j)
#pragma unroll
            for (int i = 0; i < 4; ++i) { const int col = j * 256 + lane * 4 + i;
                const float y = v[j * 4 + i] * rstd * g[col];
                XN[(size_t)row * D + col] = f2bf(y * (1.f + mod_l[b * 6144 + 1024 + col]) + mod_l[b * 6144 + col]); }
    }
}
__device__ __forceinline__ void nv_final(const float* x_in, float* out, const float* g, const float* mod_l, const bf16_t* YB, const int* POS, const float* WTS) {
    VLOOP(T / 4) {
        const int row = vb * 4 + (VT_ >> 6), lane = VT_ & 63; const int b = row / L;
        float v[16]; float ss = 0.f;
        const int p0 = POS[row * 2], p1 = POS[row * 2 + 1]; const float w0 = WTS[row * 2], w1 = WTS[row * 2 + 1];
#pragma unroll
        for (int j = 0; j < 4; ++j)
#pragma unroll
            for (int i = 0; i < 4; ++i) { const int col = j * 256 + lane * 4 + i;
                const float y = w0 * bf2f(YB[(size_t)p0 * D + col]) + w1 * bf2f(YB[(size_t)p1 * D + col]);
                const float t = x_in[(size_t)row * D + col] + mod_l[b * 6144 + 5 * 1024 + col] * y; v[j * 4 + i] = t; ss += t * t; }
        ss = wave_sum(ss);
        const float rstd = rsqrtf(ss * (1.0f / D) + NORM_EPS);
#pragma unroll
        for (int j = 0; j < 4; ++j)
#pragma unroll
            for (int i = 0; i < 4; ++i) { const int col = j * 256 + lane * 4 + i; out[(size_t)row * D + col] = v[j * 4 + i] * rstd * g[col]; }
    }
}
__device__ __forceinline__ void nv_gemm1(const bf16_t* XN, const float* w_in, const float* rope, bf16_t* UT, bf16_t* QS, bf16_t* KS, bf16_t* VT, bf16_t* GATES, unsigned char* smraw) {
    float (*sm)[256] = (float (*)[256])smraw;
    VLOOP(26 * (T / 8)) {
        const int tx = VT_; const int n = (vb % 26) * 256 + tx, t0 = (vb / 26) * 8;
        float acc[8];
#pragma unroll
        for (int i = 0; i < 8; ++i) acc[i] = 0.f;
        for (int k = 0; k < D; ++k) { const float w = w_in[(size_t)k * INC + n];
#pragma unroll
            for (int i = 0; i < 8; ++i) acc[i] += bf2f(XN[(size_t)(t0 + i) * D + k]) * w; }
        __syncthreads();
#pragma unroll
        for (int i = 0; i < 8; ++i) sm[i][tx] = acc[i];
        __syncthreads();
#pragma unroll
        for (int i = 0; i < 8; ++i) {
            const int tt = t0 + i, b = tt / L, t = tt % L;
            if (n < C3) UT[(size_t)n * T + tt] = f2bf(acc[i]);
            else if (n < C3 + 2 * HYW) {
                const int isk = n >= C3 + HYW; const int cc = n - C3 - isk * HYW; const int h = cc / 64, d = cc % 64;
                if (d < 32) {
                    const float a = acc[i], bb = sm[i][tx + 32];
                    const float cs = rope[(t * 32 + d) * 2], sn = rope[(t * 32 + d) * 2 + 1];
                    float o1 = a * cs - bb * sn, o2 = bb * cs + a * sn;
                    if (!isk) { o1 *= QSCALE; o2 *= QSCALE; }
                    bf16_t* dst = (isk ? KS : QS) + qk_row(b, h, t) * 64;
                    dst[permd(d)] = f2bf(o1); dst[permd(d + 32)] = f2bf(o2);
                }
            } else if (n < C3 + 3 * HYW) { const int cc = n - C3 - 2 * HYW; VT[vt_off(b, cc / 64, t, cc % 64)] = f2bf(acc[i]); }
            else GATES[(size_t)tt * 2048 + (n - (C3 + 3 * HYW))] = f2bf(sigmoidf_(acc[i]));
        }
    }
}
__device__ __forceinline__ void nv_attn(const bf16_t* QS, const bf16_t* KS, const bf16_t* VT, bf16_t* OG, float* LSE) {
    VLOOP(NB * NH * L / 256) {
        const int idx = vb * 256 + VT_;
        const int t = idx % L, h = (idx / L) % NH, b = idx / (L * NH);
        const int d = dil_of_head(h), Ls = L / d, r = t % d, m = t / d, g = h >> 2, hh = h & 3;
        const size_t rowbase = (size_t)(b * NH + h) * L + (size_t)r * Ls;
        unsigned q[32];
#pragma unroll
        for (int i = 0; i < 32; ++i) q[i] = ((const unsigned*)(QS + (rowbase + m) * 64))[i];
        float mx = -1e30f;
#pragma unroll 1
        for (int j = -64; j <= 64; ++j) { const int mm = m + j; if (mm < 0 || mm >= Ls) continue;
            const unsigned* kr = (const unsigned*)(KS + (rowbase + mm) * 64);
            float s = 0.f;
#pragma unroll
            for (int i = 0; i < 32; ++i) { const unsigned kv = kr[i]; s += __uint_as_float(q[i] << 16) * __uint_as_float(kv << 16) + __uint_as_float(q[i] & 0xffff0000u) * __uint_as_float(kv & 0xffff0000u); }
            mx = fmaxf(mx, s); }
        const bf16_t* vbp = VT + (size_t)(b * NH + h) * L * 64 + (size_t)(r * 64) * Ls;
        const int tt = b * L + t; float l = 0.f;
#pragma unroll 1
        for (int hf = 0; hf < 4; ++hf) {
            float o[16];
#pragma unroll
            for (int i = 0; i < 16; ++i) o[i] = 0.f;
            l = 0.f;
#pragma unroll 1
            for (int j = -64; j <= 64; ++j) { const int mm = m + j; if (mm < 0 || mm >= Ls) continue;
                const unsigned* kr = (const unsigned*)(KS + (rowbase + mm) * 64);
                float s = 0.f;
#pragma unroll
                for (int i = 0; i < 32; ++i) { const unsigned kv = kr[i]; s += __uint_as_float(q[i] << 16) * __uint_as_float(kv << 16) + __uint_as_float(q[i] & 0xffff0000u) * __uint_as_float(kv & 0xffff0000u); }
                const float pp = exp2f(s - mx); l += pp;
#pragma unroll
                for (int i = 0; i < 16; ++i) o[i] += pp * bf2f(vbp[(size_t)(hf * 16 + i) * Ls + mm]); }
            const float il = 1.f / l;
#pragma unroll
            for (int i = 0; i < 16; ++i) OG[((size_t)g * T + tt) * 256 + hh * 64 + hf * 16 + i] = f2bf(o[i] * il);
        }
        LSE[((size_t)g * T + tt) * 4 + hh] = mx + log2f(l);
    }
}
__device__ __forceinline__ void nv_z(const bf16_t* UT, const float* w_sc, const float* b_sc, float* Z, bf16_t* X0) {
    VLOOP(64 * 768) { const int tt = (vb % 64) * 256 + VT_, c = vb / 64; const int t = tt % L;
        float r[3];
#pragma unroll
        for (int s = 0; s < 3; ++s) { const int ch = s * 768 + c; const bf16_t* u = UT + (size_t)ch * T + tt;
            const float um = t > 0 ? bf2f(u[-1]) : 0.f, u0 = bf2f(u[0]), up = t < L - 1 ? bf2f(u[1]) : 0.f;
            r[s] = um * w_sc[ch] + u0 * w_sc[C3 + ch] + up * w_sc[2 * C3 + ch] + b_sc[ch]; }
        X0[(size_t)c * T + tt] = f2bf(r[0]); Z[(size_t)c * T + tt] = r[2] * r[1]; }
}
__device__ __forceinline__ void nv_conv(const _Float16* filt, const float* Z, const bf16_t* X0, const float* hy_bias, bf16_t* YT, unsigned char* smraw) {
    float* zs = (float*)smraw; float* ks = (float*)(smraw + 1024);
    VLOOP(32 * 768 * NB) {
        const int tx = VT_; const int c = (vb / 32) % 768, b = vb / (32 * 768), t0 = (vb % 32) * 256, t = t0 + tx;
        const float* z = Z + (size_t)c * T + (size_t)b * L; const _Float16* kf = filt + (size_t)c * 16384;
        float acc = 0.f;
        for (int s0 = 0; s0 < L; s0 += 256) {
            __syncthreads();
            zs[tx] = z[s0 + tx];
            const int base = t0 - s0 - 255;
            ks[tx] = (float)kf[(base + tx) & 16383]; ks[tx + 256] = (float)kf[(base + tx + 256) & 16383];
            __syncthreads();
#pragma unroll 8
            for (int i = 0; i < 256; ++i) acc += ks[tx - i + 255] * zs[i];
        }
        const size_t o = (size_t)c * T + (size_t)b * L + t;
        YT[o] = f2bf((acc + z[t] * hy_bias[c]) * bf2f(X0[o]));
    }
}
__device__ __forceinline__ void nv_ycat(const bf16_t* YT, const bf16_t* OG, const float* LSE, bf16_t* YCAT) {
    VLOOP(4 * T) { const int col = (vb % 4) * 256 + VT_; const int tt = vb / 4;
        if (col < 768) { YCAT[(size_t)tt * D + col] = YT[(size_t)col * T + tt]; continue; }
        const int cc = col - 768, hh = cc / 64;
        const float l0 = LSE[((size_t)0 * T + tt) * 4 + hh], l1 = LSE[((size_t)1 * T + tt) * 4 + hh], l2 = LSE[((size_t)2 * T + tt) * 4 + hh];
        const float mx = fmaxf(l0, fmaxf(l1, l2)); const float e0 = exp2f(l0 - mx), e1 = exp2f(l1 - mx), e2 = exp2f(l2 - mx); const float inv = 1.f / (e0 + e1 + e2);
        const float o = e0 * bf2f(OG[((size_t)0 * T + tt) * 256 + cc]) + e1 * bf2f(OG[((size_t)1 * T + tt) * 256 + cc]) + e2 * bf2f(OG[((size_t)2 * T + tt) * 256 + cc]);
        YCAT[(size_t)tt * D + col] = f2bf(o * inv); }
}
__device__ __forceinline__ void nv_merge(const bf16_t* YCAT, const float* w_br_h, const float* w_br_a, const bf16_t* GATES, bf16_t* MERGED) {
    VLOOP(4 * (T / 8)) { const int n = (vb % 4) * 256 + VT_, t0 = (vb / 4) * 8;
        float a1[8], a2[8];
#pragma unroll
        for (int i = 0; i < 8; ++i) { a1[i] = 0.f; a2[i] = 0.f; }
        for (int k = 0; k < 768; ++k) { const float w = w_br_h[(size_t)k * D + n];
#pragma unroll
            for (int i = 0; i < 8; ++i) a1[i] += bf2f(YCAT[(size_t)(t0 + i) * D + k]) * w; }
        for (int k = 0; k < 256; ++k) { const float w = w_br_a[(size_t)k * D + n];
#pragma unroll
            for (int i = 0; i < 8; ++i) a2[i] += bf2f(YCAT[(size_t)(t0 + i) * D + 768 + k]) * w; }
#pragma unroll
        for (int i = 0; i < 8; ++i) { const size_t tt = t0 + i; MERGED[tt * D + n] = f2bf(bf2f(GATES[tt * 2048 + n]) * a1[i] + bf2f(GATES[tt * 2048 + 1024 + n]) * a2[i]); } }
}
__device__ __forceinline__ void nv_out(const bf16_t* MERGED, const float* w_out, const float* mod_l, float* x) {
    VLOOP(4 * (T / 8)) { const int n = (vb % 4) * 256 + VT_, t0 = (vb / 4) * 8;
        float a[8];
#pragma unroll
        for (int i = 0; i < 8; ++i) a[i] = 0.f;
        for (int k = 0; k < D; ++k) { const float w = w_out[(size_t)k * D + n];
#pragma unroll
            for (int i = 0; i < 8; ++i) a[i] += bf2f(MERGED[(size_t)(t0 + i) * D + k]) * w; }
#pragma unroll
        for (int i = 0; i < 8; ++i) { const size_t tt = t0 + i; const int b = (int)(tt / L); x[tt * D + n] += mod_l[b * 6144 + 2 * 1024 + n] * a[i]; } }
}
__device__ __forceinline__ void nv_norm2_route(const float* x, const float* g, const float* mod_l, bf16_t* XN, const float* router_w, const float* router_bias, int* SEL, float* WTS, int* POS) {
    VLOOP(T / 4) {
        const int row = vb * 4 + (VT_ >> 6), lane = VT_ & 63; const int b = row / L;
        float v[16]; float ss = 0.f;
#pragma unroll
        for (int j = 0; j < 4; ++j) { const float4 xv = *(const float4*)(x + (size_t)row * D + j * 256 + lane * 4); v[j * 4] = xv.x; v[j * 4 + 1] = xv.y; v[j * 4 + 2] = xv.z; v[j * 4 + 3] = xv.w; ss += xv.x * xv.x + xv.y * xv.y + xv.z * xv.z + xv.w * xv.w; }
        ss = wave_sum(ss);
        const float rstd = rsqrtf(ss * (1.0f / D) + NORM_EPS);
        float lg[16];
#pragma unroll
        for (int e = 0; e < 16; ++e) lg[e] = 0.f;
#pragma unroll
        for (int j = 0; j < 4; ++j)
#pragma unroll
            for (int i = 0; i < 4; ++i) { const int col = j * 256 + lane * 4 + i;
                const float y = v[j * 4 + i] * rstd * g[col];
                const float h = y * (1.f + mod_l[b * 6144 + 4 * 1024 + col]) + mod_l[b * 6144 + 3 * 1024 + col];
                XN[(size_t)row * D + col] = f2bf(h);
                const float4* rw = (const float4*)(router_w + (size_t)col * 16);
#pragma unroll
                for (int q4 = 0; q4 < 4; ++q4) { const float4 w = rw[q4]; lg[q4 * 4] += h * w.x; lg[q4 * 4 + 1] += h * w.y; lg[q4 * 4 + 2] += h * w.z; lg[q4 * 4 + 3] += h * w.w; } }
#pragma unroll
        for (int e = 0; e < 16; ++e) lg[e] = wave_sum(lg[e]);
        if (lane == 0) {
            float sc[16], bi[16];
#pragma unroll
            for (int e = 0; e < 16; ++e) { sc[e] = 1.f / (1.f + expf(-lg[e])); bi[e] = sc[e] + router_bias[e]; }
            int sel = 0; float best = -1e30f;
#pragma unroll
            for (int gq = 0; gq < 4; ++gq) { float m1 = -1e30f, m2 = -1e30f;
#pragma unroll
                for (int i = 0; i < 4; ++i) { const float vv = bi[gq * 4 + i]; if (vv > m1) { m2 = m1; m1 = vv; } else if (vv > m2) m2 = vv; }
                const float gs = m1 + m2; if (gs > best) { best = gs; sel = gq; } }
            float gv[4], gsc[4];
#pragma unroll
            for (int i = 0; i < 4; ++i) { gv[i] = 0.f; gsc[i] = 0.f; }
#pragma unroll
            for (int gq = 0; gq < 4; ++gq)
#pragma unroll
                for (int i = 0; i < 4; ++i) { if (gq == sel) { gv[i] = bi[gq * 4 + i]; gsc[i] = sc[gq * 4 + i]; } }
            int i1 = 0; float m1 = gv[0];
#pragma unroll
            for (int i = 1; i < 4; ++i) { if (gv[i] > m1) { m1 = gv[i]; i1 = i; } }
            int i2 = 0; float m2 = -1e30f;
#pragma unroll
            for (int i = 0; i < 4; ++i) { if (i != i1 && gv[i] > m2) { m2 = gv[i]; i2 = i; } }
            float s1 = 0.f, s2 = 0.f;
#pragma unroll
            for (int i = 0; i < 4; ++i) { s1 = (i == i1) ? gsc[i] : s1; s2 = (i == i2) ? gsc[i] : s2; }
            const int e1 = sel * 4 + i1, e2 = sel * 4 + i2; const float s = s1 + s2;
            SEL[row * 2] = e1; SEL[row * 2 + 1] = e2; WTS[row * 2] = s1 / s; WTS[row * 2 + 1] = s2 / s;
            POS[row * 2] = row * 2; POS[row * 2 + 1] = row * 2 + 1;
        }
    }
}
__device__ __forceinline__ void nv_moe_up(const bf16_t* XN, const int* SEL, const float* w1, const float* w3, bf16_t* ACT) {
    VLOOP(T * 2) { const int rs = vb; const int tok = rs >> 1; const int e = SEL[rs];
        const float* W1 = w1 + (size_t)e * D * DEXP; const float* W3 = w3 + (size_t)e * D * DEXP;
        const int f = VT_;
        float a1 = 0.f, a3 = 0.f, c1 = 0.f, c3 = 0.f;
        for (int k = 0; k < D; ++k) { const float h = bf2f(XN[(size_t)tok * D + k]); a1 += h * W1[(size_t)k * DEXP + f]; a3 += h * W3[(size_t)k * DEXP + f]; c1 += h * W1[(size_t)k * DEXP + 256 + f]; c3 += h * W3[(size_t)k * DEXP + 256 + f]; }
        ACT[(size_t)rs * DEXP + f] = f2bf(siluf_(a1) * a3); ACT[(size_t)rs * DEXP + 256 + f] = f2bf(siluf_(c1) * c3); }
}
__device__ __forceinline__ void nv_moe_down(const bf16_t* ACT, const int* SEL, const float* w2, bf16_t* YB) {
    VLOOP(T * 2) { const int rs = vb; const int e = SEL[rs];
        const float* W2 = w2 + (size_t)e * DEXP * D;
        float a[4] = {0.f, 0.f, 0.f, 0.f};
        for (int k = 0; k < DEXP; ++k) { const float h = bf2f(ACT[(size_t)rs * DEXP + k]);
#pragma unroll
            for (int j = 0; j < 4; ++j) a[j] += h * W2[(size_t)k * D + j * 256 + VT_]; }
#pragma unroll
        for (int j = 0; j < 4; ++j) YB[(size_t)rs * D + j * 256 + VT_] = f2bf(a[j]); }
}

namespace cg = cooperative_groups;
constexpr int NPHASE = 1 + 11 * DEPTH + 1;
constexpr int MEGA_LDS = 16384;
__global__ void __launch_bounds__(512, 2) mega(P p) {
    extern __shared__ __attribute__((aligned(16))) unsigned char lds[];
    cg::grid_group grid = cg::this_grid();
    unsigned char* ws = p.ws; float* out = p.out;
    float* MOD = (float*)(ws + WS_MOD); float* ROPE = (float*)(ws + WS_ROPE); float* H3 = (float*)(ws + WS_H3);
    int* SEL = (int*)(ws + WS_SEL); float* WTS = (float*)(ws + WS_WTS); int* POS = (int*)(ws + WS_POS);
    _Float16* FILT = (_Float16*)(ws + WS_FILT); bf16_t* XN = (bf16_t*)(ws + WS_XN); bf16_t* UT = (bf16_t*)(ws + WS_UT);
    bf16_t* QS = (bf16_t*)(ws + WS_QS); bf16_t* KS = (bf16_t*)(ws + WS_KS); bf16_t* VT = (bf16_t*)(ws + WS_VT); bf16_t* GATES = (bf16_t*)(ws + WS_GATES);
    bf16_t* YT = (bf16_t*)(ws + WS_YT); bf16_t* OG = (bf16_t*)(ws + WS_OG); float* LSE = (float*)(ws + WS_LSE); bf16_t* YCAT = (bf16_t*)(ws + WS_YCAT);
    bf16_t* MERGED = (bf16_t*)(ws + WS_MERGED); float* Z = (float*)(ws + WS_Z); bf16_t* X0 = (bf16_t*)(ws + WS_X0); bf16_t* ACT = (bf16_t*)(ws + WS_ACT); bf16_t* YB = (bf16_t*)(ws + WS_YB);
    unsigned char* sm = lds + (threadIdx.x >> 8) * (MEGA_LDS / 2);
    int ph = 0;
#define PHASE(body) do { if (ph >= p.ph_lo && ph < p.ph_hi) { body; if (ph + 1 < p.ph_hi) grid.sync(); } ++ph; } while (0)
    PHASE({ nv_mod(p, MOD); nv_rope(p, ROPE); nv_h3(p, H3, sm); });
    for (int l = 0; l < DEPTH; ++l) {
        const float* mod_l = MOD + (size_t)l * NB * 6144;
        PHASE({ nv_filt(H3 + (size_t)l * L * 64, p.hf_w4 + (size_t)l * 64 * 1536, FILT);
                nv_norm(l == 0 ? p.x : out, out, p.norm1_g + l * D, mod_l, XN, l > 0, YB, POS, WTS, l > 0 ? mod_l - NB * 6144 : mod_l); });
        PHASE({ nv_gemm1(XN, p.w_in + (size_t)l * D * INC, ROPE, UT, QS, KS, VT, GATES, sm); });
        PHASE({ nv_attn(QS, KS, VT, OG, LSE); });
        PHASE({ nv_z(UT, p.w_sc + (size_t)l * 3 * C3, p.b_sc + (size_t)l * C3, Z, X0); });
        PHASE({ nv_conv(FILT, Z, X0, p.hy_bias + l * HYW, YT, sm); });
        PHASE({ nv_ycat(YT, OG, LSE, YCAT); });
        PHASE({ nv_merge(YCAT, p.w_br_h + (size_t)l * HYW * D, p.w_br_a + (size_t)l * ATT_OUT * D, GATES, MERGED); });
        PHASE({ nv_out(MERGED, p.w_out + (size_t)l * D * D, mod_l, out); });
        PHASE({ nv_norm2_route(out, p.norm2_g + l * D, mod_l, XN, p.router_w, p.router_bias, SEL, WTS, POS); });
        PHASE({ nv_moe_up(XN, SEL, p.moe_w1 + (size_t)l * NE * D * DEXP, p.moe_w3 + (size_t)l * NE * D * DEXP, ACT); });
        PHASE({ nv_moe_down(ACT, SEL, p.moe_w2 + (size_t)l * NE * DEXP * D, YB); });
    }
    PHASE({ nv_final(out, out, p.final_g, MOD + (size_t)(DEPTH - 1) * NB * 6144, YB, POS, WTS); });
}
}

extern "C" void kernel_launch(void* const* d_in, const int* in_sizes, int n_in, void* d_out, int out_size, void* d_ws, size_t ws_size, hipStream_t stream) {
    if (n_in != 27 || in_sizes[0] != T * D || out_size != T * D || ws_size < WS_END) {
        fprintf(stderr, "kernel_launch: unexpected shapes / workspace (n_in %d, in0 %d, out %d, ws %zu need %zu); nothing launched\n", n_in, n_in > 0 ? in_sizes[0] : -1, out_size, ws_size, (size_t)WS_END);
        return;
    }
    static int grid_blocks = 0;
    if (!grid_blocks) {
        int dev = 0, cus = 0, per_cu = 0;
        (void)hipGetDevice(&dev); (void)hipDeviceGetAttribute(&cus, hipDeviceAttributeMultiprocessorCount, dev);
        (void)hipFuncSetAttribute((const void*)mega, hipFuncAttributeMaxDynamicSharedMemorySize, MEGA_LDS);
        if (hipOccupancyMaxActiveBlocksPerMultiprocessor(&per_cu, (const void*)mega, 512, MEGA_LDS) != hipSuccess || per_cu < 1) per_cu = 1;
        if (per_cu > 2) per_cu = 2;
        grid_blocks = cus * per_cu;
        fprintf(stderr, "kernel_launch: %d CUs x %d blocks\n", cus, per_cu);
    }
    P p{};
    const float** dst = (const float**)&p;
    for (int i = 0; i < 27; ++i) dst[i] = (const float*)d_in[i];
    p.out = (float*)d_out; p.ws = (unsigned char*)d_ws;
    for (int j = 0; j < 32; ++j) p.ri.inv[j] = pow(10000.0, -(double)j / 32.0);
    p.ph_lo = 0; p.ph_hi = NPHASE;
    (void)hipMemsetAsync((unsigned char*)d_ws + WS_CTL, 0, 1 * MiB, stream);
    void* args[] = {&p};
    hipError_t e = hipLaunchCooperativeKernel((const void*)mega, dim3(grid_blocks), dim3(512), args, MEGA_LDS, stream);
    if (e != hipSuccess) fprintf(stderr, "cooperative launch failed: %s (grid %d)\n", hipGetErrorString(e), grid_blocks);
}
```

```cpp
#include <hip/hip_runtime.h>
#include <hip/hip_cooperative_groups.h>
#include <cstdio>
#include <cstdint>
#include <cmath>

typedef unsigned short bf16_t;

namespace {
constexpr int D = 1024, NB = 2, L = 8192, T = NB * L, DEPTH = 2;
constexpr int HYW = 768, C3 = 2304, NH = 12, HD = 64, ATT_OUT = 256, INC = 6656;
constexpr int HY_EMB = 33, HY_FFN = 64;
constexpr int NE = 16, DEXP = 512;
constexpr float NORM_EPS = 1e-6f;
constexpr float QSCALE = 0.125f * 1.4426950408889634f;

constexpr size_t MiB = 1u << 20;
constexpr size_t WS_CTL = 0;
constexpr size_t WS_MOD = 1 * MiB;
constexpr size_t WS_ROPE = 2 * MiB;
constexpr size_t WS_W4T = 4 * MiB;
constexpr size_t WS_H3 = 364 * MiB;
constexpr size_t WS_SEL = 8 * MiB;
constexpr size_t WS_WTS = WS_SEL + 256 * 1024;
constexpr size_t WS_POS = WS_WTS + 256 * 1024;
constexpr size_t WS_RANK = WS_POS + 256 * 1024;
constexpr size_t WS_LIST = 9 * MiB;
constexpr size_t CTL_CNT = 4096;
constexpr size_t WS_FILT = 10 * MiB;
constexpr size_t WS_WA = 34 * MiB;
constexpr size_t WS_WB = 41 * MiB;
constexpr size_t WS_WCAT = 47 * MiB;
constexpr size_t WS_WOUT = 49 * MiB;
constexpr size_t WS_W13 = 51 * MiB;
constexpr size_t WS_W2 = 83 * MiB;
constexpr size_t WS_XN = 99 * MiB;
constexpr size_t WS_UT = 131 * MiB;
constexpr size_t WS_QS = 203 * MiB;
constexpr size_t WS_KS = 227 * MiB;
constexpr size_t WS_VT = 251 * MiB;
constexpr size_t WS_GATES = 275 * MiB;
constexpr size_t WS_OG = 339 * MiB;
constexpr size_t WS_LSE = 363 * MiB;
constexpr size_t WS_END = 372 * MiB;
constexpr size_t WS_YT = WS_XN;
constexpr size_t WS_MERGED = WS_UT;
constexpr size_t WS_Z = WS_QS;
constexpr size_t WS_X0 = WS_VT;
constexpr size_t WS_YCAT = WS_QS;
constexpr size_t WS_ACT = WS_QS;
constexpr size_t WS_YB = WS_UT;

__device__ __forceinline__ float bf2f(bf16_t v) { return __uint_as_float((unsigned)v << 16); }
__device__ __forceinline__ bf16_t f2bf(float f) { unsigned u = __float_as_uint(f); return (bf16_t)((u + 0x7fffu + ((u >> 16) & 1u)) >> 16); }
__device__ __forceinline__ float sigmoidf_(float x) { return 1.f / (1.f + __expf(-x)); }
__device__ __forceinline__ float siluf_(float x) { return x / (1.f + __expf(-x)); }
__host__ __device__ __forceinline__ int dil_of_head(int h) { const int g = h >> 2; return g == 0 ? 1 : (g == 1 ? 4 : 16); }
__device__ __forceinline__ size_t qk_row(int b, int h, int t) { const int d = dil_of_head(h), Ls = L / d; return (size_t)(b * NH + h) * L + (size_t)(t % d) * Ls + (t / d); }
__device__ __forceinline__ size_t vt_off(int b, int h, int t, int dv) { const int d = dil_of_head(h), Ls = L / d; return (size_t)(b * NH + h) * L * 64 + (size_t)((t % d) * 64 + dv) * Ls + (t / d); }
__device__ __forceinline__ int permd(int d) { return d < 32 ? 2 * d : 2 * (d - 32) + 1; }

__device__ __forceinline__ float sin_rev(float r) { r = r - rintf(r); return __builtin_amdgcn_sinf(r); }
__device__ __forceinline__ float cos_rev(float r) { r = r - rintf(r); return __builtin_amdgcn_cosf(r); }
__device__ __forceinline__ float sin_rad(float x) { return sin_rev(x * 0.15915494309189535f); }
struct RopeInv { double inv[32]; };
__device__ __forceinline__ float shx(float v, int o, int lane) { return __int_as_float(__builtin_amdgcn_ds_bpermute((lane ^ o) << 2, __float_as_int(v))); }
__device__ __forceinline__ float wave_sum(float v, int lane) {
#pragma unroll
    for (int o = 1; o < 64; o <<= 1) v += shx(v, o, lane);
    return v;
}


struct P {
    const float *x, *c, *norm1_g, *norm2_g, *w_ada, *b_ada, *w_in, *w_sc, *b_sc, *hf_w1, *hf_b1, *hf_w2, *hf_b2, *hf_w3, *hf_b3, *hf_w4, *hf_freq, *hy_bias,
                *w_br_h, *w_br_a, *w_out, *router_w, *router_bias, *moe_w1, *moe_w3, *moe_w2, *final_g;
    float* out; unsigned char* ws;
    RopeInv ri;
    int ph_lo, ph_hi;
};
typedef const __attribute__((address_space(4))) P& CP;
#define VT_ (tid & 255)
#define VLOOP(NVB) for (int vb = bid * 2 + (tid >> 8); vb < (NVB); vb += (int)gridDim.x * 2)

__device__ __forceinline__ void nv_mod(const int tid, const int bid, CP p, float* mod) {
    VLOOP(96) { const int idx = vb * 256 + VT_;
        const int n = idx % 6144, b = (idx / 6144) % NB, l = idx / (6144 * NB);
        float acc = p.b_ada[l * 6144 + n];
        const float* w = p.w_ada + (size_t)l * 1024 * 6144 + n;
        for (int k = 0; k < 1024; ++k) acc += siluf_(p.c[b * 1024 + k]) * w[(size_t)k * 6144];
        mod[idx] = acc; }
}
__device__ __forceinline__ void nv_rope(const int tid, const int bid, CP p, float* rope) {
    VLOOP(1024) { const int idx = vb * 256 + VT_; const int j = idx % 32, pos = idx / 32;
        double rev = (double)pos * p.ri.inv[j] * 0.15915494309189535; rev -= floor(rev);
        rope[idx * 2] = cos_rev((float)rev); rope[idx * 2 + 1] = sin_rev((float)rev); }
}
__device__ __forceinline__ void nv_h3(const int tid, const int bid, CP p, _Float16* h3, unsigned char* sm) {
    float (*zs)[64] = (float (*)[64])sm; float (*hs)[64] = (float (*)[64])(sm + 1024);
    VLOOP(DEPTH * L / 4) {
        const int wv = VT_ >> 6, j = VT_ & 63;
        const int gi = vb * 4 + wv; const int layer = gi / L, l = gi % L;
        const float tpos = (float)l / (float)(L - 1);
        const float wrev = (float)l / (float)L;
        __syncthreads();
        if (j < HY_EMB) {
            float z;
            if (j == 0) z = tpos;
            else { const int i = (j - 1) % 16; const float f = 1e-4f + (15.0f - 1e-4f) * (float)i / 15.0f; z = (j <= 16) ? cos_rev(f * wrev) : -sin_rev(f * wrev); }
            zs[wv][j] = z;
        }
        __syncthreads();
        const float fr = p.hf_freq[layer * 64 + j];
        float a = p.hf_b1[layer * 64 + j];
        for (int i = 0; i < HY_EMB; ++i) a += zs[wv][i] * p.hf_w1[(layer * HY_EMB + i) * 64 + j];
        float h = sin_rad(fr * a);
        hs[wv][j] = h; __syncthreads();
        a = p.hf_b2[layer * 64 + j];
        for (int i = 0; i < 64; ++i) a += hs[wv][i] * p.hf_w2[(layer * 64 + i) * 64 + j];
        h = sin_rad(fr * a); __syncthreads();
        hs[wv][j] = h; __syncthreads();
        a = p.hf_b3[layer * 64 + j];
        for (int i = 0; i < 64; ++i) a += hs[wv][i] * p.hf_w3[(layer * 64 + i) * 64 + j];
        h = sin_rad(fr * a);
        h3[(size_t)gi * 256 + j] = (_Float16)h; h3[(size_t)gi * 256 + 64 + j] = (_Float16)0.f; h3[(size_t)gi * 256 + 128 + j] = (_Float16)0.f; h3[(size_t)gi * 256 + 192 + j] = (_Float16)0.f;
    }
}
__device__ __forceinline__ void nv_norm(const int tid, const int bid, const float* x_in, float* x_out, const float* g, const float* mod_l, bf16_t* XN, int combine, const bf16_t* YB, const int* POS, const float* WTS, const float* mod_prev) {
    VLOOP(T / 4) {
        const int row = vb * 4 + (VT_ >> 6), lane = VT_ & 63; const int b = row / L;
        float v[16]; float ss = 0.f;
#pragma unroll
        for (int j = 0; j < 4; ++j) {
            const int col = j * 256 + lane * 4;
            const float4 xv = *(const float4*)(x_in + (size_t)row * D + col);
            float t4[4] = {xv.x, xv.y, xv.z, xv.w};
            if (combine) {
                const int p0 = POS[row * 2], p1 = POS[row * 2 + 1]; const float w0 = WTS[row * 2], w1 = WTS[row * 2 + 1];
#pragma unroll
                for (int i = 0; i < 4; ++i) { const float y = w0 * bf2f(YB[(size_t)p0 * D + col + i]) + w1 * bf2f(YB[(size_t)p1 * D + col + i]); t4[i] += mod_prev[b * 6144 + 5 * 1024 + col + i] * y; }
            }
#pragma unroll
            for (int i = 0; i < 4; ++i) { v[j * 4 + i] = t4[i]; ss += t4[i] * t4[i]; }
            *(float4*)(x_out + (size_t)row * D + col) = make_float4(t4[0], t4[1], t4[2], t4[3]);
        }
        ss = wave_sum(ss, lane);
        const float rstd = rsqrtf(ss * (1.0f / D) + NORM_EPS);
#pragma unroll
        for (int j = 0; j < 4; ++j)
#pragma unroll
            for (int i = 0; i < 4; ++i) { const int col = j * 256 + lane * 4 + i;
                const float y = v[j * 4 + i] * rstd * g[col];
                XN[(size_t)row * D + col] = f2bf(y * (1.f + mod_l[b * 6144 + 1024 + col]) + mod_l[b * 6144 + col]); }
    }
}
__device__ __forceinline__ void nv_final(const int tid, const int bid, const float* x_in, float* out, const float* g, const float* mod_l, const bf16_t* YB, const int* POS, const float* WTS) {
    VLOOP(T / 4) {
        const int row = vb * 4 + (VT_ >> 6), lane = VT_ & 63; const int b = row / L;
        float v[16]; float ss = 0.f;
        const int p0 = POS[row * 2], p1 = POS[row * 2 + 1]; const float w0 = WTS[row * 2], w1 = WTS[row * 2 + 1];
#pragma unroll
        for (int j = 0; j < 4; ++j)
#pragma unroll
            for (int i = 0; i < 4; ++i) { const int col = j * 256 + lane * 4 + i;
                const float y = w0 * bf2f(YB[(size_t)p0 * D + col]) + w1 * bf2f(YB[(size_t)p1 * D + col]);
                const float t = x_in[(size_t)row * D + col] + mod_l[b * 6144 + 5 * 1024 + col] * y; v[j * 4 + i] = t; ss += t * t; }
        ss = wave_sum(ss, lane);
        const float rstd = rsqrtf(ss * (1.0f / D) + NORM_EPS);
#pragma unroll
        for (int j = 0; j < 4; ++j)
#pragma unroll
            for (int i = 0; i < 4; ++i) { const int col = j * 256 + lane * 4 + i; out[(size_t)row * D + col] = v[j * 4 + i] * rstd * g[col]; }
    }
}
__device__ __forceinline__ void nv_gemm1(const int tid, const int bid, const bf16_t* XN, const float* w_in, const float* rope, bf16_t* UT, bf16_t* QS, bf16_t* KS, bf16_t* VT, bf16_t* GATES, unsigned char* smraw) {
    float (*sm)[256] = (float (*)[256])smraw;
    VLOOP(26 * (T / 8)) {
        const int tx = VT_; const int n = (vb % 26) * 256 + tx, t0 = (vb / 26) * 8;
        float acc[8];
#pragma unroll
        for (int i = 0; i < 8; ++i) acc[i] = 0.f;
        for (int k = 0; k < D; ++k) { const float w = w_in[(size_t)k * INC + n];
#pragma unroll
            for (int i = 0; i < 8; ++i) acc[i] += bf2f(XN[(size_t)(t0 + i) * D + k]) * w; }
        __syncthreads();
#pragma unroll
        for (int i = 0; i < 8; ++i) sm[i][tx] = acc[i];
        __syncthreads();
#pragma unroll
        for (int i = 0; i < 8; ++i) {
            const int tt = t0 + i, b = tt / L, t = tt % L;
            if (n < C3) UT[(size_t)n * T + tt] = f2bf(acc[i]);
            else if (n < C3 + 2 * HYW) {
                const int isk = n >= C3 + HYW; const int cc = n - C3 - isk * HYW; const int h = cc / 64, d = cc % 64;
                if (d < 32) {
                    const float a = acc[i], bb = sm[i][tx + 32];
                    const float cs = rope[(t * 32 + d) * 2], sn = rope[(t * 32 + d) * 2 + 1];
                    float o1 = a * cs - bb * sn, o2 = bb * cs + a * sn;
                    if (!isk) { o1 *= QSCALE; o2 *= QSCALE; }
                    bf16_t* dst = (isk ? KS : QS) + qk_row(b, h, t) * 64;
                    dst[permd(d)] = f2bf(o1); dst[permd(d + 32)] = f2bf(o2);
                }
            } else if (n < C3 + 3 * HYW) { const int cc = n - C3 - 2 * HYW; VT[vt_off(b, cc / 64, t, cc % 64)] = f2bf(acc[i]); }
            else GATES[(size_t)tt * 2048 + (n - (C3 + 3 * HYW))] = f2bf(sigmoidf_(acc[i]));
        }
    }
}
__device__ __forceinline__ void nv_ycat(const int tid, const int bid, const bf16_t* YT, const bf16_t* OG, const float* LSE, bf16_t* YCAT) {
    VLOOP(4 * T) { const int col = (vb % 4) * 256 + VT_; const int tt = vb / 4;
        if (col < 768) { YCAT[(size_t)tt * D + col] = YT[(size_t)col * T + tt]; continue; }
        const int cc = col - 768, hh = cc / 64;
        const float l0 = LSE[((size_t)0 * T + tt) * 4 + hh], l1 = LSE[((size_t)1 * T + tt) * 4 + hh], l2 = LSE[((size_t)2 * T + tt) * 4 + hh];
        const float mx = fmaxf(l0, fmaxf(l1, l2)); const float e0 = exp2f(l0 - mx), e1 = exp2f(l1 - mx), e2 = exp2f(l2 - mx); const float inv = 1.f / (e0 + e1 + e2);
        const float o = e0 * bf2f(OG[((size_t)0 * T + tt) * 256 + cc]) + e1 * bf2f(OG[((size_t)1 * T + tt) * 256 + cc]) + e2 * bf2f(OG[((size_t)2 * T + tt) * 256 + cc]);
        YCAT[(size_t)tt * D + col] = f2bf(o * inv); }
}
__device__ __forceinline__ void nv_merge(const int tid, const int bid, const bf16_t* YCAT, const float* w_br_h, const float* w_br_a, const bf16_t* GATES, bf16_t* MERGED) {
    VLOOP(4 * (T / 8)) { const int n = (vb % 4) * 256 + VT_, t0 = (vb / 4) * 8;
        float a1[8], a2[8];
#pragma unroll
        for (int i = 0; i < 8; ++i) { a1[i] = 0.f; a2[i] = 0.f; }
        for (int k = 0; k < 768; ++k) { const float w = w_br_h[(size_t)k * D + n];
#pragma unroll
            for (int i = 0; i < 8; ++i) a1[i] += bf2f(YCAT[(size_t)(t0 + i) * D + k]) * w; }
        for (int k = 0; k < 256; ++k) { const float w = w_br_a[(size_t)k * D + n];
#pragma unroll
            for (int i = 0; i < 8; ++i) a2[i] += bf2f(YCAT[(size_t)(t0 + i) * D + 768 + k]) * w; }
#pragma unroll
        for (int i = 0; i < 8; ++i) { const size_t tt = t0 + i; MERGED[tt * D + n] = f2bf(bf2f(GATES[tt * 2048 + n]) * a1[i] + bf2f(GATES[tt * 2048 + 1024 + n]) * a2[i]); } }
}
__device__ __forceinline__ void nv_out(const int tid, const int bid, const bf16_t* MERGED, const float* w_out, const float* mod_l, float* x) {
    VLOOP(4 * (T / 8)) { const int n = (vb % 4) * 256 + VT_, t0 = (vb / 4) * 8;
        float a[8];
#pragma unroll
        for (int i = 0; i < 8; ++i) a[i] = 0.f;
        for (int k = 0; k < D; ++k) { const float w = w_out[(size_t)k * D + n];
#pragma unroll
            for (int i = 0; i < 8; ++i) a[i] += bf2f(MERGED[(size_t)(t0 + i) * D + k]) * w; }
#pragma unroll
        for (int i = 0; i < 8; ++i) { const size_t tt = t0 + i; const int b = (int)(tt / L); x[tt * D + n] += mod_l[b * 6144 + 2 * 1024 + n] * a[i]; } }
}
__device__ __forceinline__ void nv_norm2_route(const int tid, const int bid, const float* x, const float* g, const float* mod_l, bf16_t* XN, const float* router_w, const float* router_bias, int* SEL, float* WTS, int* CNT, int* LIST, int* RANK) {
    VLOOP(T / 4) {
        const int row = vb * 4 + (VT_ >> 6), lane = VT_ & 63; const int b = row / L;
        float v[16]; float ss = 0.f;
#pragma unroll
        for (int j = 0; j < 4; ++j) { const float4 xv = *(const float4*)(x + (size_t)row * D + j * 256 + lane * 4); v[j * 4] = xv.x; v[j * 4 + 1] = xv.y; v[j * 4 + 2] = xv.z; v[j * 4 + 3] = xv.w; ss += xv.x * xv.x + xv.y * xv.y + xv.z * xv.z + xv.w * xv.w; }
        ss = wave_sum(ss, lane);
        const float rstd = rsqrtf(ss * (1.0f / D) + NORM_EPS);
        float lg[16];
#pragma unroll
        for (int e = 0; e < 16; ++e) lg[e] = 0.f;
#pragma unroll
        for (int j = 0; j < 4; ++j)
#pragma unroll
            for (int i = 0; i < 4; ++i) { const int col = j * 256 + lane * 4 + i;
                const float y = v[j * 4 + i] * rstd * g[col];
                const float h = y * (1.f + mod_l[b * 6144 + 4 * 1024 + col]) + mod_l[b * 6144 + 3 * 1024 + col];
                XN[(size_t)row * D + col] = f2bf(h);
                const float4* rw = (const float4*)(router_w + (size_t)col * 16);
#pragma unroll
                for (int q4 = 0; q4 < 4; ++q4) { const float4 w = rw[q4]; lg[q4 * 4] += h * w.x; lg[q4 * 4 + 1] += h * w.y; lg[q4 * 4 + 2] += h * w.z; lg[q4 * 4 + 3] += h * w.w; } }
#pragma unroll
        for (int e = 0; e < 16; ++e) lg[e] = wave_sum(lg[e], lane);
        if (lane == 0) {
            float sc[16], bi[16];
#pragma unroll
            for (int e = 0; e < 16; ++e) { sc[e] = 1.f / (1.f + expf(-lg[e])); bi[e] = sc[e] + router_bias[e]; }
            int sel = 0; float best = -1e30f;
#pragma unroll
            for (int gq = 0; gq < 4; ++gq) { float m1 = -1e30f, m2 = -1e30f;
#pragma unroll
                for (int i = 0; i < 4; ++i) { const float vv = bi[gq * 4 + i]; if (vv > m1) { m2 = m1; m1 = vv; } else if (vv > m2) m2 = vv; }
                const float gs = m1 + m2; if (gs > best) { best = gs; sel = gq; } }
            float gv[4], gsc[4];
#pragma unroll
            for (int i = 0; i < 4; ++i) { gv[i] = 0.f; gsc[i] = 0.f; }
#pragma unroll
            for (int gq = 0; gq < 4; ++gq)
#pragma unroll
                for (int i = 0; i < 4; ++i) { if (gq == sel) { gv[i] = bi[gq * 4 + i]; gsc[i] = sc[gq * 4 + i]; } }
            int i1 = 0; float m1 = gv[0];
#pragma unroll
            for (int i = 1; i < 4; ++i) { if (gv[i] > m1) { m1 = gv[i]; i1 = i; } }
            int i2 = 0; float m2 = -1e30f;
#pragma unroll
            for (int i = 0; i < 4; ++i) { if (i != i1 && gv[i] > m2) { m2 = gv[i]; i2 = i; } }
            float s1 = 0.f, s2 = 0.f;
#pragma unroll
            for (int i = 0; i < 4; ++i) { s1 = (i == i1) ? gsc[i] : s1; s2 = (i == i2) ? gsc[i] : s2; }
            const int e1 = sel * 4 + i1, e2 = sel * 4 + i2; const float s = s1 + s2;
            SEL[row * 2] = e1; SEL[row * 2 + 1] = e2; WTS[row * 2] = s1 / s; WTS[row * 2 + 1] = s2 / s;
            const int r1 = atomicAdd(CNT + e1, 1), r2 = atomicAdd(CNT + e2, 1);
            LIST[e1 * 16384 + r1] = row; LIST[e2 * 16384 + r2] = row; RANK[row * 2] = r1; RANK[row * 2 + 1] = r2;
        }
    }
}
__device__ __forceinline__ void nv_moe_up(const int tid, const int bid, const bf16_t* XN, const int* SEL, const float* w1, const float* w3, bf16_t* ACT) {
    VLOOP(T * 2) { const int rs = vb; const int tok = rs >> 1; const int e = SEL[rs];
        const float* W1 = w1 + (size_t)e * D * DEXP; const float* W3 = w3 + (size_t)e * D * DEXP;
        const int f = VT_;
        float a1 = 0.f, a3 = 0.f, c1 = 0.f, c3 = 0.f;
        for (int k = 0; k < D; ++k) { const float h = bf2f(XN[(size_t)tok * D + k]); a1 += h * W1[(size_t)k * DEXP + f]; a3 += h * W3[(size_t)k * DEXP + f]; c1 += h * W1[(size_t)k * DEXP + 256 + f]; c3 += h * W3[(size_t)k * DEXP + 256 + f]; }
        ACT[(size_t)rs * DEXP + f] = f2bf(siluf_(a1) * a3); ACT[(size_t)rs * DEXP + 256 + f] = f2bf(siluf_(c1) * c3); }
}
__device__ __forceinline__ void nv_moe_down(const int tid, const int bid, const bf16_t* ACT, const int* SEL, const float* w2, bf16_t* YB) {
    VLOOP(T * 2) { const int rs = vb; const int e = SEL[rs];
        const float* W2 = w2 + (size_t)e * DEXP * D;
        float a[4] = {0.f, 0.f, 0.f, 0.f};
        for (int k = 0; k < DEXP; ++k) { const float h = bf2f(ACT[(size_t)rs * DEXP + k]);
#pragma unroll
            for (int j = 0; j < 4; ++j) a[j] += h * W2[(size_t)k * D + j * 256 + VT_]; }
#pragma unroll
        for (int j = 0; j < 4; ++j) YB[(size_t)rs * D + j * 256 + VT_] = f2bf(a[j]); }
}

namespace pg8 {
#define PG8_LAS __attribute__((address_space(3)))
typedef unsigned short bf16_t;
typedef short bf16x8 __attribute__((ext_vector_type(8)));
typedef float f32x4 __attribute__((ext_vector_type(4)));
typedef unsigned u32x4 __attribute__((ext_vector_type(4)));
constexpr int BM = 256, BK = 64, HALF = 128, HTB = HALF * BK * 2  , STAGE_BYTES = 8 * HTB, NXCD = 8, WGM = 8;

__host__ __device__ __forceinline__ int lds_byte(int r, int c) { const int st = (r >> 4) * 2 + (c >> 5), rr = r & 15, cc = c & 31, ob = rr * 64 + cc * 2; return st * 1024 + (ob ^ (((ob >> 9) & 1) << 5)); }
__host__ __device__ __forceinline__ void stage_rc(int b, int& R, int& C) { const int st = b / 1024, sb = b % 1024, swz = sb ^ (((sb >> 9) & 1) << 5); R = (st >> 1) * 16 + swz / 64; C = (st & 1) * 32 + (swz % 64) / 2; }
__host__ __device__ __forceinline__ int perm32(int rho) { const int n = rho >> 4, i = rho & 15; return 8 * (i >> 2) + 4 * n + (i & 3); }

struct Unit { int pm, pn, kind, nvalid; const char* A; const char* B; const int* rows; };
__device__ __forceinline__ void tile_of(int wgid, int nM, int nN, int& pm, int& pn) {
    const int nwg = nM * nN;
    { const int q = nwg / NXCD, r = nwg % NXCD, xcd = wgid % NXCD, off = wgid / NXCD; wgid = (xcd < r ? xcd * (q + 1) : r * (q + 1) + (xcd - r) * q) + off; }
    const int nig = WGM * nN, gid = wgid / nig, fm = gid * WGM, gsz = (nM - fm) < WGM ? (nM - fm) : WGM;
    pm = __builtin_amdgcn_readfirstlane(fm + ((wgid % nig) % gsz)); pn = __builtin_amdgcn_readfirstlane((wgid % nig) / gsz);
}
typedef _Float16 f16x8 __attribute__((ext_vector_type(8)));
template <bool F16> __device__ __forceinline__ f32x4 mma16(bf16x8 a, bf16x8 b, f32x4 c) {
    if constexpr (F16) return __builtin_amdgcn_mfma_f32_16x16x32_f16(__builtin_bit_cast(f16x8, a), __builtin_bit_cast(f16x8, b), c, 0, 0, 0);
    else return __builtin_amdgcn_mfma_f32_16x16x32_bf16(a, b, c, 0, 0, 0);
}
__device__ __forceinline__ unsigned cvt_pk_bf16(float lo, float hi) { unsigned r; asm volatile("v_cvt_pk_bf16_f32 %0, %1, %2" : "=v"(r) : "v"(lo), "v"(hi)); return r; }
template <class Epi, class Sched, bool ALIGN_EPI = false, bool SP2 = false, bool GATHER = false, bool F16 = false>
__device__ __forceinline__ void gemm_phase(const int tid, PG8_LAS unsigned char* lds, const int K, const Sched& S, const Epi& E) {
    const int wid = __builtin_amdgcn_readfirstlane(tid >> 6), lane = tid & 63, wr = wid >> 2, wc = wid & 3, fr = lane & 15, fq = lane >> 4;
    const int nt = K / BK;
    unsigned voffA[2], voffB[2];
#pragma unroll
    for (int i = 0; i < 2; ++i) { int R, C; stage_rc(tid * 16 + i * 8192, R, C); const int Rb = Epi::PERM ? ((R & ~31) + perm32(R & 31)) : R;
        voffA[i] = (unsigned)(R * K + C) * 2u; voffB[i] = (unsigned)(Rb * K + C) * 2u; }
    const size_t kstep = (size_t)(BK * 2);
    const size_t hstep = (size_t)HALF * K * 2;
    const unsigned ldsw = (unsigned)wid * 1024u;
    const int aoff = lds_byte(wr * 64 + fr, fq * 8), boff = lds_byte(wc * 32 + fr, fq * 8);
#define PG8_SA(b, h) (((b) * 2 + (h)) * HTB)
#define PG8_SB(b, h) ((4 + (b) * 2 + (h)) * HTB)
#define PG8_STAGE(bufoff, gbase, voff) do { _Pragma("unroll") for (int _i = 0; _i < 2; ++_i) \
        __builtin_amdgcn_global_load_lds((const unsigned*)((const char*)(gbase) + (voff)[_i]), (PG8_LAS unsigned*)(lds + (bufoff) + ldsw + _i * 8192), 16, 0, 0); } while (0)
#define PG8_STAGEA(bufoff, gbase, h, VG) do { if constexpr (GATHER) { PG8_STAGE(bufoff, gbase, VG[h]); } else { PG8_STAGE(bufoff, (gbase) + (h) * hstep, voffA); } } while (0)
#define PG8_LDA(dst, b, h) do { _Pragma("unroll") for (int m = 0; m < 4; ++m) _Pragma("unroll") for (int k = 0; k < 2; ++k) dst[m][k] = *(const PG8_LAS bf16x8*)(lds + PG8_SA(b, h) + aoff + m * 2048 + k * 1024); } while (0)
#define PG8_LDB(dst, b, h) do { _Pragma("unroll") for (int n = 0; n < 2; ++n) _Pragma("unroll") for (int k = 0; k < 2; ++k) dst[n][k] = *(const PG8_LAS bf16x8*)(lds + PG8_SB(b, h) + boff + n * 2048 + k * 1024); } while (0)
#define PG8_MMA(ai, bj, At, Bt) do { __builtin_amdgcn_s_setprio(1); _Pragma("unroll") for (int m = 0; m < 4; ++m) _Pragma("unroll") for (int n = 0; n < 2; ++n) _Pragma("unroll") for (int k = 0; k < 2; ++k) \
        acc[ai][bj][m][n] = mma16<F16>(Bt[n][k], At[m][k], acc[ai][bj][m][n]); __builtin_amdgcn_s_setprio(0); } while (0)
#define PG8_WAIT_V(n) asm volatile("s_waitcnt vmcnt(" #n ")" ::: "memory")
#define PG8_WAIT_L(n) asm volatile("s_waitcnt lgkmcnt(" #n ")" ::: "memory")
#define PG8_BAR __builtin_amdgcn_s_barrier()
#define PG8_SCHED __builtin_amdgcn_sched_barrier(0)
    Unit cur, nxt; int ui = 0;
    if (!S.next(0, cur)) return;
    unsigned vgc[2][2] = {{0u, 0u}, {0u, 0u}}, vgn[2][2] = {{0u, 0u}, {0u, 0u}}, vga[2][2] = {{0u, 0u}, {0u, 0u}}; int Rg[2], Cg[2];
#pragma unroll
    for (int i = 0; i < 2; ++i) stage_rc(tid * 16 + i * 8192, Rg[i], Cg[i]);
#define PG8_LOADVG(dst, U) do { _Pragma("unroll") for (int h_ = 0; h_ < 2; ++h_) _Pragma("unroll") for (int i_ = 0; i_ < 2; ++i_) { const int r_ = h_ * HALF + Rg[i_]; const int tk_ = r_ < (U).nvalid ? (U).rows[r_] : 0; dst[h_][i_] = (unsigned)tk_ * (unsigned)(K * 2) + (unsigned)(Cg[i_] * 2); } } while (0)
    if constexpr (GATHER) PG8_LOADVG(vgc, cur);
    f32x4 acc[2][2][4][2];
#pragma unroll
    for (int a = 0; a < 2; ++a)
#pragma unroll
        for (int b = 0; b < 2; ++b)
#pragma unroll
            for (int m = 0; m < 4; ++m)
#pragma unroll
                for (int n = 0; n < 2; ++n) acc[a][b][m][n] = (f32x4){0.f, 0.f, 0.f, 0.f};
    bf16x8 At[4][2], B0[2][2], B1[2][2];
    const char* cA = cur.A; const char* cB = cur.B;
    S.a_ready(cur);
    if constexpr (SP2) {
        PG8_STAGE(PG8_SB(0, 0), cB, voffB); PG8_STAGE(PG8_SB(0, 1), cB + hstep, voffB); PG8_STAGEA(PG8_SA(0, 0), cA, 0, vgc); PG8_STAGEA(PG8_SA(0, 1), cA, 1, vgc);
        if (wr == 1) PG8_BAR;
        PG8_WAIT_V(2); PG8_BAR;
        PG8_STAGE(PG8_SB(1, 0), cB + kstep, voffB); PG8_STAGEA(PG8_SA(1, 0), cA + kstep, 0, vgc); PG8_STAGE(PG8_SB(1, 1), cB + hstep + kstep, voffB);
        PG8_WAIT_V(6); PG8_BAR;
    } else {
        PG8_STAGE(PG8_SB(0, 0), cB, voffB); PG8_STAGEA(PG8_SA(0, 0), cA, 0, vgc); PG8_STAGE(PG8_SB(0, 1), cB + hstep, voffB); PG8_STAGEA(PG8_SA(0, 1), cA, 1, vgc);
        if (wr == 1) PG8_BAR;
        PG8_WAIT_V(4); PG8_BAR;
        PG8_STAGE(PG8_SB(1, 0), cB + kstep, voffB); PG8_STAGEA(PG8_SA(1, 0), cA + kstep, 0, vgc); PG8_STAGE(PG8_SB(1, 1), cB + hstep + kstep, voffB);
        PG8_WAIT_V(6); PG8_BAR;
    }
    for (;;) {
        const bool has_next = S.next(ui + 1, nxt);
        const char* nA = has_next ? nxt.A : cA; const char* nB = has_next ? nxt.B : cB;
        if constexpr (GATHER) { if (has_next) PG8_LOADVG(vgn, nxt); }
        for (int t = 0; t < nt; t += 2) {
            if constexpr (Epi::MIDK > 0) { if (t == Epi::MIDK) { int ln_; asm volatile("v_mbcnt_lo_u32_b32 %0, -1, 0\n\tv_mbcnt_hi_u32_b32 %0, -1, %0" : "=v"(ln_)); E.mid(acc, cur, wr, wc, ln_ & 15, ln_ >> 4); } }
            const bool last = (t == nt - 2);
            if constexpr (GATHER) { _Pragma("unroll") for (int h_ = 0; h_ < 2; ++h_) _Pragma("unroll") for (int i_ = 0; i_ < 2; ++i_) vga[h_][i_] = (last && has_next) ? vgn[h_][i_] : vgc[h_][i_]; }
            const char* a1 = cA + (size_t)(t + 1) * kstep;
            const char* a2 = last ? nA : cA + (size_t)(t + 2) * kstep; const char* b2 = last ? nB : cB + (size_t)(t + 2) * kstep;
            const char* a3 = a2 + kstep; const char* b3 = b2 + kstep;
            if (last && has_next) S.a_ready(nxt);
            if constexpr (SP2) {
            PG8_LDB(B0, 0, 0); PG8_LDB(B1, 0, 1); PG8_SCHED; PG8_LDA(At, 0, 0); PG8_STAGEA(PG8_SA(1, 1), a1, 1, vgc);
            PG8_WAIT_V(8); PG8_WAIT_L(0); PG8_BAR; PG8_MMA(0, 0, At, B0); PG8_MMA(0, 1, At, B1); PG8_BAR; PG8_SCHED;
            PG8_LDA(At, 0, 1); PG8_STAGE(PG8_SB(0, 0), b2, voffB); PG8_STAGE(PG8_SB(0, 1), b2 + hstep, voffB); PG8_STAGEA(PG8_SA(0, 0), a2, 0, vga);
            PG8_WAIT_V(8); PG8_WAIT_L(0); PG8_BAR; PG8_MMA(1, 0, At, B0); PG8_MMA(1, 1, At, B1); PG8_BAR; PG8_SCHED;
            PG8_LDB(B0, 1, 0); PG8_LDB(B1, 1, 1); PG8_SCHED; PG8_LDA(At, 1, 0); PG8_STAGEA(PG8_SA(0, 1), a2, 1, vga);
            PG8_WAIT_V(8); PG8_WAIT_L(0); PG8_BAR; PG8_MMA(0, 0, At, B0); PG8_MMA(0, 1, At, B1); PG8_BAR; PG8_SCHED;
            PG8_LDA(At, 1, 1); PG8_STAGE(PG8_SB(1, 0), b3, voffB); PG8_STAGE(PG8_SB(1, 1), b3 + hstep, voffB); PG8_STAGEA(PG8_SA(1, 0), a3, 0, vga);
            PG8_WAIT_V(8); PG8_WAIT_L(0); PG8_BAR; PG8_MMA(1, 0, At, B0); PG8_MMA(1, 1, At, B1); PG8_BAR; PG8_SCHED;
            } else {
            PG8_LDB(B0, 0, 0); PG8_SCHED; PG8_LDA(At, 0, 0); PG8_STAGEA(PG8_SA(1, 1), a1, 1, vgc);
            PG8_WAIT_L(8); PG8_BAR; PG8_WAIT_L(0); PG8_MMA(0, 0, At, B0); PG8_BAR; PG8_SCHED;
            PG8_LDB(B1, 0, 1); PG8_STAGE(PG8_SB(0, 0), b2, voffB);
            PG8_BAR; PG8_WAIT_L(0); PG8_MMA(0, 1, At, B1); PG8_BAR;
            PG8_LDA(At, 0, 1); PG8_STAGEA(PG8_SA(0, 0), a2, 0, vga);
            PG8_BAR; PG8_WAIT_L(0); PG8_MMA(1, 0, At, B0); PG8_BAR; PG8_SCHED;
            PG8_STAGE(PG8_SB(0, 1), b2 + hstep, voffB);
            PG8_WAIT_V(6); PG8_BAR; PG8_MMA(1, 1, At, B1); PG8_BAR;
            PG8_LDB(B0, 1, 0); PG8_SCHED; PG8_LDA(At, 1, 0); PG8_STAGEA(PG8_SA(0, 1), a2, 1, vga);
            PG8_WAIT_L(8); PG8_BAR; PG8_WAIT_L(0); PG8_MMA(0, 0, At, B0); PG8_BAR; PG8_SCHED;
            PG8_LDB(B1, 1, 1); PG8_STAGE(PG8_SB(1, 0), b3, voffB);
            PG8_BAR; PG8_WAIT_L(0); PG8_MMA(0, 1, At, B1); PG8_BAR;
            PG8_LDA(At, 1, 1); PG8_STAGEA(PG8_SA(1, 0), a3, 0, vga);
            PG8_BAR; PG8_WAIT_L(0); PG8_MMA(1, 0, At, B0); PG8_BAR; PG8_SCHED;
            PG8_STAGE(PG8_SB(1, 1), b3 + hstep, voffB);
            PG8_WAIT_V(6); PG8_BAR; PG8_MMA(1, 1, At, B1); PG8_BAR;
            }
        }
        if constexpr (ALIGN_EPI) { if (wr == 0) PG8_BAR; }
        if constexpr (!Epi::AFTER_DRAIN) { int ln_; asm volatile("v_mbcnt_lo_u32_b32 %0, -1, 0\n\tv_mbcnt_hi_u32_b32 %0, -1, %0" : "=v"(ln_)); E(acc, cur, wr, wc, ln_ & 15, ln_ >> 4); S.done(cur); }
        if (!has_next) break;
#pragma unroll
        for (int a = 0; a < 2; ++a)
#pragma unroll
            for (int b = 0; b < 2; ++b)
#pragma unroll
                for (int m = 0; m < 4; ++m)
#pragma unroll
                    for (int n = 0; n < 2; ++n) acc[a][b][m][n] = (f32x4){0.f, 0.f, 0.f, 0.f};
        cur = nxt; cA = nA; cB = nB; ++ui;
        if constexpr (GATHER) { _Pragma("unroll") for (int h_ = 0; h_ < 2; ++h_) _Pragma("unroll") for (int i_ = 0; i_ < 2; ++i_) vgc[h_][i_] = vgn[h_][i_]; }
        if constexpr (ALIGN_EPI) { if (wr == 1) PG8_BAR; }
    }
    PG8_WAIT_V(0);
    if constexpr (!ALIGN_EPI) { if (wr == 0) PG8_BAR; }
    PG8_BAR;
    if constexpr (Epi::AFTER_DRAIN) { E.fused(acc, cur, wr, wc, fr, fq, lds, wid, lane); S.done(cur); }
#undef PG8_SA
#undef PG8_STAGEA
#undef PG8_LOADVG
#undef PG8_SB
#undef PG8_STAGE
#undef PG8_LDA
#undef PG8_LDB
#undef PG8_MMA
#undef PG8_WAIT_V
#undef PG8_WAIT_L
#undef PG8_BAR
#undef PG8_SCHED
}
}

#define LAS __attribute__((address_space(3)))
using pg8::f32x4; using pg8::u32x4; using pg8::Unit;
__device__ __forceinline__ u32x4 pack8(const f32x4 a, const f32x4 b) { u32x4 w; w.x = pg8::cvt_pk_bf16(a[0], a[1]); w.y = pg8::cvt_pk_bf16(a[2], a[3]); w.z = pg8::cvt_pk_bf16(b[0], b[1]); w.w = pg8::cvt_pk_bf16(b[2], b[3]); return w; }
__device__ __forceinline__ float bflo(unsigned x) { return __uint_as_float(x << 16); }
__device__ __forceinline__ float bfhi(unsigned x) { return __uint_as_float(x & 0xffff0000u); }

__device__ __forceinline__ void cvt_item(const float* W, int ldw, int ncol0, bf16_t* WT, int ldk, int koff, int rowmap, int rowbase, int nblk, int item, LAS float* scr, int lane) {
    const int kb = item / nblk, nb = item % nblk, k0 = 64 * kb, n0 = 32 * nb;
#pragma unroll 8
    for (int i = 0; i < 32; ++i) { const int kk = 2 * i + (lane >> 5); scr[kk * 33 + (lane & 31)] = W[(size_t)(k0 + kk) * ldw + ncol0 + n0 + (lane & 31)]; }
    asm volatile("s_waitcnt lgkmcnt(0)" ::: "memory");
    const int c = lane & 7;
#pragma unroll
    for (int j = 0; j < 4; ++j) { const int n = (lane >> 3) + 8 * j; const LAS float* s = scr + (8 * c) * 33 + n; const int nrel = n0 + n;
        const int row = rowbase + (rowmap == 0 ? nrel : (rowmap == 1 ? ((nrel & ~63) + permd(nrel & 63)) : ((nrel >> 7) * 256 + (nrel & 127))));
        u32x4 o; o.x = pg8::cvt_pk_bf16(s[0 * 33], s[1 * 33]); o.y = pg8::cvt_pk_bf16(s[2 * 33], s[3 * 33]); o.z = pg8::cvt_pk_bf16(s[4 * 33], s[5 * 33]); o.w = pg8::cvt_pk_bf16(s[6 * 33], s[7 * 33]);
        *(u32x4*)(WT + (size_t)row * ldk + koff + k0 + 8 * c) = o; }
    asm volatile("s_waitcnt lgkmcnt(0)" ::: "memory");
}
__device__ __forceinline__ void ph_convert(const int tid, const int bid, CP p, int layer, unsigned char* ws, LAS unsigned char* lds) {
    const int lane = tid & 63, wave = tid >> 6;
    LAS float* scr = (LAS float*)(lds + wave * 8704);
    const float* w_in = p.w_in + (size_t)layer * D * INC;
    bf16_t* WA = (bf16_t*)(ws + WS_WA); bf16_t* WB = (bf16_t*)(ws + WS_WB); bf16_t* WCAT = (bf16_t*)(ws + WS_WCAT); bf16_t* WOUT = (bf16_t*)(ws + WS_WOUT);
    bf16_t* W13 = (bf16_t*)(ws + WS_W13); bf16_t* W2 = (bf16_t*)(ws + WS_W2);
    const int gw = bid * 8 + wave, NGW = gridDim.x * 8;
    for (int it = gw; it < 16640; it += NGW) {
        int r = it;
        if (r < 768) { cvt_item(w_in, INC, 2304, WA, 1024, 0, 1, 0, 48, r, scr, lane); continue; } r -= 768;
        if (r < 1024) { cvt_item(w_in, INC, 4608, WA, 1024, 0, 0, 1536, 64, r, scr, lane); continue; } r -= 1024;
        if (r < 1152) { cvt_item(w_in, INC, 0, WB, 1024, 0, 0, 0, 72, r, scr, lane); continue; } r -= 1152;
        if (r < 384) { cvt_item(w_in, INC, 3840, WB, 1024, 0, 0, 2304, 24, r, scr, lane); continue; } r -= 384;
        if (r < 384) { cvt_item(p.w_br_h + (size_t)layer * HYW * D, D, 0, WCAT, 1024, 0, 0, 0, 32, r, scr, lane); continue; } r -= 384;
        if (r < 128) { cvt_item(p.w_br_a + (size_t)layer * ATT_OUT * D, D, 0, WCAT, 1024, 768, 0, 0, 32, r, scr, lane); continue; } r -= 128;
        if (r < 512) { cvt_item(p.w_out + (size_t)layer * D * D, D, 0, WOUT, 1024, 0, 0, 0, 32, r, scr, lane); continue; } r -= 512;
        const int e = r / 768; r -= e * 768;
        if (r < 256) cvt_item(p.moe_w1 + ((size_t)layer * NE + e) * D * DEXP, DEXP, 0, W13 + (size_t)e * 1024 * 1024, 1024, 0, 2, 0, 16, r, scr, lane);
        else if (r < 512) cvt_item(p.moe_w3 + ((size_t)layer * NE + e) * D * DEXP, DEXP, 0, W13 + (size_t)e * 1024 * 1024, 1024, 0, 2, 128, 16, r - 256, scr, lane);
        else cvt_item(p.moe_w2 + ((size_t)layer * NE + e) * DEXP * D, D, 0, W2 + (size_t)e * 1024 * 512, 512, 0, 0, 0, 32, r - 512, scr, lane);
    }
}

struct SchedG1 {
    const char *XN, *WA, *WB; int G, c;
    __device__ __forceinline__ bool next(int i, Unit& u) const {
        const int id = i * G + c; if (id >= 1664) return false;
        if (id < 896) { pg8::tile_of(id, 64, 14, u.pm, u.pn); u.kind = 0; u.A = XN + (size_t)u.pm * 524288; u.B = WA + (size_t)u.pn * 524288; }
        else { pg8::tile_of(id - 896, 12, 64, u.pm, u.pn); u.kind = 1; u.A = WB + (size_t)u.pm * 524288; u.B = XN + (size_t)u.pn * 524288; }
        return true;
    }
    __device__ __forceinline__ void a_ready(const Unit&) const {}
    __device__ __forceinline__ void done(const Unit&) const {}
};
struct SchedDense {
    const char *A, *B; int nM, nN, G, c; size_t tstep;
    __device__ __forceinline__ bool next(int i, Unit& u) const {
        const int id = i * G + c; if (id >= nM * nN) return false;
        pg8::tile_of(id, nM, nN, u.pm, u.pn); u.kind = 0; u.A = A + (size_t)u.pm * tstep; u.B = B + (size_t)u.pn * tstep; return true;
    }
    __device__ __forceinline__ void a_ready(const Unit&) const {}
    __device__ __forceinline__ void done(const Unit&) const {}
};
struct EpiG1 {
    static constexpr bool PERM = true, AFTER_DRAIN = false; static constexpr int MIDK = 0;
    unsigned char* ws;
    __device__ __forceinline__ void mid(f32x4 (&)[2][2][4][2], const Unit&, int, int, int, int) const {}
    __device__ __forceinline__ void operator()(const f32x4 (&acc)[2][2][4][2], const Unit& u, int wr, int wc, int fr, int fq) const {
        asm volatile("" : "+v"(fr), "+v"(fq));
        unsigned wlo_ = __builtin_amdgcn_readfirstlane((unsigned)(uintptr_t)ws), whi_ = __builtin_amdgcn_readfirstlane((unsigned)((uintptr_t)ws >> 32)); asm volatile("" : "+s"(wlo_), "+s"(whi_));
        unsigned char* w_ = (unsigned char*)(((uintptr_t)whi_ << 32) | wlo_);
        bf16_t *UT = (bf16_t*)(w_ + WS_UT), *QS = (bf16_t*)(w_ + WS_QS), *KS = (bf16_t*)(w_ + WS_KS), *VT = (bf16_t*)(w_ + WS_VT), *GATES = (bf16_t*)(w_ + WS_GATES); const float* rope = (const float*)(w_ + WS_ROPE);
        if (u.kind == 1) {
#pragma unroll
            for (int ai = 0; ai < 2; ++ai)
#pragma unroll
                for (int m = 0; m < 4; ++m) { const int row = u.pm * 256 + ai * 128 + wr * 64 + m * 16 + fr;
#pragma unroll
                    for (int bj = 0; bj < 2; ++bj) { const int tok0 = u.pn * 256 + bj * 128 + wc * 32 + 8 * fq;
                        const u32x4 w = pack8(acc[ai][bj][m][0], acc[ai][bj][m][1]);
                        if (u.pm < 9) *(u32x4*)(UT + (size_t)row * T + tok0) = w;
                        else { const int cc = row - 2304, h = cc >> 6, dv = cc & 63, b = tok0 >> 13, t0 = tok0 & 8191; bf16_t* base = VT + (size_t)(b * NH + h) * L * 64;
                            if (u.pm == 9) *(u32x4*)(base + (size_t)dv * L + t0) = w;
                            else if (u.pm == 10) { const int m0 = t0 >> 2;
#pragma unroll
                                for (int r = 0; r < 4; ++r) { const unsigned lo = (r & 1) ? (w[r >> 1] >> 16) : (w[r >> 1] & 0xffffu), hi = (r & 1) ? (w[(r >> 1) + 2] >> 16) : (w[(r >> 1) + 2] & 0xffffu);
                                    *(unsigned*)(base + (size_t)(r * 64 + dv) * 2048 + m0) = lo | (hi << 16); } }
                            else { const int r0 = t0 & 15, mm = t0 >> 4;
#pragma unroll
                                for (int i = 0; i < 8; ++i) base[(size_t)((r0 + i) * 64 + dv) * 512 + mm] = (bf16_t)((i & 1) ? (w[i >> 1] >> 16) : (w[i >> 1] & 0xffffu)); } } }
                    asm volatile("" ::: "memory"); }
        } else {
            const int colt = u.pn * 256;
#pragma unroll
            for (int ai = 0; ai < 2; ++ai)
#pragma unroll
                for (int m = 0; m < 4; ++m) { const int tok = u.pm * 256 + ai * 128 + wr * 64 + m * 16 + fr; const int b = tok >> 13, t = tok & 8191;
#pragma unroll
                    for (int bj = 0; bj < 2; ++bj) { const int c0 = colt + bj * 128 + wc * 32 + 8 * fq;
                        const f32x4 v0 = acc[ai][bj][m][0], v1 = acc[ai][bj][m][1];
                        if (colt < 1536) {
                            const int isk = colt >= 768; const int cc = c0 - isk * 768, h = cc >> 6, pc = cc & 63, j0 = pc >> 1;
                            const f32x4 r0 = *(const f32x4*)(rope + ((size_t)t * 32 + j0) * 2), r1 = *(const f32x4*)(rope + ((size_t)t * 32 + j0 + 2) * 2);
                            f32x4 o0, o1;
                            o0[0] = v0[0] * r0[0] - v0[1] * r0[1]; o0[1] = v0[1] * r0[0] + v0[0] * r0[1]; o0[2] = v0[2] * r0[2] - v0[3] * r0[3]; o0[3] = v0[3] * r0[2] + v0[2] * r0[3];
                            o1[0] = v1[0] * r1[0] - v1[1] * r1[1]; o1[1] = v1[1] * r1[0] + v1[0] * r1[1]; o1[2] = v1[2] * r1[2] - v1[3] * r1[3]; o1[3] = v1[3] * r1[2] + v1[2] * r1[3];
                            if (!isk) { o0 = o0 * QSCALE; o1 = o1 * QSCALE; }
                            *(u32x4*)((isk ? KS : QS) + qk_row(b, h, t) * 64 + pc) = pack8(o0, o1);
                        } else {
                            f32x4 s0, s1;
#pragma unroll
                            for (int i = 0; i < 4; ++i) { s0[i] = sigmoidf_(v0[i]); s1[i] = sigmoidf_(v1[i]); }
                            *(u32x4*)(GATES + (size_t)tok * 2048 + (c0 - 1536)) = pack8(s0, s1);
                        } }
                    asm volatile("" ::: "memory"); }
        }
    }
};
struct EpiMerge {
    static constexpr bool PERM = true, AFTER_DRAIN = false; static constexpr int MIDK = 12;
    unsigned char* ws;
    __device__ __forceinline__ void mid(f32x4 (&acc)[2][2][4][2], const Unit& u, int wr, int wc, int fr, int fq) const {
        asm volatile("" : "+v"(fr), "+v"(fq));
        unsigned char* w_ = ws; asm volatile("" : "+s"(w_)); const bf16_t* GATES = (const bf16_t*)(w_ + WS_GATES);
#pragma unroll
        for (int ai = 0; ai < 2; ++ai)
#pragma unroll
            for (int m = 0; m < 4; ++m) { const int tok = u.pm * 256 + ai * 128 + wr * 64 + m * 16 + fr;
#pragma unroll
                for (int bj = 0; bj < 2; ++bj) { const int c0 = u.pn * 256 + bj * 128 + wc * 32 + 8 * fq;
                    const u32x4 g1 = *(const u32x4*)(GATES + (size_t)tok * 2048 + c0), g2 = *(const u32x4*)(GATES + (size_t)tok * 2048 + 1024 + c0);
#pragma unroll
                    for (int i = 0; i < 4; ++i) { const float rl = bflo(g1[i]) * __builtin_amdgcn_rcpf(fmaxf(bflo(g2[i]), 1e-20f)), rh = bfhi(g1[i]) * __builtin_amdgcn_rcpf(fmaxf(bfhi(g2[i]), 1e-20f));
                        acc[ai][bj][m][i >> 1][(i & 1) * 2] *= rl; acc[ai][bj][m][i >> 1][(i & 1) * 2 + 1] *= rh; } }
                asm volatile("" : "+v"(acc[ai][0][m][0]), "+v"(acc[ai][0][m][1]), "+v"(acc[ai][1][m][0]), "+v"(acc[ai][1][m][1]) :: "memory"); }
    }
    __device__ __forceinline__ void operator()(const f32x4 (&acc)[2][2][4][2], const Unit& u, int wr, int wc, int fr, int fq) const {
        asm volatile("" : "+v"(fr), "+v"(fq));
        unsigned char* w_ = ws; asm volatile("" : "+s"(w_)); const bf16_t* GATES = (const bf16_t*)(w_ + WS_GATES); bf16_t* MERGED = (bf16_t*)(w_ + WS_MERGED);
#pragma unroll
        for (int ai = 0; ai < 2; ++ai)
#pragma unroll
            for (int m = 0; m < 4; ++m) { const int tok = u.pm * 256 + ai * 128 + wr * 64 + m * 16 + fr;
#pragma unroll
                for (int bj = 0; bj < 2; ++bj) { const int c0 = u.pn * 256 + bj * 128 + wc * 32 + 8 * fq;
                    const u32x4 g2 = *(const u32x4*)(GATES + (size_t)tok * 2048 + 1024 + c0);
                    f32x4 o0 = acc[ai][bj][m][0], o1 = acc[ai][bj][m][1];
                    o0[0] *= fmaxf(bflo(g2[0]), 1e-20f); o0[1] *= fmaxf(bfhi(g2[0]), 1e-20f); o0[2] *= fmaxf(bflo(g2[1]), 1e-20f); o0[3] *= fmaxf(bfhi(g2[1]), 1e-20f);
                    o1[0] *= fmaxf(bflo(g2[2]), 1e-20f); o1[1] *= fmaxf(bfhi(g2[2]), 1e-20f); o1[2] *= fmaxf(bflo(g2[3]), 1e-20f); o1[3] *= fmaxf(bfhi(g2[3]), 1e-20f);
                    *(u32x4*)(MERGED + (size_t)tok * D + c0) = pack8(o0, o1); } }
    }
};
struct EpiOut {
    static constexpr bool PERM = true, AFTER_DRAIN = false; static constexpr int MIDK = 0;
    float* xo; unsigned char* ws; int layer;
    __device__ __forceinline__ void mid(f32x4 (&)[2][2][4][2], const Unit&, int, int, int, int) const {}
    __device__ __forceinline__ void operator()(const f32x4 (&acc)[2][2][4][2], const Unit& u, int wr, int wc, int fr, int fq) const {
        asm volatile("" : "+v"(fr), "+v"(fq));
        unsigned char* w_ = ws; float* x = xo; asm volatile("" : "+s"(w_), "+s"(x)); const float* mod_l = (const float*)(w_ + WS_MOD) + (size_t)layer * NB * 6144;
#pragma unroll
        for (int ai = 0; ai < 2; ++ai)
#pragma unroll
            for (int m = 0; m < 4; ++m) { const int tok = u.pm * 256 + ai * 128 + wr * 64 + m * 16 + fr; const int b = tok >> 13;
#pragma unroll
                for (int bj = 0; bj < 2; ++bj) { const int c0 = u.pn * 256 + bj * 128 + wc * 32 + 8 * fq;
                    float* xp = x + (size_t)tok * D + c0; const float* gp = mod_l + b * 6144 + 2048 + c0;
                    const f32x4 g0 = *(const f32x4*)gp, g1 = *(const f32x4*)(gp + 4);
                    const f32x4 x0 = *(const f32x4*)xp, x1 = *(const f32x4*)(xp + 4);
                    *(f32x4*)xp = x0 + g0 * acc[ai][bj][m][0]; *(f32x4*)(xp + 4) = x1 + g1 * acc[ai][bj][m][1]; } }
    }
};


__device__ __forceinline__ void ph_w4t(const int tid, const int bid, CP p, _Float16* W4T) {
    for (int idx = bid * 512 + tid; idx < DEPTH * 1536 * 256; idx += (int)gridDim.x * 512) { const int kq = idx & 255, n = (idx >> 8) % 1536, l = idx / (1536 * 256);
        W4T[idx] = (_Float16)(kq < 64 ? p.hf_w4[((size_t)l * 64 + kq) * 1536 + n] : 0.f); }
}
struct EpiTaps {
    static constexpr bool PERM = true, AFTER_DRAIN = false; static constexpr int MIDK = 0;
    unsigned char* ws;
    __device__ __forceinline__ void mid(f32x4 (&)[2][2][4][2], const Unit&, int, int, int, int) const {}
    __device__ __forceinline__ void operator()(const f32x4 (&acc)[2][2][4][2], const Unit& u, int wr, int wc, int fr, int fq) const {
        asm volatile("" : "+v"(fr), "+v"(fq));
        unsigned char* w_ = ws; asm volatile("" : "+s"(w_)); _Float16* FILT = (_Float16*)(w_ + WS_FILT);
#pragma unroll
        for (int ai = 0; ai < 2; ++ai)
#pragma unroll
            for (int m = 0; m < 4; ++m) { const int row = u.pm * 256 + ai * 128 + wr * 64 + m * 16 + fr; const int dir = row >= 768 ? 1 : 0, c = row - dir * 768;
                const float kc = -(3.0701134573253945f + (15.350567286626972f - 3.0701134573253945f) * (float)c * (1.0f / 767.0f)) * (1.4426950408889634f / 8191.0f);
#pragma unroll
                for (int bj = 0; bj < 2; ++bj) { const int l0 = u.pn * 256 + bj * 128 + wc * 32 + 8 * fq;
                    pg8::f16x8 o;
#pragma unroll
                    for (int i = 0; i < 8; ++i) o[i] = (_Float16)(acc[ai][bj][m][i >> 2][i & 3] * exp2f(kc * (float)(l0 + i)));
                    *(pg8::f16x8*)(FILT + (size_t)c * 16384 + dir * 8192 + l0) = o; } }
    }
};

__device__ __forceinline__ void ph_moe_prep(const int tid, const int bid, unsigned char* ws, int layer) {
    const int* CNT = (const int*)(ws + WS_CTL + CTL_CNT) + layer * 64; const int* SEL = (const int*)(ws + WS_SEL); const int* RANK = (const int*)(ws + WS_RANK); int* POS = (int*)(ws + WS_POS);
    int base[16]; int acc = 0;
#pragma unroll
    for (int e = 0; e < 16; ++e) { base[e] = acc; acc += (CNT[e] + 255) & ~255; }
    for (int idx = bid * 512 + tid; idx < T * 2; idx += (int)gridDim.x * 512) { const int e = SEL[idx]; int b = 0;
#pragma unroll
        for (int k = 0; k < 16; ++k) b = (k == e) ? base[k] : b;
        POS[idx] = b + RANK[idx]; }
}
struct SchedMoe {
    const int* CNT; const char* A; const char* B; const int* LIST; size_t bstrideE, tstepA, tstepB; int gather, G, c;
    __device__ __forceinline__ bool next(int i, Unit& u) const {
        const int id = i * G + c; int q = id >> 2; const int ct = id & 3; int e = 0, tile0 = 0, ce = 0;
        for (; e < 16; ++e) { ce = __builtin_amdgcn_readfirstlane(CNT[e]); const int n = (ce + 255) >> 8; if (q < n) break; q -= n; tile0 += n; }
        if (e == 16) return false;
        u.pm = tile0 + q; u.pn = ct; u.kind = e; u.nvalid = ce - q * 256 < 256 ? ce - q * 256 : 256;
        u.B = B + (size_t)e * bstrideE + (size_t)ct * tstepB;
        if (gather) { u.A = A; u.rows = LIST + e * 16384 + q * 256; } else { u.A = A + (size_t)u.pm * tstepA; u.rows = nullptr; }
        return true;
    }
    __device__ __forceinline__ void a_ready(const Unit&) const {}
    __device__ __forceinline__ void done(const Unit&) const {}
};
struct EpiMoeUp {
    static constexpr bool PERM = true, AFTER_DRAIN = false; static constexpr int MIDK = 0;
    unsigned char* ws;
    __device__ __forceinline__ void mid(f32x4 (&)[2][2][4][2], const Unit&, int, int, int, int) const {}
    __device__ __forceinline__ void operator()(const f32x4 (&acc)[2][2][4][2], const Unit& u, int wr, int wc, int fr, int fq) const {
        asm volatile("" : "+v"(fr), "+v"(fq));
        unsigned char* w_ = ws; asm volatile("" : "+s"(w_)); bf16_t* ACT = (bf16_t*)(w_ + WS_ACT);
#pragma unroll
        for (int ai = 0; ai < 2; ++ai)
#pragma unroll
            for (int m = 0; m < 4; ++m) { const int row = u.pm * 256 + ai * 128 + wr * 64 + m * 16 + fr;
                f32x4 o0, o1;
#pragma unroll
                for (int i = 0; i < 4; ++i) { o0[i] = siluf_(acc[ai][0][m][0][i]) * acc[ai][1][m][0][i]; o1[i] = siluf_(acc[ai][0][m][1][i]) * acc[ai][1][m][1][i]; }
                *(u32x4*)(ACT + (size_t)row * DEXP + u.pn * 128 + wc * 32 + 8 * fq) = pack8(o0, o1); }
    }
};
struct EpiMoeDown {
    static constexpr bool PERM = true, AFTER_DRAIN = false; static constexpr int MIDK = 0;
    unsigned char* ws;
    __device__ __forceinline__ void mid(f32x4 (&)[2][2][4][2], const Unit&, int, int, int, int) const {}
    __device__ __forceinline__ void operator()(const f32x4 (&acc)[2][2][4][2], const Unit& u, int wr, int wc, int fr, int fq) const {
        asm volatile("" : "+v"(fr), "+v"(fq));
        unsigned char* w_ = ws; asm volatile("" : "+s"(w_)); bf16_t* YB = (bf16_t*)(w_ + WS_YB);
#pragma unroll
        for (int ai = 0; ai < 2; ++ai)
#pragma unroll
            for (int m = 0; m < 4; ++m) { const int row = u.pm * 256 + ai * 128 + wr * 64 + m * 16 + fr;
#pragma unroll
                for (int bj = 0; bj < 2; ++bj) *(u32x4*)(YB + (size_t)row * D + u.pn * 256 + bj * 128 + wc * 32 + 8 * fq) = pack8(acc[ai][bj][m][0], acc[ai][bj][m][1]); }
    }
};


typedef float f32x16 __attribute__((ext_vector_type(16)));
typedef unsigned u32x2 __attribute__((ext_vector_type(2)));
__device__ __forceinline__ void ph_attn(const int tid, const int bid, unsigned char* ws) {
    const bf16_t* QS = (const bf16_t*)(ws + WS_QS); const bf16_t* KS = (const bf16_t*)(ws + WS_KS); const bf16_t* VT = (const bf16_t*)(ws + WS_VT);
    bf16_t* OG = (bf16_t*)(ws + WS_OG); float* LSE = (float*)(ws + WS_LSE);
    const int lane = tid & 63, q = lane & 31, hi = lane >> 5, wave = tid >> 6;
    const float NEG = -1e30f;
    for (int it = bid * 8 + wave; it < NB * NH * (L / 32); it += (int)gridDim.x * 8) {
        const int bh = it >> 8, tile = it & 255; const int h = bh % NH, b = bh / NH, g = h >> 2, hh = h & 3;
        const int lsh = g == 0 ? 13 : (g == 1 ? 11 : 9), Ls = 1 << lsh, dsh = 13 - lsh;
        const int row0 = tile * 32, r = row0 >> lsh, m0 = row0 & (Ls - 1);
        const size_t rb = (size_t)bh * L + (size_t)r * Ls;
        pg8::bf16x8 qf[4];
#pragma unroll
        for (int s = 0; s < 4; ++s) qf[s] = *(const pg8::bf16x8*)(QS + (rb + m0 + q) * 64 + 16 * s + 8 * hi);
        f32x16 S[5]; float mx = NEG;
#pragma unroll
        for (int i = 0; i < 5; ++i) {
            const int t0 = m0 - 64 + 32 * i; const bool ok = (t0 >= 0) && (t0 < Ls);
            f32x16 a;
#pragma unroll
            for (int e = 0; e < 16; ++e) a[e] = 0.f;
            if (ok) {
#pragma unroll
                for (int s = 0; s < 4; ++s) { const pg8::bf16x8 kf = *(const pg8::bf16x8*)(KS + (rb + t0 + q) * 64 + 16 * s + 8 * hi); a = __builtin_amdgcn_mfma_f32_32x32x16_bf16(kf, qf[s], a, 0, 0, 0); }
#pragma unroll
                for (int e = 0; e < 16; ++e) { const int kk = (e & 3) + 8 * (e >> 2) + 4 * hi;
                    if (i == 0 && kk < q) a[e] = NEG;
                    if (i == 4 && kk > q) a[e] = NEG;
                    mx = fmaxf(mx, a[e]); }
            } else {
#pragma unroll
                for (int e = 0; e < 16; ++e) a[e] = NEG;
            }
            S[i] = a;
        }
        mx = fmaxf(mx, shx(mx, 32, lane));
        float l = 0.f;
#pragma unroll
        for (int i = 0; i < 5; ++i)
#pragma unroll
            for (int e = 0; e < 16; ++e) { const float pv = exp2f(S[i][e] - mx); S[i][e] = pv; l += pv; }
        l += shx(l, 32, lane);
        f32x16 o[2];
#pragma unroll
        for (int dvb = 0; dvb < 2; ++dvb) {
#pragma unroll
            for (int e = 0; e < 16; ++e) o[dvb][e] = 0.f;
        }
        const bf16_t* vrow0 = VT + (size_t)bh * L * 64 + (size_t)(r * 64 + q) * Ls + 4 * hi;
#pragma unroll
        for (int i = 0; i < 5; ++i) {
            const int t0 = m0 - 64 + 32 * i; const bool ok = (t0 >= 0) && (t0 < Ls);
            if (ok) {
#pragma unroll
                for (int s2 = 0; s2 < 2; ++s2) {
                    u32x4 pf; pf.x = pg8::cvt_pk_bf16(S[i][8 * s2 + 0], S[i][8 * s2 + 1]); pf.y = pg8::cvt_pk_bf16(S[i][8 * s2 + 2], S[i][8 * s2 + 3]);
                    pf.z = pg8::cvt_pk_bf16(S[i][8 * s2 + 4], S[i][8 * s2 + 5]); pf.w = pg8::cvt_pk_bf16(S[i][8 * s2 + 6], S[i][8 * s2 + 7]);
                    const pg8::bf16x8 pb = __builtin_bit_cast(pg8::bf16x8, pf);
#pragma unroll
                    for (int dvb = 0; dvb < 2; ++dvb) {
                        const bf16_t* vp = vrow0 + (size_t)(dvb * 32) * Ls + t0 + 16 * s2;
                        const u32x2 v0 = *(const u32x2*)vp, v1 = *(const u32x2*)(vp + 8);
                        u32x4 vv; vv.x = v0.x; vv.y = v0.y; vv.z = v1.x; vv.w = v1.y;
                        o[dvb] = __builtin_amdgcn_mfma_f32_32x32x16_bf16(__builtin_bit_cast(pg8::bf16x8, vv), pb, o[dvb], 0, 0, 0);
                    }
                }
            }
        }
        const float il = 1.f / l; const int t = ((m0 + q) << dsh) + r; const size_t tt = (size_t)b * L + t;
        bf16_t* op = OG + ((size_t)g * T + tt) * 256 + hh * 64 + 4 * hi;
#pragma unroll
        for (int dvb = 0; dvb < 2; ++dvb)
#pragma unroll
            for (int g4 = 0; g4 < 4; ++g4) { u32x2 w; w.x = pg8::cvt_pk_bf16(o[dvb][4 * g4] * il, o[dvb][4 * g4 + 1] * il); w.y = pg8::cvt_pk_bf16(o[dvb][4 * g4 + 2] * il, o[dvb][4 * g4 + 3] * il);
                *(u32x2*)(op + dvb * 32 + 8 * g4) = w; }
        if (hi == 0) LSE[((size_t)g * T + tt) * 4 + hh] = mx + log2f(l);
    }
}

#define FFT_HD __device__ __forceinline__
#define FFT_LDS __attribute__((address_space(3)))
#define FFT_ORDER(a, b) asm volatile("" : "+v"(a) : "v"(b))
#define FFT_LAUNDER(x) asm volatile("" : "+v"(x))
#define FFT_SCONST(dst, val, bits) asm volatile("s_mov_b32 %0, " #bits : "=s"(dst))
typedef float cpx __attribute__((ext_vector_type(2)));
FFT_HD inline cpx cmul(cpx a, cpx b) { cpx r; r.x = a.x * b.x - a.y * b.y; r.y = a.x * b.y + a.y * b.x; return r; }
FFT_HD inline cpx cmulc(cpx a, cpx b) { cpx r; r.x = a.x * b.x + a.y * b.y; r.y = a.y * b.x - a.x * b.y; return r; }
FFT_HD inline int FPHYS(int p) { return p + (p >> 4) + 16 * (p >> 9); }
constexpr int FFT_LDS_ELEMS = 16384 + 1024 + 512;
#define FFT_C1 0.98078528040323043f
#define FFT_S1 0.19509032201612825f
#define FFT_C2 0.92387953251128674f
#define FFT_S2 0.38268343236508978f
#define FFT_C3 0.83146961230254524f
#define FFT_S3 0.55557023301960218f
#define FFT_C4 0.70710678118654752f
struct W32C { float c1, c2, c3, c4, s1, s2, s3; };
FFT_HD inline W32C w32_consts() {
    W32C k;
    FFT_SCONST(k.c1, FFT_C1, 0x3f7b14be); FFT_SCONST(k.c2, FFT_C2, 0x3f6c835e); FFT_SCONST(k.c3, FFT_C3, 0x3f54db31); FFT_SCONST(k.c4, FFT_C4, 0x3f3504f3);
    FFT_SCONST(k.s1, FFT_S1, 0x3e47c5c2); FFT_SCONST(k.s2, FFT_S2, 0x3ec3ef15); FFT_SCONST(k.s3, FFT_S3, 0x3f0e39da);
    return k;
}
FFT_HD inline cpx w32(int m, const W32C& k) {
#define FFT_CT(q) ((q) == 0 ? 1.f : (q) == 1 ? k.c1 : (q) == 2 ? k.c2 : (q) == 3 ? k.c3 : (q) == 4 ? k.c4 : (q) == 5 ? k.s3 : (q) == 6 ? k.s2 : (q) == 7 ? k.s1 : 0.f)
    cpx r; if (m <= 8) { r.x = FFT_CT(m); r.y = -FFT_CT(8 - m); } else { r.x = -FFT_CT(16 - m); r.y = -FFT_CT(m - 8); } return r;
}
template <int R, bool INV> FFT_HD inline void dft_regs(cpx (&v)[R]) {
    const W32C kc = w32_consts();
#pragma unroll
    for (int s = R / 2; s >= 1; s >>= 1) {
#pragma unroll
        for (int g = 0; g < R; g += 2 * s) {
#pragma unroll
            for (int k = 0; k < s; ++k) {
                const cpx a = v[g + k], b = v[g + k + s];
                cpx d; d.x = a.x - b.x; d.y = a.y - b.y;
                v[g + k].x = a.x + b.x; v[g + k].y = a.y + b.y;
                const int m = k * (16 / s);
                if (m == 0) v[g + k + s] = d;
                else if (m == 8) { cpx t; if (INV) { t.x = -d.y; t.y = d.x; } else { t.x = d.y; t.y = -d.x; } v[g + k + s] = t; }
                else { const cpx w = w32(m, kc); v[g + k + s] = INV ? cmulc(d, w) : cmul(d, w); }
            }
        }
    }
}
FFT_HD constexpr int brev(int i, int bits) { int r = 0; for (int b = 0; b < bits; ++b) r |= ((i >> b) & 1) << (bits - 1 - b); return r; }
FFT_HD inline cpx small_twiddle(float th) {
    const float t2 = th * th;
    cpx r;
    r.x = 1.f + t2 * (-0.5f + t2 * (4.1666666666666664e-2f + t2 * (-1.3888888888888889e-3f + t2 * 2.48015873015873e-5f)));
    r.y = -th * (1.f + t2 * (-1.6666666666666666e-1f + t2 * (8.3333333333333332e-3f + t2 * (-1.984126984126984e-4f))));
    return r;
}
template <int R, int BITS, bool BREV_IDX, bool INV> FFT_HD inline void apply_twiddles(cpx (&v)[R], cpx w1) {
    const cpx w2 = cmul(w1, w1), w3 = cmul(w2, w1), w4 = cmul(w2, w2);
    cpx cur[4]; cur[0].x = 1.f; cur[0].y = 0.f; cur[1] = w1; cur[2] = w2; cur[3] = w3;
#pragma unroll
    for (int q = 0; q < R; ++q) {
        const int idx = BREV_IDX ? brev(q, BITS) : q;
        if (q > 0) v[idx] = INV ? cmulc(v[idx], cur[q & 3]) : cmul(v[idx], cur[q & 3]);
        if (q + 4 < R) { cur[q & 3] = cmul(cur[q & 3], w4); FFT_ORDER(cur[q & 3], v[idx]); }
    }
}
template <bool ZERO_UPPER> FFT_HD inline void fft_f1(int tid, FFT_LDS cpx* lds) {
    FFT_LAUNDER(tid);
    cpx v[32];
#pragma unroll
    for (int j = 0; j < 32; ++j) { if (ZERO_UPPER && j >= 16) { v[j].x = 0.f; v[j].y = 0.f; } else v[j] = lds[FPHYS(tid + 512 * j)]; }
    dft_regs<32, false>(v);
    apply_twiddles<32, 5, true, false>(v, small_twiddle(6.283185307179586f * (float)tid * (1.0f / 16384.0f)));
#pragma unroll
    for (int q = 0; q < 32; ++q) lds[FPHYS(tid + 512 * q)] = v[brev(q, 5)];
}
FFT_HD inline void fft_f2(int tid, FFT_LDS cpx* lds) {
    FFT_LAUNDER(tid);
    const int q1 = tid >> 4, a = tid & 15; cpx v[32];
#pragma unroll
    for (int b = 0; b < 32; ++b) v[b] = lds[FPHYS(512 * q1 + a + 16 * b)];
    dft_regs<32, false>(v);
    apply_twiddles<32, 5, true, false>(v, small_twiddle(6.283185307179586f * (float)a * (1.0f / 512.0f)));
#pragma unroll
    for (int q = 0; q < 32; ++q) lds[FPHYS(512 * q1 + a + 16 * q)] = v[brev(q, 5)];
}
FFT_HD inline void fft_f3(int tid, FFT_LDS const cpx* lds, cpx (&out)[2][16]) {
    FFT_LAUNDER(tid);
#pragma unroll
    for (int h = 0; h < 2; ++h) { const int blk = tid + 512 * h; cpx v[16];
#pragma unroll
        for (int i = 0; i < 16; ++i) v[i] = lds[FPHYS(16 * blk + i)];
        dft_regs<16, false>(v);
#pragma unroll
        for (int k = 0; k < 16; ++k) out[h][k] = v[brev(k, 4)]; }
}
FFT_HD inline void fft_i3(int tid, cpx (&in)[2][16], FFT_LDS cpx* lds) {
    FFT_LAUNDER(tid);
#pragma unroll
    for (int h = 0; h < 2; ++h) { const int blk = tid + 512 * h; cpx v[16];
#pragma unroll
        for (int k = 0; k < 16; ++k) v[k] = in[h][k];
        dft_regs<16, true>(v);
#pragma unroll
        for (int i = 0; i < 16; ++i) lds[FPHYS(16 * blk + i)] = v[brev(i, 4)]; }
}
FFT_HD inline void fft_i2(int tid, FFT_LDS cpx* lds) {
    FFT_LAUNDER(tid);
    const int q1 = tid >> 4, a = tid & 15; cpx v[32];
#pragma unroll
    for (int q = 0; q < 32; ++q) v[q] = lds[FPHYS(512 * q1 + a + 16 * q)];
    apply_twiddles<32, 5, false, true>(v, small_twiddle(6.283185307179586f * (float)a * (1.0f / 512.0f)));
    dft_regs<32, true>(v);
#pragma unroll
    for (int b = 0; b < 32; ++b) lds[FPHYS(512 * q1 + a + 16 * b)] = v[brev(b, 5)];
}
FFT_HD inline void fft_i1(int tid, FFT_LDS const cpx* lds, cpx (&v)[32]) {
    FFT_LAUNDER(tid);
#pragma unroll
    for (int q = 0; q < 32; ++q) v[q] = lds[FPHYS(tid + 512 * q)];
    apply_twiddles<32, 5, false, true>(v, small_twiddle(6.283185307179586f * (float)tid * (1.0f / 16384.0f)));
    dft_regs<32, true>(v);
}
FFT_HD inline void fft_i1_store(int tid, FFT_LDS cpx* lds) {
    cpx v[32]; fft_i1(tid, lds, v);
    FFT_LAUNDER(tid);
#pragma unroll
    for (int j = 0; j < 16; ++j) lds[FPHYS(tid + 512 * j)] = v[brev(j, 5)];
}

typedef _Float16 h2_t __attribute__((ext_vector_type(2)));
#define OPAQUE_PTR(T, name, expr) T name; { unsigned lo_ = __builtin_amdgcn_readfirstlane((unsigned)(uintptr_t)(expr)), hi_ = __builtin_amdgcn_readfirstlane((unsigned)((uintptr_t)(expr) >> 32)); asm volatile("" : "+s"(lo_), "+s"(hi_)); name = (T)(((uintptr_t)hi_ << 32) | lo_); }
typedef const bf16_t __attribute__((address_space(1)))* gbf_cp;
__device__ __forceinline__ float conv3(gbf_cp u, int t, float w0, float w1, float w2, float bb) {
    const float um = bf2f(u[t > 0 ? -1 : 0]), u0 = bf2f(u[0]), up = bf2f(u[t < L - 1 ? 1 : 0]);
    return (t > 0 ? um : 0.f) * w0 + u0 * w1 + (t < L - 1 ? up : 0.f) * w2 + bb;
}
__device__ __forceinline__ void ph_fftconv(const int tid, const int bid, CP p, int layer, unsigned char* ws, LAS unsigned char* ldsraw) {
    LAS cpx* lds = (LAS cpx*)ldsraw;
    const float* w_sc_ = p.w_sc + (size_t)layer * 3 * C3; const float* b_sc_ = p.b_sc + (size_t)layer * C3; const float* hy_bias_ = p.hy_bias + layer * HYW;
    for (int c = bid; c < HYW; c += (int)gridDim.x) {
        OPAQUE_PTR(unsigned char*, wsl, ws)
        const _Float16* FILT = (const _Float16*)(wsl + WS_FILT); const bf16_t* UT = (const bf16_t*)(wsl + WS_UT); bf16_t* YT = (bf16_t*)(wsl + WS_YT);
        { OPAQUE_PTR(const _Float16 __attribute__((address_space(1)))*, kf, FILT + (size_t)c * 16384) OPAQUE_PTR(const float*, hy_bias, hy_bias_)
          int tl = tid; asm volatile("" : "+v"(tl));
#pragma unroll 8
          for (int j = 0; j < 32; ++j) { const int n = tl + 512 * j; cpx t; t.y = 0.f;
              t.x = (float)kf[j < 16 ? n : (n == 8192 ? 8192 : 24576 - n)]; if (n == 8192) t.x = 0.f; if (n == 0) t.x += hy_bias[c]; lds[FPHYS(n)] = t; } }
        asm volatile("" ::: "memory");
        fft_f1<false>(tid, lds); __syncthreads(); fft_f2(tid, lds); __syncthreads();
        h2_t KF[2][16];
        { cpx KFf[2][16]; fft_f3(tid, lds, KFf);
#pragma unroll
          for (int h = 0; h < 2; ++h)
#pragma unroll
              for (int kq = 0; kq < 16; ++kq) { h2_t t; t.x = (_Float16)KFf[h][kq].x; t.y = (_Float16)KFf[h][kq].y; KF[h][kq] = t; } }
        __syncthreads();
        { const int c1 = HYW + c, c2 = 2 * HYW + c; OPAQUE_PTR(const float*, w_sc, w_sc_) OPAQUE_PTR(const float*, b_sc, b_sc_)
          const float a0 = w_sc[c1], a1 = w_sc[C3 + c1], a2 = w_sc[2 * C3 + c1], ab = b_sc[c1], v0 = w_sc[c2], v1 = w_sc[C3 + c2], v2 = w_sc[2 * C3 + c2], vb = b_sc[c2];
          OPAQUE_PTR(gbf_cp, u1, UT + (size_t)c1 * T) OPAQUE_PTR(gbf_cp, u2, UT + (size_t)c2 * T)
          int tl = tid; asm volatile("" : "+v"(tl));
#pragma unroll 4
          for (int j = 0; j < 16; ++j) { const int t = tl + 512 * j; cpx z;
              z.x = conv3(u1 + t, t, a0, a1, a2, ab) * conv3(u2 + t, t, v0, v1, v2, vb);
              z.y = conv3(u1 + L + t, t, a0, a1, a2, ab) * conv3(u2 + L + t, t, v0, v1, v2, vb);
              lds[FPHYS(t)] = z; } }
        asm volatile("" ::: "memory");
        fft_f1<true>(tid, lds); __syncthreads(); fft_f2(tid, lds); __syncthreads();
        { cpx W[2][16]; fft_f3(tid, lds, W);
#pragma unroll
          for (int h = 0; h < 2; ++h)
#pragma unroll
              for (int k = 0; k < 16; ++k) { cpx kf; kf.x = (float)KF[h][k].x; kf.y = (float)KF[h][k].y; W[h][k] = cmul(W[h][k], kf); }
          fft_i3(tid, W, lds); }
        __syncthreads(); fft_i2(tid, lds); __syncthreads(); fft_i1_store(tid, lds);
        asm volatile("" ::: "memory");
        { OPAQUE_PTR(const float*, w_sc, w_sc_) OPAQUE_PTR(const float*, b_sc, b_sc_) const float x0w = w_sc[c], x1w = w_sc[C3 + c], x2w = w_sc[2 * C3 + c], xb = b_sc[c];
          OPAQUE_PTR(gbf_cp, u0, UT + (size_t)c * T) OPAQUE_PTR(bf16_t __attribute__((address_space(1)))*, yo, YT + (size_t)c * T)
          int tl = tid; asm volatile("" : "+v"(tl));
#pragma unroll 4
          for (int j = 0; j < 16; ++j) { const int t = tl + 512 * j; const cpx u = lds[FPHYS(t)];
              yo[t] = f2bf(u.x * (1.0f / 16384.0f) * conv3(u0 + t, t, x0w, x1w, x2w, xb));
              yo[L + t] = f2bf(u.y * (1.0f / 16384.0f) * conv3(u0 + L + t, t, x0w, x1w, x2w, xb)); } }
        __syncthreads();
    }
}

namespace cg = cooperative_groups;
constexpr int NPHASE = 1 + 9 * DEPTH + 1;
constexpr int MEGA_LDS = 147456;
__global__ void __launch_bounds__(512, 2) mega(P p_unused) {
    extern __shared__ __attribute__((aligned(16))) unsigned char lds[];
    typedef const __attribute__((address_space(4))) P* KP;
    KP kp0 = (KP)__builtin_amdgcn_kernarg_segment_ptr();
    cg::grid_group grid = cg::this_grid();
    const int ph_lo = kp0->ph_lo, ph_hi = kp0->ph_hi;
    const int wave0 = __builtin_amdgcn_readfirstlane((int)(threadIdx.x >> 6));
#define PHASE_VARS const __attribute__((address_space(4))) P& p = *pp; unsigned char* ws = p.ws; float* out = p.out; float* MOD = (float*)(ws + WS_MOD); float* ROPE = (float*)(ws + WS_ROPE); _Float16* H3 = (_Float16*)(ws + WS_H3); _Float16* W4T = (_Float16*)(ws + WS_W4T); int* SEL = (int*)(ws + WS_SEL); float* WTS = (float*)(ws + WS_WTS); int* POS = (int*)(ws + WS_POS); _Float16* FILT = (_Float16*)(ws + WS_FILT); bf16_t* XN = (bf16_t*)(ws + WS_XN); bf16_t* UT = (bf16_t*)(ws + WS_UT); bf16_t* QS = (bf16_t*)(ws + WS_QS); bf16_t* KS = (bf16_t*)(ws + WS_KS); bf16_t* VT = (bf16_t*)(ws + WS_VT); bf16_t* GATES = (bf16_t*)(ws + WS_GATES); bf16_t* YT = (bf16_t*)(ws + WS_YT); bf16_t* OG = (bf16_t*)(ws + WS_OG); float* LSE = (float*)(ws + WS_LSE); bf16_t* YCAT = (bf16_t*)(ws + WS_YCAT); bf16_t* MERGED = (bf16_t*)(ws + WS_MERGED); float* Z = (float*)(ws + WS_Z); bf16_t* X0 = (bf16_t*)(ws + WS_X0); bf16_t* ACT = (bf16_t*)(ws + WS_ACT); bf16_t* YB = (bf16_t*)(ws + WS_YB); unsigned char* sm = lds + (tid >> 8) * 8192; LAS unsigned char* ldsp = (LAS unsigned char*)lds; bf16_t* WA = (bf16_t*)(ws + WS_WA); bf16_t* WB = (bf16_t*)(ws + WS_WB); bf16_t* WCAT = (bf16_t*)(ws + WS_WCAT); bf16_t* WOUT = (bf16_t*)(ws + WS_WOUT);
    int ph = 0;
#define PHASE(...) do { if (ph >= ph_lo && ph < ph_hi) { int tid, bid = blockIdx.x; KP pp = kp0; asm volatile("v_mbcnt_lo_u32_b32 %0, -1, 0\n\tv_mbcnt_hi_u32_b32 %0, -1, %0" : "=v"(tid)); tid += wave0 * 64; asm volatile("" : "+v"(tid), "+s"(bid), "+s"(pp)); PHASE_VARS; __VA_ARGS__; if (ph + 1 < ph_hi) grid.sync(); } ++ph; } while (0)
    PHASE({ nv_mod(tid, bid, p, MOD); nv_rope(tid, bid, p, ROPE); nv_h3(tid, bid, p, H3, sm); ph_w4t(tid, bid, p, W4T); __syncthreads(); ph_convert(tid, bid, p, 0, ws, ldsp); });
    for (int l = 0; l < DEPTH; ++l) {
#define mod_l (MOD + (size_t)l * NB * 6144)
        PHASE({ if (l > 0) { ph_convert(tid, bid, p, l, ws, ldsp); __syncthreads(); }
                { SchedDense S{(const char*)(W4T + (size_t)l * 1536 * 256), (const char*)(H3 + (size_t)l * L * 256), 6, 32, (int)gridDim.x, bid, (size_t)256 * 256 * 2}; EpiTaps E{ws};
                  pg8::gemm_phase<EpiTaps, SchedDense, true, true, false, true>(tid, ldsp, 256, S, E); }
                asm volatile("v_mbcnt_lo_u32_b32 %0, -1, 0\n\tv_mbcnt_hi_u32_b32 %0, -1, %0" : "=v"(tid)); tid += wave0 * 64;
                nv_norm(tid, bid, l == 0 ? p.x : out, out, p.norm1_g + l * D, mod_l, XN, l > 0, YB, POS, WTS, l > 0 ? mod_l - NB * 6144 : mod_l); });
        PHASE({ SchedG1 S{(const char*)XN, (const char*)WA, (const char*)WB, (int)gridDim.x, bid}; EpiG1 E{ws};
                pg8::gemm_phase<EpiG1, SchedG1, true, true>(tid, ldsp, 1024, S, E); });
        PHASE({ ph_fftconv(tid, bid, p, l, ws, ldsp); ph_attn(tid, bid, ws); });
        PHASE({ nv_ycat(tid, bid, YT, OG, LSE, YCAT); });
        PHASE({ SchedDense S{(const char*)YCAT, (const char*)WCAT, 64, 4, (int)gridDim.x, bid, 524288}; EpiMerge E{ws};
                pg8::gemm_phase<EpiMerge, SchedDense, true, true>(tid, ldsp, 1024, S, E); });
        PHASE({ SchedDense S{(const char*)MERGED, (const char*)WOUT, 64, 4, (int)gridDim.x, bid, 524288}; EpiOut E{out, ws, l};
                pg8::gemm_phase<EpiOut, SchedDense, true, true>(tid, ldsp, 1024, S, E); });
        PHASE({ nv_norm2_route(tid, bid, out, p.norm2_g + l * D, mod_l, XN, p.router_w, p.router_bias, SEL, WTS, (int*)(ws + WS_CTL + CTL_CNT) + l * 64, (int*)(ws + WS_LIST), (int*)(ws + WS_RANK)); });
        PHASE({ ph_moe_prep(tid, bid, ws, l);
                SchedMoe S{(const int*)(ws + WS_CTL + CTL_CNT) + l * 64, (const char*)XN, (const char*)(ws + WS_W13), (const int*)(ws + WS_LIST), (size_t)1024 * 1024 * 2, 0, (size_t)256 * 1024 * 2, 1, (int)gridDim.x, bid}; EpiMoeUp E{ws};
                pg8::gemm_phase<EpiMoeUp, SchedMoe, true, true, true>(tid, ldsp, 1024, S, E); });
        PHASE({ SchedMoe S{(const int*)(ws + WS_CTL + CTL_CNT) + l * 64, (const char*)ACT, (const char*)(ws + WS_W2), nullptr, (size_t)1024 * 512 * 2, (size_t)256 * 512 * 2, (size_t)256 * 512 * 2, 0, (int)gridDim.x, bid}; EpiMoeDown E{ws};
                pg8::gemm_phase<EpiMoeDown, SchedMoe, true, true, false>(tid, ldsp, 512, S, E); });
    }
    PHASE({ nv_final(tid, bid, out, out, p.final_g, MOD + (size_t)(DEPTH - 1) * NB * 6144, YB, POS, WTS); });
}
}

extern "C" void kernel_launch(void* const* d_in, const int* in_sizes, int n_in, void* d_out, int out_size, void* d_ws, size_t ws_size, hipStream_t stream) {
    if (n_in != 27 || in_sizes[0] != T * D || out_size != T * D || ws_size < WS_END) {
        fprintf(stderr, "kernel_launch: unexpected shapes / workspace (n_in %d, in0 %d, out %d, ws %zu need %zu); nothing launched\n", n_in, n_in > 0 ? in_sizes[0] : -1, out_size, ws_size, (size_t)WS_END);
        return;
    }
    static int grid_blocks = 0;
    if (!grid_blocks) {
        int dev = 0, cus = 0, per_cu = 0;
        (void)hipGetDevice(&dev); (void)hipDeviceGetAttribute(&cus, hipDeviceAttributeMultiprocessorCount, dev);
        (void)hipFuncSetAttribute((const void*)mega, hipFuncAttributeMaxDynamicSharedMemorySize, MEGA_LDS);
        if (hipOccupancyMaxActiveBlocksPerMultiprocessor(&per_cu, (const void*)mega, 512, MEGA_LDS) != hipSuccess || per_cu < 1) per_cu = 1;
        grid_blocks = cus;
        fprintf(stderr, "kernel_launch: %d CUs x %d blocks\n", cus, per_cu);
    }
    P p{};
    const float** dst = (const float**)&p;
    for (int i = 0; i < 27; ++i) dst[i] = (const float*)d_in[i];
    p.out = (float*)d_out; p.ws = (unsigned char*)d_ws;
    for (int j = 0; j < 32; ++j) p.ri.inv[j] = pow(10000.0, -(double)j / 32.0);
    p.ph_lo = 0; p.ph_hi = NPHASE;
    (void)hipMemsetAsync((unsigned char*)d_ws + WS_CTL, 0, 1 * MiB, stream);
    void* args[] = {&p};
    hipError_t e = hipLaunchCooperativeKernel((const void*)mega, dim3(grid_blocks), dim3(512), args, MEGA_LDS, stream);
    if (e != hipSuccess) fprintf(stderr, "cooperative launch failed: %s (grid %d)\n", hipGetErrorString(e), grid_blocks);
}
```

```cpp
#include <hip/hip_runtime.h>
#include <hip/hip_cooperative_groups.h>
#include <cstdio>
#include <cstdint>
#include <cmath>

typedef unsigned short bf16_t;

namespace {
constexpr int D = 1024, NB = 2, L = 8192, T = NB * L, DEPTH = 2;
constexpr int HYW = 768, C3 = 2304, NH = 12, HD = 64, ATT_OUT = 256, INC = 6656;
constexpr int HY_EMB = 33, HY_FFN = 64;
constexpr int NE = 16, DEXP = 512;
constexpr float NORM_EPS = 1e-6f;
constexpr float QSCALE = 0.125f * 1.4426950408889634f;

constexpr size_t MiB = 1u << 20;
constexpr size_t WS_CTL = 0;
constexpr size_t WS_MOD = 1 * MiB;
constexpr size_t WS_ROPE = 2 * MiB;
constexpr size_t WS_W4T = 4 * MiB;
constexpr size_t WS_H3 = 364 * MiB;
constexpr size_t WS_SEL = 8 * MiB;
constexpr size_t WS_WTS = WS_SEL + 256 * 1024;
constexpr size_t WS_POS = WS_WTS + 256 * 1024;
constexpr size_t WS_RANK = WS_POS + 256 * 1024;
constexpr size_t WS_LIST = 9 * MiB;
constexpr size_t CTL_CNT = 4096;
constexpr size_t WS_FILT = 10 * MiB;
constexpr size_t WS_WA = 34 * MiB;
constexpr size_t WS_WB = 41 * MiB;
constexpr size_t WS_WCAT = 47 * MiB;
constexpr size_t WS_WOUT = 49 * MiB;
constexpr size_t WS_W13 = 51 * MiB;
constexpr size_t WS_W2 = 83 * MiB;
constexpr size_t WS_XN = 99 * MiB;
constexpr size_t WS_UT = 131 * MiB;
constexpr size_t WS_QS = 203 * MiB;
constexpr size_t WS_KS = 227 * MiB;
constexpr size_t WS_VT = 251 * MiB;
constexpr size_t WS_GATES = 275 * MiB;
constexpr size_t WS_OG = 339 * MiB;
constexpr size_t WS_LSE = 363 * MiB;
constexpr size_t WS_END = 372 * MiB;
constexpr size_t WS_YT = WS_XN;
constexpr size_t WS_MERGED = WS_UT;
constexpr size_t WS_Z = WS_QS;
constexpr size_t WS_X0 = WS_VT;
constexpr size_t WS_YCAT = WS_QS;
constexpr size_t WS_ACT = WS_QS;
constexpr size_t WS_YB = WS_UT;

__device__ __forceinline__ float bf2f(bf16_t v) { return __uint_as_float((unsigned)v << 16); }
__device__ __forceinline__ bf16_t f2bf(float f) { unsigned u = __float_as_uint(f); return (bf16_t)((u + 0x7fffu + ((u >> 16) & 1u)) >> 16); }
__device__ __forceinline__ float sigmoidf_(float x) { return 1.f / (1.f + __expf(-x)); }
__device__ __forceinline__ float siluf_(float x) { return x / (1.f + __expf(-x)); }
__host__ __device__ __forceinline__ int dil_of_head(int h) { const int g = h >> 2; return g == 0 ? 1 : (g == 1 ? 4 : 16); }
__device__ __forceinline__ size_t qk_row(int b, int h, int t) { const int d = dil_of_head(h), Ls = L / d; return (size_t)(b * NH + h) * L + (size_t)(t % d) * Ls + (t / d); }
__device__ __forceinline__ size_t vt_off(int b, int h, int t, int dv) { const int d = dil_of_head(h), Ls = L / d; return (size_t)(b * NH + h) * L * 64 + (size_t)((t % d) * 64 + dv) * Ls + (t / d); }
__device__ __forceinline__ int permd(int d) { return d < 32 ? 2 * d : 2 * (d - 32) + 1; }

__device__ __forceinline__ float sin_rev(float r) { r = r - rintf(r); return __builtin_amdgcn_sinf(r); }
__device__ __forceinline__ float cos_rev(float r) { r = r - rintf(r); return __builtin_amdgcn_cosf(r); }
__device__ __forceinline__ float sin_rad(float x) { return sin_rev(x * 0.15915494309189535f); }
struct RopeInv { double inv[32]; };
__device__ __forceinline__ float shx(float v, int o, int lane) { return __int_as_float(__builtin_amdgcn_ds_bpermute((lane ^ o) << 2, __float_as_int(v))); }
__device__ __forceinline__ float wave_sum(float v, int lane) {
#pragma unroll
    for (int o = 1; o < 64; o <<= 1) v += shx(v, o, lane);
    return v;
}


struct P {
    const float *x, *c, *norm1_g, *norm2_g, *w_ada, *b_ada, *w_in, *w_sc, *b_sc, *hf_w1, *hf_b1, *hf_w2, *hf_b2, *hf_w3, *hf_b3, *hf_w4, *hf_freq, *hy_bias,
                *w_br_h, *w_br_a, *w_out, *router_w, *router_bias, *moe_w1, *moe_w3, *moe_w2, *final_g;
    float* out; unsigned char* ws;
    RopeInv ri;
    int ph_lo, ph_hi;
};
typedef const __attribute__((address_space(4))) P& CP;
#define VT_ (tid & 255)
#define VLOOP(NVB) for (int vb = bid * 2 + (tid >> 8); vb < (NVB); vb += (int)gridDim.x * 2)

namespace pg8 {
#define PG8_LAS __attribute__((address_space(3)))
typedef unsigned short bf16_t;
typedef short bf16x8 __attribute__((ext_vector_type(8)));
typedef float f32x4 __attribute__((ext_vector_type(4)));
typedef unsigned u32x4 __attribute__((ext_vector_type(4)));
constexpr int BM = 256, BK = 64, HALF = 128, HTB = HALF * BK * 2  , STAGE_BYTES = 8 * HTB, NXCD = 8, WGM = 8;

__host__ __device__ __forceinline__ int lds_byte(int r, int c) { const int st = (r >> 4) * 2 + (c >> 5), rr = r & 15, cc = c & 31, ob = rr * 64 + cc * 2; return st * 1024 + (ob ^ (((ob >> 9) & 1) << 5)); }
__host__ __device__ __forceinline__ void stage_rc(int b, int& R, int& C) { const int st = b / 1024, sb = b % 1024, swz = sb ^ (((sb >> 9) & 1) << 5); R = (st >> 1) * 16 + swz / 64; C = (st & 1) * 32 + (swz % 64) / 2; }
__host__ __device__ __forceinline__ int perm32(int rho) { const int n = rho >> 4, i = rho & 15; return 8 * (i >> 2) + 4 * n + (i & 3); }

struct Unit { int pm, pn, kind, nvalid, bstride; const char* A; const char* B; const int* rows; };
__device__ __forceinline__ void tile_of(int wgid, int nM, int nN, int& pm, int& pn) {
    const int nwg = nM * nN;
    { const int q = nwg / NXCD, r = nwg % NXCD, xcd = wgid % NXCD, off = wgid / NXCD; wgid = (xcd < r ? xcd * (q + 1) : r * (q + 1) + (xcd - r) * q) + off; }
    const int nig = WGM * nN, gid = wgid / nig, fm = gid * WGM, gsz = (nM - fm) < WGM ? (nM - fm) : WGM;
    pm = __builtin_amdgcn_readfirstlane(fm + ((wgid % nig) % gsz)); pn = __builtin_amdgcn_readfirstlane((wgid % nig) / gsz);
}
typedef _Float16 f16x8 __attribute__((ext_vector_type(8)));
template <bool F16> __device__ __forceinline__ f32x4 mma16(bf16x8 a, bf16x8 b, f32x4 c) {
    if constexpr (F16) return __builtin_amdgcn_mfma_f32_16x16x32_f16(__builtin_bit_cast(f16x8, a), __builtin_bit_cast(f16x8, b), c, 0, 0, 0);
    else return __builtin_amdgcn_mfma_f32_16x16x32_bf16(a, b, c, 0, 0, 0);
}
__device__ __forceinline__ unsigned cvt_pk_bf16(float lo, float hi) { unsigned r; asm volatile("v_cvt_pk_bf16_f32 %0, %1, %2" : "=v"(r) : "v"(lo), "v"(hi)); return r; }
template <class Epi, class Sched, bool ALIGN_EPI = false, bool SP2 = false, bool GATHER = false, bool F16 = false, bool BSTRIDE = false>
__device__ __forceinline__ void gemm_phase(const int tid, PG8_LAS unsigned char* lds, const int K, const Sched& S, const Epi& E) {
    const int wid = __builtin_amdgcn_readfirstlane(tid >> 6), lane = tid & 63, wr = wid >> 2, wc = wid & 3, fr = lane & 15, fq = lane >> 4;
    const int nt = K / BK;
    unsigned voffA[2], voffB[2];
#pragma unroll
    for (int i = 0; i < 2; ++i) { int R, C; stage_rc(tid * 16 + i * 8192, R, C); const int Rb = Epi::PERM ? ((R & ~31) + perm32(R & 31)) : R;
        voffA[i] = (unsigned)(R * K + C) * 2u; voffB[i] = (unsigned)(Rb * K + C) * 2u; }
    const size_t kstep = (size_t)(BK * 2);
    const size_t hstep = (size_t)HALF * K * 2;
    const unsigned ldsw = (unsigned)wid * 1024u;
    const int aoff = lds_byte(wr * 64 + fr, fq * 8), boff = lds_byte(wc * 32 + fr, fq * 8);
#define PG8_SA(b, h) (((b) * 2 + (h)) * HTB)
#define PG8_SB(b, h) ((4 + (b) * 2 + (h)) * HTB)
#define PG8_STAGE(bufoff, gbase, voff) do { _Pragma("unroll") for (int _i = 0; _i < 2; ++_i) \
        __builtin_amdgcn_global_load_lds((const unsigned*)((const char*)(gbase) + (voff)[_i]), (PG8_LAS unsigned*)(lds + (bufoff) + ldsw + _i * 8192), 16, 0, 0); } while (0)
#define PG8_STAGEA(bufoff, gbase, h, VG) do { if constexpr (GATHER) { PG8_STAGE(bufoff, gbase, VG[h]); } else { PG8_STAGE(bufoff, (gbase) + (h) * hstep, voffA); } } while (0)
#define PG8_STAGEB(bufoff, gbase, h, VB) do { if constexpr (BSTRIDE) { PG8_STAGE(bufoff, gbase, VB[h]); } else { PG8_STAGE(bufoff, (gbase) + (h) * hstep, voffB); } } while (0)
#define PG8_LDA(dst, b, h) do { _Pragma("unroll") for (int m = 0; m < 4; ++m) _Pragma("unroll") for (int k = 0; k < 2; ++k) dst[m][k] = *(const PG8_LAS bf16x8*)(lds + PG8_SA(b, h) + aoff + m * 2048 + k * 1024); } while (0)
#define PG8_LDB(dst, b, h) do { _Pragma("unroll") for (int n = 0; n < 2; ++n) _Pragma("unroll") for (int k = 0; k < 2; ++k) dst[n][k] = *(const PG8_LAS bf16x8*)(lds + PG8_SB(b, h) + boff + n * 2048 + k * 1024); } while (0)
#define PG8_MMA(ai, bj, At, Bt) do { __builtin_amdgcn_s_setprio(1); _Pragma("unroll") for (int m = 0; m < 4; ++m) _Pragma("unroll") for (int n = 0; n < 2; ++n) _Pragma("unroll") for (int k = 0; k < 2; ++k) \
        acc[ai][bj][m][n] = mma16<F16>(Bt[n][k], At[m][k], acc[ai][bj][m][n]); __builtin_amdgcn_s_setprio(0); } while (0)
#define PG8_WAIT_V(n) asm volatile("s_waitcnt vmcnt(" #n ")" ::: "memory")
#define PG8_WAIT_L(n) asm volatile("s_waitcnt lgkmcnt(" #n ")" ::: "memory")
#define PG8_BAR __builtin_amdgcn_s_barrier()
#define PG8_SCHED __builtin_amdgcn_sched_barrier(0)
    Unit cur, nxt; int ui = 0;
    if (!S.next(0, cur)) return;
    unsigned vgc[2][2] = {{0u, 0u}, {0u, 0u}}, vgn[2][2] = {{0u, 0u}, {0u, 0u}}, vga[2][2] = {{0u, 0u}, {0u, 0u}}; int Rg[2], Cg[2];
#pragma unroll
    for (int i = 0; i < 2; ++i) stage_rc(tid * 16 + i * 8192, Rg[i], Cg[i]);
#define PG8_LOADVG(dst, U) do { _Pragma("unroll") for (int h_ = 0; h_ < 2; ++h_) _Pragma("unroll") for (int i_ = 0; i_ < 2; ++i_) { const int r_ = h_ * HALF + Rg[i_]; const int tk_ = r_ < (U).nvalid ? (U).rows[r_] : 0; dst[h_][i_] = (unsigned)tk_ * (unsigned)(K * 2) + (unsigned)(Cg[i_] * 2); } } while (0)
    if constexpr (GATHER) PG8_LOADVG(vgc, cur);
    unsigned vbc[2][2] = {{0u, 0u}, {0u, 0u}}, vbn[2][2] = {{0u, 0u}, {0u, 0u}}, vbb[2][2] = {{0u, 0u}, {0u, 0u}}; int RBg[2];
#pragma unroll
    for (int i = 0; i < 2; ++i) RBg[i] = Epi::PERM ? ((Rg[i] & ~31) + perm32(Rg[i] & 31)) : Rg[i];
#define PG8_LOADVB(dst, U) do { _Pragma("unroll") for (int h_ = 0; h_ < 2; ++h_) _Pragma("unroll") for (int i_ = 0; i_ < 2; ++i_) dst[h_][i_] = (unsigned)(((h_ * HALF + RBg[i_]) * (U).bstride) * K + Cg[i_]) * 2u; } while (0)
    if constexpr (BSTRIDE) PG8_LOADVB(vbc, cur);
    f32x4 acc[2][2][4][2];
#pragma unroll
    for (int a = 0; a < 2; ++a)
#pragma unroll
        for (int b = 0; b < 2; ++b)
#pragma unroll
            for (int m = 0; m < 4; ++m)
#pragma unroll
                for (int n = 0; n < 2; ++n) acc[a][b][m][n] = (f32x4){0.f, 0.f, 0.f, 0.f};
    bf16x8 At[4][2], B0[2][2], B1[2][2];
    const char* cA = cur.A; const char* cB = cur.B;
    S.a_ready(cur);
    if constexpr (SP2) {
        PG8_STAGEB(PG8_SB(0, 0), cB, 0, vbc); PG8_STAGEB(PG8_SB(0, 1), cB, 1, vbc); PG8_STAGEA(PG8_SA(0, 0), cA, 0, vgc); PG8_STAGEA(PG8_SA(0, 1), cA, 1, vgc);
        if (wr == 1) PG8_BAR;
        PG8_WAIT_V(2); PG8_BAR;
        PG8_STAGEB(PG8_SB(1, 0), cB + kstep, 0, vbc); PG8_STAGEA(PG8_SA(1, 0), cA + kstep, 0, vgc); PG8_STAGEB(PG8_SB(1, 1), cB + kstep, 1, vbc);
        PG8_WAIT_V(6); PG8_BAR;
    } else {
        PG8_STAGEB(PG8_SB(0, 0), cB, 0, vbc); PG8_STAGEA(PG8_SA(0, 0), cA, 0, vgc); PG8_STAGEB(PG8_SB(0, 1), cB, 1, vbc); PG8_STAGEA(PG8_SA(0, 1), cA, 1, vgc);
        if (wr == 1) PG8_BAR;
        PG8_WAIT_V(4); PG8_BAR;
        PG8_STAGEB(PG8_SB(1, 0), cB + kstep, 0, vbc); PG8_STAGEA(PG8_SA(1, 0), cA + kstep, 0, vgc); PG8_STAGEB(PG8_SB(1, 1), cB + kstep, 1, vbc);
        PG8_WAIT_V(6); PG8_BAR;
    }
    for (;;) {
        const bool has_next = S.next(ui + 1, nxt);
        const char* nA = has_next ? nxt.A : cA; const char* nB = has_next ? nxt.B : cB;
        if constexpr (GATHER) { if (has_next) PG8_LOADVG(vgn, nxt); }
        if constexpr (BSTRIDE) { if (has_next) PG8_LOADVB(vbn, nxt); }
        for (int t = 0; t < nt; t += 2) {
            if constexpr (Epi::MIDK > 0) { if (t == Epi::MIDK) { int ln_; asm volatile("v_mbcnt_lo_u32_b32 %0, -1, 0\n\tv_mbcnt_hi_u32_b32 %0, -1, %0" : "=v"(ln_)); E.mid(acc, cur, wr, wc, ln_ & 15, ln_ >> 4); } }
            const bool last = (t == nt - 2);
            if constexpr (GATHER) { _Pragma("unroll") for (int h_ = 0; h_ < 2; ++h_) _Pragma("unroll") for (int i_ = 0; i_ < 2; ++i_) vga[h_][i_] = (last && has_next) ? vgn[h_][i_] : vgc[h_][i_]; }
            if constexpr (BSTRIDE) { _Pragma("unroll") for (int h_ = 0; h_ < 2; ++h_) _Pragma("unroll") for (int i_ = 0; i_ < 2; ++i_) vbb[h_][i_] = (last && has_next) ? vbn[h_][i_] : vbc[h_][i_]; }
            const char* a1 = cA + (size_t)(t + 1) * kstep;
            const char* a2 = last ? nA : cA + (size_t)(t + 2) * kstep; const char* b2 = last ? nB : cB + (size_t)(t + 2) * kstep;
            const char* a3 = a2 + kstep; const char* b3 = b2 + kstep;
            if (last && has_next) S.a_ready(nxt);
            if constexpr (SP2) {
            PG8_LDB(B0, 0, 0); PG8_LDB(B1, 0, 1); PG8_SCHED; PG8_LDA(At, 0, 0); PG8_STAGEA(PG8_SA(1, 1), a1, 1, vgc);
            PG8_WAIT_V(8); PG8_WAIT_L(0); PG8_BAR; PG8_MMA(0, 0, At, B0); PG8_MMA(0, 1, At, B1); PG8_BAR; PG8_SCHED;
            PG8_LDA(At, 0, 1); PG8_STAGEB(PG8_SB(0, 0), b2, 0, vbb); PG8_STAGEB(PG8_SB(0, 1), b2, 1, vbb); PG8_STAGEA(PG8_SA(0, 0), a2, 0, vga);
            PG8_WAIT_V(8); PG8_WAIT_L(0); PG8_BAR; PG8_MMA(1, 0, At, B0); PG8_MMA(1, 1, At, B1); PG8_BAR; PG8_SCHED;
            PG8_LDB(B0, 1, 0); PG8_LDB(B1, 1, 1); PG8_SCHED; PG8_LDA(At, 1, 0); PG8_STAGEA(PG8_SA(0, 1), a2, 1, vga);
            PG8_WAIT_V(8); PG8_WAIT_L(0); PG8_BAR; PG8_MMA(0, 0, At, B0); PG8_MMA(0, 1, At, B1); PG8_BAR; PG8_SCHED;
            PG8_LDA(At, 1, 1); PG8_STAGEB(PG8_SB(1, 0), b3, 0, vbb); PG8_STAGEB(PG8_SB(1, 1), b3, 1, vbb); PG8_STAGEA(PG8_SA(1, 0), a3, 0, vga);
            PG8_WAIT_V(8); PG8_WAIT_L(0); PG8_BAR; PG8_MMA(1, 0, At, B0); PG8_MMA(1, 1, At, B1); PG8_BAR; PG8_SCHED;
            } else {
            PG8_LDB(B0, 0, 0); PG8_SCHED; PG8_LDA(At, 0, 0); PG8_STAGEA(PG8_SA(1, 1), a1, 1, vgc);
            PG8_WAIT_L(8); PG8_BAR; PG8_WAIT_L(0); PG8_MMA(0, 0, At, B0); PG8_BAR; PG8_SCHED;
            PG8_LDB(B1, 0, 1); PG8_STAGEB(PG8_SB(0, 0), b2, 0, vbb);
            PG8_BAR; PG8_WAIT_L(0); PG8_MMA(0, 1, At, B1); PG8_BAR;
            PG8_LDA(At, 0, 1); PG8_STAGEA(PG8_SA(0, 0), a2, 0, vga);
            PG8_BAR; PG8_WAIT_L(0); PG8_MMA(1, 0, At, B0); PG8_BAR; PG8_SCHED;
            PG8_STAGEB(PG8_SB(0, 1), b2, 1, vbb);
            PG8_WAIT_V(6); PG8_BAR; PG8_MMA(1, 1, At, B1); PG8_BAR;
            PG8_LDB(B0, 1, 0); PG8_SCHED; PG8_LDA(At, 1, 0); PG8_STAGEA(PG8_SA(0, 1), a2, 1, vga);
            PG8_WAIT_L(8); PG8_BAR; PG8_WAIT_L(0); PG8_MMA(0, 0, At, B0); PG8_BAR; PG8_SCHED;
            PG8_LDB(B1, 1, 1); PG8_STAGEB(PG8_SB(1, 0), b3, 0, vbb);
            PG8_BAR; PG8_WAIT_L(0); PG8_MMA(0, 1, At, B1); PG8_BAR;
            PG8_LDA(At, 1, 1); PG8_STAGEA(PG8_SA(1, 0), a3, 0, vga);
            PG8_BAR; PG8_WAIT_L(0); PG8_MMA(1, 0, At, B0); PG8_BAR; PG8_SCHED;
            PG8_STAGEB(PG8_SB(1, 1), b3, 1, vbb);
            PG8_WAIT_V(6); PG8_BAR; PG8_MMA(1, 1, At, B1); PG8_BAR;
            }
        }
        if constexpr (ALIGN_EPI) { if (wr == 0) PG8_BAR; }
        if constexpr (!Epi::AFTER_DRAIN) { int ln_; asm volatile("v_mbcnt_lo_u32_b32 %0, -1, 0\n\tv_mbcnt_hi_u32_b32 %0, -1, %0" : "=v"(ln_)); E(acc, cur, wr, wc, ln_ & 15, ln_ >> 4); S.done(cur); }
        if (!has_next) break;
#pragma unroll
        for (int a = 0; a < 2; ++a)
#pragma unroll
            for (int b = 0; b < 2; ++b)
#pragma unroll
                for (int m = 0; m < 4; ++m)
#pragma unroll
                    for (int n = 0; n < 2; ++n) acc[a][b][m][n] = (f32x4){0.f, 0.f, 0.f, 0.f};
        cur = nxt; cA = nA; cB = nB; ++ui;
        if constexpr (GATHER) { _Pragma("unroll") for (int h_ = 0; h_ < 2; ++h_) _Pragma("unroll") for (int i_ = 0; i_ < 2; ++i_) vgc[h_][i_] = vgn[h_][i_]; }
        if constexpr (BSTRIDE) { _Pragma("unroll") for (int h_ = 0; h_ < 2; ++h_) _Pragma("unroll") for (int i_ = 0; i_ < 2; ++i_) vbc[h_][i_] = vbn[h_][i_]; }
        if constexpr (ALIGN_EPI) { if (wr == 1) PG8_BAR; }
    }
    PG8_WAIT_V(0);
    if constexpr (!ALIGN_EPI) { if (wr == 0) PG8_BAR; }
    PG8_BAR;
    if constexpr (Epi::AFTER_DRAIN) { E.fused(acc, cur, wr, wc, fr, fq, lds, wid, lane); S.done(cur); }
#undef PG8_SA
#undef PG8_STAGEA
#undef PG8_STAGEB
#undef PG8_LOADVB
#undef PG8_LOADVG
#undef PG8_SB
#undef PG8_STAGE
#undef PG8_LDA
#undef PG8_LDB
#undef PG8_MMA
#undef PG8_WAIT_V
#undef PG8_WAIT_L
#undef PG8_BAR
#undef PG8_SCHED
}
}

#define LAS __attribute__((address_space(3)))
using pg8::f32x4; using pg8::u32x4; using pg8::Unit;
__device__ __forceinline__ u32x4 pack8(const f32x4 a, const f32x4 b) { u32x4 w; w.x = pg8::cvt_pk_bf16(a[0], a[1]); w.y = pg8::cvt_pk_bf16(a[2], a[3]); w.z = pg8::cvt_pk_bf16(b[0], b[1]); w.w = pg8::cvt_pk_bf16(b[2], b[3]); return w; }
__device__ __forceinline__ float bflo(unsigned x) { return __uint_as_float(x << 16); }
__device__ __forceinline__ float bfhi(unsigned x) { return __uint_as_float(x & 0xffff0000u); }
typedef unsigned u32x2 __attribute__((ext_vector_type(2)));
__device__ __forceinline__ void nv_rope(const int tid, const int bid, CP p, float* rope) {
    VLOOP(1024) { const int idx = vb * 256 + VT_; const int j = idx % 32, pos = idx / 32;
        double rev = (double)pos * p.ri.inv[j] * 0.15915494309189535; rev -= floor(rev);
        rope[idx * 2] = cos_rev((float)rev); rope[idx * 2 + 1] = sin_rev((float)rev); }
}
__device__ __forceinline__ void nv_h3(const int tid, const int bid, CP p, _Float16* h3, unsigned char* sm) {
    float (*zs)[64] = (float (*)[64])sm; float (*hs)[64] = (float (*)[64])(sm + 1024);
    VLOOP(DEPTH * L / 4) {
        const int wv = VT_ >> 6, j = VT_ & 63;
        const int gi = vb * 4 + wv; const int layer = gi / L, l = gi % L;
        const float tpos = (float)l / (float)(L - 1);
        const float wrev = (float)l / (float)L;
        __syncthreads();
        if (j < HY_EMB) {
            float z;
            if (j == 0) z = tpos;
            else { const int i = (j - 1) % 16; const float f = 1e-4f + (15.0f - 1e-4f) * (float)i / 15.0f; z = (j <= 16) ? cos_rev(f * wrev) : -sin_rev(f * wrev); }
            zs[wv][j] = z;
        }
        __syncthreads();
        const float fr = p.hf_freq[layer * 64 + j];
        float a = p.hf_b1[layer * 64 + j];
        for (int i = 0; i < HY_EMB; ++i) a += zs[wv][i] * p.hf_w1[(layer * HY_EMB + i) * 64 + j];
        float h = sin_rad(fr * a);
        hs[wv][j] = h; __syncthreads();
        a = p.hf_b2[layer * 64 + j];
        for (int i = 0; i < 64; ++i) a += hs[wv][i] * p.hf_w2[(layer * 64 + i) * 64 + j];
        h = sin_rad(fr * a); __syncthreads();
        hs[wv][j] = h; __syncthreads();
        a = p.hf_b3[layer * 64 + j];
        for (int i = 0; i < 64; ++i) a += hs[wv][i] * p.hf_w3[(layer * 64 + i) * 64 + j];
        h = sin_rad(fr * a);
        h3[(size_t)gi * 256 + j] = (_Float16)h; h3[(size_t)gi * 256 + 64 + j] = (_Float16)0.f; h3[(size_t)gi * 256 + 128 + j] = (_Float16)0.f; h3[(size_t)gi * 256 + 192 + j] = (_Float16)0.f;
    }
}
__device__ __forceinline__ void nv_norm(const int tid, const int bid, const float* x_in, float* x_out, const float* g, const float* mod_l, bf16_t* XN, int combine, const bf16_t* YB, const int* POS, const float* WTS, const float* mod_prev) {
    VLOOP(T / 4) {
        const int row = vb * 4 + (VT_ >> 6), lane = VT_ & 63; const int b = row / L;
        float v[16]; float ss = 0.f;
#pragma unroll
        for (int j = 0; j < 4; ++j) {
            const int col = j * 256 + lane * 4;
            const float4 xv = *(const float4*)(x_in + (size_t)row * D + col);
            float t4[4] = {xv.x, xv.y, xv.z, xv.w};
            if (combine) {
                const int p0 = POS[row * 2], p1 = POS[row * 2 + 1]; const float w0 = WTS[row * 2], w1 = WTS[row * 2 + 1];
                const u32x2 ya = *(const u32x2*)(YB + (size_t)p0 * D + col), yb = *(const u32x2*)(YB + (size_t)p1 * D + col); const f32x4 g2v = *(const f32x4*)(mod_prev + b * 6144 + 5 * 1024 + col);
#pragma unroll
                for (int i = 0; i < 4; ++i) { const float y = w0 * (i & 1 ? bfhi(ya[i >> 1]) : bflo(ya[i >> 1])) + w1 * (i & 1 ? bfhi(yb[i >> 1]) : bflo(yb[i >> 1])); t4[i] += g2v[i] * y; }
            }
#pragma unroll
            for (int i = 0; i < 4; ++i) { v[j * 4 + i] = t4[i]; ss += t4[i] * t4[i]; }
            *(float4*)(x_out + (size_t)row * D + col) = make_float4(t4[0], t4[1], t4[2], t4[3]);
        }
        ss = wave_sum(ss, lane);
        const float rstd = rsqrtf(ss * (1.0f / D) + NORM_EPS);
#pragma unroll
        for (int j = 0; j < 4; ++j) { const int col = j * 256 + lane * 4; float y[4];
            const float4 gv = *(const float4*)(g + col), sc = *(const float4*)(mod_l + b * 6144 + 1024 + col), sh = *(const float4*)(mod_l + b * 6144 + col);
            y[0] = v[j * 4] * rstd * gv.x * (1.f + sc.x) + sh.x; y[1] = v[j * 4 + 1] * rstd * gv.y * (1.f + sc.y) + sh.y; y[2] = v[j * 4 + 2] * rstd * gv.z * (1.f + sc.z) + sh.z; y[3] = v[j * 4 + 3] * rstd * gv.w * (1.f + sc.w) + sh.w;
            u32x2 o; o.x = pg8::cvt_pk_bf16(y[0], y[1]); o.y = pg8::cvt_pk_bf16(y[2], y[3]);
            *(u32x2*)(XN + (size_t)row * D + col) = o; }
    }
}
__device__ __forceinline__ void nv_final(const int tid, const int bid, const float* x_in, float* out, const float* g, const float* mod_l, const bf16_t* YB, const int* POS, const float* WTS) {
    VLOOP(T / 4) {
        const int row = vb * 4 + (VT_ >> 6), lane = VT_ & 63; const int b = row / L;
        float v[16]; float ss = 0.f;
        const int p0 = POS[row * 2], p1 = POS[row * 2 + 1]; const float w0 = WTS[row * 2], w1 = WTS[row * 2 + 1];
#pragma unroll
        for (int j = 0; j < 4; ++j)
#pragma unroll
            for (int i = 0; i < 4; ++i) { const int col = j * 256 + lane * 4 + i;
                const float y = w0 * bf2f(YB[(size_t)p0 * D + col]) + w1 * bf2f(YB[(size_t)p1 * D + col]);
                const float t = x_in[(size_t)row * D + col] + mod_l[b * 6144 + 5 * 1024 + col] * y; v[j * 4 + i] = t; ss += t * t; }
        ss = wave_sum(ss, lane);
        const float rstd = rsqrtf(ss * (1.0f / D) + NORM_EPS);
#pragma unroll
        for (int j = 0; j < 4; ++j)
#pragma unroll
            for (int i = 0; i < 4; ++i) { const int col = j * 256 + lane * 4 + i; out[(size_t)row * D + col] = v[j * 4 + i] * rstd * g[col]; }
    }
}
__device__ __forceinline__ void nv_gemm1(const int tid, const int bid, const bf16_t* XN, const float* w_in, const float* rope, bf16_t* UT, bf16_t* QS, bf16_t* KS, bf16_t* VT, bf16_t* GATES, unsigned char* smraw) {
    float (*sm)[256] = (float (*)[256])smraw;
    VLOOP(26 * (T / 8)) {
        const int tx = VT_; const int n = (vb % 26) * 256 + tx, t0 = (vb / 26) * 8;
        float acc[8];
#pragma unroll
        for (int i = 0; i < 8; ++i) acc[i] = 0.f;
        for (int k = 0; k < D; ++k) { const float w = w_in[(size_t)k * INC + n];
#pragma unroll
            for (int i = 0; i < 8; ++i) acc[i] += bf2f(XN[(size_t)(t0 + i) * D + k]) * w; }
        __syncthreads();
#pragma unroll
        for (int i = 0; i < 8; ++i) sm[i][tx] = acc[i];
        __syncthreads();
#pragma unroll
        for (int i = 0; i < 8; ++i) {
            const int tt = t0 + i, b = tt / L, t = tt % L;
            if (n < C3) UT[(size_t)n * T + tt] = f2bf(acc[i]);
            else if (n < C3 + 2 * HYW) {
                const int isk = n >= C3 + HYW; const int cc = n - C3 - isk * HYW; const int h = cc / 64, d = cc % 64;
                if (d < 32) {
                    const float a = acc[i], bb = sm[i][tx + 32];
                    const float cs = rope[(t * 32 + d) * 2], sn = rope[(t * 32 + d) * 2 + 1];
                    float o1 = a * cs - bb * sn, o2 = bb * cs + a * sn;
                    if (!isk) { o1 *= QSCALE; o2 *= QSCALE; }
                    bf16_t* dst = (isk ? KS : QS) + qk_row(b, h, t) * 64;
                    dst[permd(d)] = f2bf(o1); dst[permd(d + 32)] = f2bf(o2);
                }
            } else if (n < C3 + 3 * HYW) { const int cc = n - C3 - 2 * HYW; VT[vt_off(b, cc / 64, t, cc % 64)] = f2bf(acc[i]); }
            else GATES[(size_t)tt * 2048 + (n - (C3 + 3 * HYW))] = f2bf(sigmoidf_(acc[i]));
        }
    }
}
__device__ __forceinline__ void nv_merge(const int tid, const int bid, const bf16_t* YCAT, const float* w_br_h, const float* w_br_a, const bf16_t* GATES, bf16_t* MERGED) {
    VLOOP(4 * (T / 8)) { const int n = (vb % 4) * 256 + VT_, t0 = (vb / 4) * 8;
        float a1[8], a2[8];
#pragma unroll
        for (int i = 0; i < 8; ++i) { a1[i] = 0.f; a2[i] = 0.f; }
        for (int k = 0; k < 768; ++k) { const float w = w_br_h[(size_t)k * D + n];
#pragma unroll
            for (int i = 0; i < 8; ++i) a1[i] += bf2f(YCAT[(size_t)(t0 + i) * D + k]) * w; }
        for (int k = 0; k < 256; ++k) { const float w = w_br_a[(size_t)k * D + n];
#pragma unroll
            for (int i = 0; i < 8; ++i) a2[i] += bf2f(YCAT[(size_t)(t0 + i) * D + 768 + k]) * w; }
#pragma unroll
        for (int i = 0; i < 8; ++i) { const size_t tt = t0 + i; MERGED[tt * D + n] = f2bf(bf2f(GATES[tt * 2048 + n]) * a1[i] + bf2f(GATES[tt * 2048 + 1024 + n]) * a2[i]); } }
}
__device__ __forceinline__ void nv_out(const int tid, const int bid, const bf16_t* MERGED, const float* w_out, const float* mod_l, float* x) {
    VLOOP(4 * (T / 8)) { const int n = (vb % 4) * 256 + VT_, t0 = (vb / 4) * 8;
        float a[8];
#pragma unroll
        for (int i = 0; i < 8; ++i) a[i] = 0.f;
        for (int k = 0; k < D; ++k) { const float w = w_out[(size_t)k * D + n];
#pragma unroll
            for (int i = 0; i < 8; ++i) a[i] += bf2f(MERGED[(size_t)(t0 + i) * D + k]) * w; }
#pragma unroll
        for (int i = 0; i < 8; ++i) { const size_t tt = t0 + i; const int b = (int)(tt / L); x[tt * D + n] += mod_l[b * 6144 + 2 * 1024 + n] * a[i]; } }
}
__device__ __forceinline__ void ph_route(const int tid, const int bid, CP p, int layer, unsigned char* ws, float* x, LAS unsigned char* lds) {
    const int lane = tid & 63, wave = tid >> 6;
    LAS float* rwt = (LAS float*)lds;
    LAS int* sel_l = (LAS int*)(lds + 65536);
    LAS int* rank_l = (LAS int*)(lds + 65536 + 512);
    LAS int* base_l = (LAS int*)(lds + 65536 + 1024);
    const float* g = p.norm2_g + layer * D; const float* mod_l = (const float*)(ws + WS_MOD) + (size_t)layer * NB * 6144;
    bf16_t* XN = (bf16_t*)(ws + WS_XN); int* SEL = (int*)(ws + WS_SEL); float* WTS = (float*)(ws + WS_WTS); int* CNT = (int*)(ws + WS_CTL + CTL_CNT) + layer * 1024;     int* LIST = (int*)(ws + WS_LIST); int* RANK = (int*)(ws + WS_RANK);
    for (int i = tid; i < 1024 * 4; i += 512) { const int col = i >> 2, e4 = (i & 3) * 4; const float4 w = *(const float4*)(p.router_w + (size_t)col * 16 + e4);
        rwt[(e4 + 0) * 1024 + col] = w.x; rwt[(e4 + 1) * 1024 + col] = w.y; rwt[(e4 + 2) * 1024 + col] = w.z; rwt[(e4 + 3) * 1024 + col] = w.w; }
    __syncthreads();
    for (int blk = bid; blk < T / 64; blk += (int)gridDim.x) {
#pragma unroll 1
        for (int it = 0; it < 8; ++it) {
            const int rl = it * 8 + wave, row = blk * 64 + rl; const int b = row / L;
            float v[16]; float ss = 0.f;
#pragma unroll
            for (int j = 0; j < 4; ++j) { const float4 xv = *(const float4*)(x + (size_t)row * D + j * 256 + lane * 4); v[j * 4] = xv.x; v[j * 4 + 1] = xv.y; v[j * 4 + 2] = xv.z; v[j * 4 + 3] = xv.w; ss += xv.x * xv.x + xv.y * xv.y + xv.z * xv.z + xv.w * xv.w; }
            ss = wave_sum(ss, lane);
            const float rstd = rsqrtf(ss * (1.0f / D) + NORM_EPS);
#pragma unroll
            for (int j = 0; j < 4; ++j) { const int col = j * 256 + lane * 4;
                const float4 gv = *(const float4*)(g + col), sc = *(const float4*)(mod_l + b * 6144 + 4 * 1024 + col), sh = *(const float4*)(mod_l + b * 6144 + 3 * 1024 + col);
                v[j * 4] = v[j * 4] * rstd * gv.x * (1.f + sc.x) + sh.x; v[j * 4 + 1] = v[j * 4 + 1] * rstd * gv.y * (1.f + sc.y) + sh.y;
                v[j * 4 + 2] = v[j * 4 + 2] * rstd * gv.z * (1.f + sc.z) + sh.z; v[j * 4 + 3] = v[j * 4 + 3] * rstd * gv.w * (1.f + sc.w) + sh.w;
                u32x2 o; o.x = pg8::cvt_pk_bf16(v[j * 4], v[j * 4 + 1]); o.y = pg8::cvt_pk_bf16(v[j * 4 + 2], v[j * 4 + 3]);
                *(u32x2*)(XN + (size_t)row * D + col) = o; }
            float lg[16];
#pragma unroll
            for (int e = 0; e < 16; ++e) { float a = 0.f;
#pragma unroll
                for (int j = 0; j < 4; ++j) { const f32x4 w = *(const LAS f32x4*)(rwt + e * 1024 + j * 256 + lane * 4); a += v[j * 4] * w[0] + v[j * 4 + 1] * w[1] + v[j * 4 + 2] * w[2] + v[j * 4 + 3] * w[3]; }
                lg[e] = a; }
#pragma unroll
            for (int e = 0; e < 16; ++e) lg[e] = wave_sum(lg[e], lane);
            if (lane == 0) {
                float sc[16], bi[16];
#pragma unroll
                for (int e = 0; e < 16; ++e) { sc[e] = 1.f / (1.f + expf(-lg[e])); bi[e] = sc[e] + p.router_bias[e]; }
                int sel = 0; float best = -1e30f;
#pragma unroll
                for (int gq = 0; gq < 4; ++gq) { float m1 = -1e30f, m2 = -1e30f;
#pragma unroll
                    for (int i = 0; i < 4; ++i) { const float vv = bi[gq * 4 + i]; if (vv > m1) { m2 = m1; m1 = vv; } else if (vv > m2) m2 = vv; }
                    const float gs = m1 + m2; if (gs > best) { best = gs; sel = gq; } }
                float gv[4], gsc[4];
#pragma unroll
                for (int i = 0; i < 4; ++i) { gv[i] = 0.f; gsc[i] = 0.f; }
#pragma unroll
                for (int gq = 0; gq < 4; ++gq)
#pragma unroll
                    for (int i = 0; i < 4; ++i) { if (gq == sel) { gv[i] = bi[gq * 4 + i]; gsc[i] = sc[gq * 4 + i]; } }
                int i1 = 0; float m1 = gv[0];
#pragma unroll
                for (int i = 1; i < 4; ++i) { if (gv[i] > m1) { m1 = gv[i]; i1 = i; } }
                int i2 = 0; float m2 = -1e30f;
#pragma unroll
                for (int i = 0; i < 4; ++i) { if (i != i1 && gv[i] > m2) { m2 = gv[i]; i2 = i; } }
                float s1 = 0.f, s2 = 0.f;
#pragma unroll
                for (int i = 0; i < 4; ++i) { s1 = (i == i1) ? gsc[i] : s1; s2 = (i == i2) ? gsc[i] : s2; }
                const int e1 = sel * 4 + i1, e2 = sel * 4 + i2; const float s = s1 + s2;
                SEL[row * 2] = e1; SEL[row * 2 + 1] = e2; WTS[row * 2] = s1 / s; WTS[row * 2 + 1] = s2 / s;
                sel_l[rl * 2] = e1; sel_l[rl * 2 + 1] = e2;
            }
        }
        __syncthreads();
        if (tid < 16) { int cnt = 0;
            for (int i = 0; i < 128; ++i) { if (sel_l[i] == tid) { rank_l[i] = cnt; ++cnt; } }
            base_l[tid] = cnt ? atomicAdd(CNT + tid * 64, cnt) : 0; }
        __syncthreads();
        if (tid < 128) { const int e = sel_l[tid], r = base_l[e] + rank_l[tid], row = blk * 64 + (tid >> 1); LIST[e * 16384 + r] = row; RANK[row * 2 + (tid & 1)] = r; }
        __syncthreads();
    }
}
__device__ __forceinline__ void nv_moe_up(const int tid, const int bid, const bf16_t* XN, const int* SEL, const float* w1, const float* w3, bf16_t* ACT) {
    VLOOP(T * 2) { const int rs = vb; const int tok = rs >> 1; const int e = SEL[rs];
        const float* W1 = w1 + (size_t)e * D * DEXP; const float* W3 = w3 + (size_t)e * D * DEXP;
        const int f = VT_;
        float a1 = 0.f, a3 = 0.f, c1 = 0.f, c3 = 0.f;
        for (int k = 0; k < D; ++k) { const float h = bf2f(XN[(size_t)tok * D + k]); a1 += h * W1[(size_t)k * DEXP + f]; a3 += h * W3[(size_t)k * DEXP + f]; c1 += h * W1[(size_t)k * DEXP + 256 + f]; c3 += h * W3[(size_t)k * DEXP + 256 + f]; }
        ACT[(size_t)rs * DEXP + f] = f2bf(siluf_(a1) * a3); ACT[(size_t)rs * DEXP + 256 + f] = f2bf(siluf_(c1) * c3); }
}
__device__ __forceinline__ void nv_moe_down(const int tid, const int bid, const bf16_t* ACT, const int* SEL, const float* w2, bf16_t* YB) {
    VLOOP(T * 2) { const int rs = vb; const int e = SEL[rs];
        const float* W2 = w2 + (size_t)e * DEXP * D;
        float a[4] = {0.f, 0.f, 0.f, 0.f};
        for (int k = 0; k < DEXP; ++k) { const float h = bf2f(ACT[(size_t)rs * DEXP + k]);
#pragma unroll
            for (int j = 0; j < 4; ++j) a[j] += h * W2[(size_t)k * D + j * 256 + VT_]; }
#pragma unroll
        for (int j = 0; j < 4; ++j) YB[(size_t)rs * D + j * 256 + VT_] = f2bf(a[j]); }
}


__device__ __forceinline__ void cvt_item(const float* W, int ldw, int ncol0, bf16_t* WT, int ldk, int koff, int rowmap, int rowbase, int nblk, int item, LAS float* scr, int lane) {
    const int kb = item / nblk, nb = item % nblk, k0 = 64 * kb, n0 = 32 * nb;
#pragma unroll
    for (int i = 0; i < 8; ++i) { const int kk = 8 * i + (lane >> 3), nn = (lane & 7) * 4; const float4 w4 = *(const float4*)(W + (size_t)(k0 + kk) * ldw + ncol0 + n0 + nn);
        LAS float* d = scr + kk * 33 + nn; d[0] = w4.x; d[1] = w4.y; d[2] = w4.z; d[3] = w4.w; }
    asm volatile("s_waitcnt lgkmcnt(0)" ::: "memory");
    const int c = lane & 7;
#pragma unroll
    for (int j = 0; j < 4; ++j) { const int n = (lane >> 3) + 8 * j; const LAS float* s = scr + (8 * c) * 33 + n; const int nrel = n0 + n;
        const int row = rowbase + (rowmap == 0 ? nrel : (rowmap == 1 ? ((nrel & ~63) + permd(nrel & 63)) : ((nrel >> 7) * 256 + (nrel & 127))));
        u32x4 o; o.x = pg8::cvt_pk_bf16(s[0 * 33], s[1 * 33]); o.y = pg8::cvt_pk_bf16(s[2 * 33], s[3 * 33]); o.z = pg8::cvt_pk_bf16(s[4 * 33], s[5 * 33]); o.w = pg8::cvt_pk_bf16(s[6 * 33], s[7 * 33]);
        *(u32x4*)(WT + (size_t)row * ldk + koff + k0 + 8 * c) = o; }
    asm volatile("s_waitcnt lgkmcnt(0)" ::: "memory");
}
__device__ __forceinline__ void ph_convert(const int tid, const int bid, CP p, int layer, unsigned char* ws, LAS unsigned char* lds) {
    const int lane = tid & 63, wave = tid >> 6;
    LAS float* scr = (LAS float*)(lds + wave * 8704);
    const float* w_in = p.w_in + (size_t)layer * D * INC;
    bf16_t* WA = (bf16_t*)(ws + WS_WA); bf16_t* WB = (bf16_t*)(ws + WS_WB); bf16_t* WCAT = (bf16_t*)(ws + WS_WCAT); bf16_t* WOUT = (bf16_t*)(ws + WS_WOUT);
    bf16_t* W13 = (bf16_t*)(ws + WS_W13); bf16_t* W2 = (bf16_t*)(ws + WS_W2);
    const int gw = bid * 8 + wave, NGW = gridDim.x * 8;
    for (int it = gw; it < 16640; it += NGW) {
        int r = it;
        if (r < 768) { cvt_item(w_in, INC, 2304, WA, 1024, 0, 1, 0, 48, r, scr, lane); continue; } r -= 768;
        if (r < 1024) { cvt_item(w_in, INC, 4608, WA, 1024, 0, 0, 1536, 64, r, scr, lane); continue; } r -= 1024;
        if (r < 1152) { cvt_item(w_in, INC, 0, WB, 1024, 0, 0, 0, 72, r, scr, lane); continue; } r -= 1152;
        if (r < 384) { cvt_item(w_in, INC, 3840, WB, 1024, 0, 0, 2304, 24, r, scr, lane); continue; } r -= 384;
        if (r < 384) { cvt_item(p.w_br_h + (size_t)layer * HYW * D, D, 0, WCAT, 1024, 0, 0, 0, 32, r, scr, lane); continue; } r -= 384;
        if (r < 128) { cvt_item(p.w_br_a + (size_t)layer * ATT_OUT * D, D, 0, WCAT, 1024, 768, 0, 0, 32, r, scr, lane); continue; } r -= 128;
        if (r < 512) { cvt_item(p.w_out + (size_t)layer * D * D, D, 0, WOUT, 1024, 0, 0, 0, 32, r, scr, lane); continue; } r -= 512;
        const int e = r / 768; r -= e * 768;
        if (r < 256) cvt_item(p.moe_w1 + ((size_t)layer * NE + e) * D * DEXP, DEXP, 0, W13 + (size_t)e * 1024 * 1024, 1024, 0, 2, 0, 16, r, scr, lane);
        else if (r < 512) cvt_item(p.moe_w3 + ((size_t)layer * NE + e) * D * DEXP, DEXP, 0, W13 + (size_t)e * 1024 * 1024, 1024, 0, 2, 128, 16, r - 256, scr, lane);
        else cvt_item(p.moe_w2 + ((size_t)layer * NE + e) * DEXP * D, D, 0, W2 + (size_t)e * 1024 * 512, 512, 0, 0, 0, 32, r - 512, scr, lane);
    }
}

struct SchedG1a {
    const char *XN, *WA; int G, c;
    __device__ __forceinline__ bool next(int i, Unit& u) const {
        const int id = i * G + c; if (id >= 896) return false;
        pg8::tile_of(id, 64, 14, u.pm, u.pn); u.kind = 0; u.bstride = 1; u.A = XN + (size_t)u.pm * 524288; u.B = WA + (size_t)u.pn * 524288; return true;
    }
    __device__ __forceinline__ void a_ready(const Unit&) const {}
    __device__ __forceinline__ void done(const Unit&) const {}
};
struct SchedG1b {
    const char *XN, *WB; int G, c;
    __device__ __forceinline__ bool next(int i, Unit& u) const {
        const int id = i * G + c; if (id >= 768) return false;
        pg8::tile_of(id, 12, 64, u.pm, u.pn); u.kind = 1; u.A = WB + (size_t)u.pm * 524288;
        if (u.pm < 9) { u.bstride = 1; u.B = XN + (size_t)u.pn * 524288; u.nvalid = 0; }
        else { const int lsh = u.pm == 9 ? 13 : (u.pm == 10 ? 11 : 9), d = 1 << (13 - lsh), b = u.pn >> 5, v0 = (u.pn & 31) * 256, r = v0 >> lsh, m0 = v0 & ((1 << lsh) - 1);
            u.bstride = d; u.nvalid = r; u.B = XN + (size_t)(b * L + m0 * d + r) * 2048; }
        return true;
    }
    __device__ __forceinline__ void a_ready(const Unit&) const {}
    __device__ __forceinline__ void done(const Unit&) const {}
};
struct SchedDense {
    const char *A, *B; int nM, nN, G, c; size_t tstep;
    __device__ __forceinline__ bool next(int i, Unit& u) const {
        const int id = i * G + c; if (id >= nM * nN) return false;
        pg8::tile_of(id, nM, nN, u.pm, u.pn); u.kind = 0; u.A = A + (size_t)u.pm * tstep; u.B = B + (size_t)u.pn * tstep; return true;
    }
    __device__ __forceinline__ void a_ready(const Unit&) const {}
    __device__ __forceinline__ void done(const Unit&) const {}
};
struct EpiG1a {
    static constexpr bool PERM = true, AFTER_DRAIN = false; static constexpr int MIDK = 0;
    unsigned char* ws;
    __device__ __forceinline__ void mid(f32x4 (&)[2][2][4][2], const Unit&, int, int, int, int) const {}
    __device__ __forceinline__ void operator()(const f32x4 (&acc)[2][2][4][2], const Unit& u, int wr, int wc, int fr, int fq) const {
        asm volatile("" : "+v"(fr), "+v"(fq));
        unsigned wlo_ = __builtin_amdgcn_readfirstlane((unsigned)(uintptr_t)ws), whi_ = __builtin_amdgcn_readfirstlane((unsigned)((uintptr_t)ws >> 32)); asm volatile("" : "+s"(wlo_), "+s"(whi_));
        unsigned char* w_ = (unsigned char*)(((uintptr_t)whi_ << 32) | wlo_);
        bf16_t *UT = (bf16_t*)(w_ + WS_UT), *QS = (bf16_t*)(w_ + WS_QS), *KS = (bf16_t*)(w_ + WS_KS), *VT = (bf16_t*)(w_ + WS_VT), *GATES = (bf16_t*)(w_ + WS_GATES); const float* rope = (const float*)(w_ + WS_ROPE);
        {
            const int colt = u.pn * 256;
#pragma unroll
            for (int ai = 0; ai < 2; ++ai)
#pragma unroll
                for (int m = 0; m < 4; ++m) { const int tok = u.pm * 256 + ai * 128 + wr * 64 + m * 16 + fr; const int b = tok >> 13, t = tok & 8191;
#pragma unroll
                    for (int bj = 0; bj < 2; ++bj) { const int c0 = colt + bj * 128 + wc * 32 + 8 * fq;
                        const f32x4 v0 = acc[ai][bj][m][0], v1 = acc[ai][bj][m][1];
                        if (colt < 1536) {
                            const int isk = colt >= 768; const int cc = c0 - isk * 768, h = cc >> 6, pc = cc & 63, j0 = pc >> 1;
                            const f32x4 r0 = *(const f32x4*)(rope + ((size_t)t * 32 + j0) * 2), r1 = *(const f32x4*)(rope + ((size_t)t * 32 + j0 + 2) * 2);
                            f32x4 o0, o1;
                            o0[0] = v0[0] * r0[0] - v0[1] * r0[1]; o0[1] = v0[1] * r0[0] + v0[0] * r0[1]; o0[2] = v0[2] * r0[2] - v0[3] * r0[3]; o0[3] = v0[3] * r0[2] + v0[2] * r0[3];
                            o1[0] = v1[0] * r1[0] - v1[1] * r1[1]; o1[1] = v1[1] * r1[0] + v1[0] * r1[1]; o1[2] = v1[2] * r1[2] - v1[3] * r1[3]; o1[3] = v1[3] * r1[2] + v1[2] * r1[3];
                            if (!isk) { o0 = o0 * QSCALE; o1 = o1 * QSCALE; }
                            *(u32x4*)((isk ? KS : QS) + qk_row(b, h, t) * 64 + pc) = pack8(o0, o1);
                        } else {
                            f32x4 s0, s1;
#pragma unroll
                            for (int i = 0; i < 4; ++i) { s0[i] = sigmoidf_(v0[i]); s1[i] = sigmoidf_(v1[i]); }
                            *(u32x4*)(GATES + (size_t)tok * 2048 + (c0 - 1536)) = pack8(s0, s1);
                        } }
                    asm volatile("" ::: "memory"); }
        }
    }
};
struct EpiG1b {
    static constexpr bool PERM = true, AFTER_DRAIN = false; static constexpr int MIDK = 0;
    unsigned char* ws;
    __device__ __forceinline__ void mid(f32x4 (&)[2][2][4][2], const Unit&, int, int, int, int) const {}
    __device__ __forceinline__ void operator()(const f32x4 (&acc)[2][2][4][2], const Unit& u, int wr, int wc, int fr, int fq) const {
        asm volatile("" : "+v"(fr), "+v"(fq));
        unsigned wlo_ = __builtin_amdgcn_readfirstlane((unsigned)(uintptr_t)ws), whi_ = __builtin_amdgcn_readfirstlane((unsigned)((uintptr_t)ws >> 32)); asm volatile("" : "+s"(wlo_), "+s"(whi_));
        unsigned char* w_ = (unsigned char*)(((uintptr_t)whi_ << 32) | wlo_);
        bf16_t *UT = (bf16_t*)(w_ + WS_UT), *QS = (bf16_t*)(w_ + WS_QS), *KS = (bf16_t*)(w_ + WS_KS), *VT = (bf16_t*)(w_ + WS_VT), *GATES = (bf16_t*)(w_ + WS_GATES); const float* rope = (const float*)(w_ + WS_ROPE);
        {
#pragma unroll
            for (int ai = 0; ai < 2; ++ai)
#pragma unroll
                for (int m = 0; m < 4; ++m) { const int row = u.pm * 256 + ai * 128 + wr * 64 + m * 16 + fr;
#pragma unroll
                    for (int bj = 0; bj < 2; ++bj) { const int vi = bj * 128 + wc * 32 + 8 * fq;
                        const u32x4 w = pack8(acc[ai][bj][m][0], acc[ai][bj][m][1]);
                        if (u.pm < 9) *(u32x4*)(UT + (size_t)row * T + u.pn * 256 + vi) = w;
                        else { const int lsh = u.pm == 9 ? 13 : (u.pm == 10 ? 11 : 9); const int cc = row - 2304, h = cc >> 6, dv = cc & 63, b = u.pn >> 5, m0 = ((u.pn & 31) * 256) & ((1 << lsh) - 1);
                            *(u32x4*)(VT + (size_t)(b * NH + h) * L * 64 + ((size_t)(u.nvalid * 64 + dv) << lsh) + m0 + vi) = w; } }
                    asm volatile("" ::: "memory"); }
        }
    }
};
struct EpiMerge {
    static constexpr bool PERM = true, AFTER_DRAIN = false; static constexpr int MIDK = 12;
    unsigned char* ws;
    __device__ __forceinline__ void mid(f32x4 (&acc)[2][2][4][2], const Unit& u, int wr, int wc, int fr, int fq) const {
        asm volatile("" : "+v"(fr), "+v"(fq));
        unsigned char* w_ = ws; asm volatile("" : "+s"(w_)); const bf16_t* GATES = (const bf16_t*)(w_ + WS_GATES);
#pragma unroll
        for (int ai = 0; ai < 2; ++ai)
#pragma unroll
            for (int m = 0; m < 4; ++m) { const int tok = u.pm * 256 + ai * 128 + wr * 64 + m * 16 + fr;
#pragma unroll
                for (int bj = 0; bj < 2; ++bj) { const int c0 = u.pn * 256 + bj * 128 + wc * 32 + 8 * fq;
                    const u32x4 g1 = *(const u32x4*)(GATES + (size_t)tok * 2048 + c0), g2 = *(const u32x4*)(GATES + (size_t)tok * 2048 + 1024 + c0);
#pragma unroll
                    for (int i = 0; i < 4; ++i) { const float rl = bflo(g1[i]) * __builtin_amdgcn_rcpf(fmaxf(bflo(g2[i]), 1e-20f)), rh = bfhi(g1[i]) * __builtin_amdgcn_rcpf(fmaxf(bfhi(g2[i]), 1e-20f));
                        acc[ai][bj][m][i >> 1][(i & 1) * 2] *= rl; acc[ai][bj][m][i >> 1][(i & 1) * 2 + 1] *= rh; } }
                asm volatile("" : "+v"(acc[ai][0][m][0]), "+v"(acc[ai][0][m][1]), "+v"(acc[ai][1][m][0]), "+v"(acc[ai][1][m][1]) :: "memory"); }
    }
    __device__ __forceinline__ void operator()(const f32x4 (&acc)[2][2][4][2], const Unit& u, int wr, int wc, int fr, int fq) const {
        asm volatile("" : "+v"(fr), "+v"(fq));
        unsigned char* w_ = ws; asm volatile("" : "+s"(w_)); const bf16_t* GATES = (const bf16_t*)(w_ + WS_GATES); bf16_t* MERGED = (bf16_t*)(w_ + WS_MERGED);
#pragma unroll
        for (int ai = 0; ai < 2; ++ai)
#pragma unroll
            for (int m = 0; m < 4; ++m) { const int tok = u.pm * 256 + ai * 128 + wr * 64 + m * 16 + fr;
#pragma unroll
                for (int bj = 0; bj < 2; ++bj) { const int c0 = u.pn * 256 + bj * 128 + wc * 32 + 8 * fq;
                    const u32x4 g2 = *(const u32x4*)(GATES + (size_t)tok * 2048 + 1024 + c0);
                    f32x4 o0 = acc[ai][bj][m][0], o1 = acc[ai][bj][m][1];
                    o0[0] *= fmaxf(bflo(g2[0]), 1e-20f); o0[1] *= fmaxf(bfhi(g2[0]), 1e-20f); o0[2] *= fmaxf(bflo(g2[1]), 1e-20f); o0[3] *= fmaxf(bfhi(g2[1]), 1e-20f);
                    o1[0] *= fmaxf(bflo(g2[2]), 1e-20f); o1[1] *= fmaxf(bfhi(g2[2]), 1e-20f); o1[2] *= fmaxf(bflo(g2[3]), 1e-20f); o1[3] *= fmaxf(bfhi(g2[3]), 1e-20f);
                    *(u32x4*)(MERGED + (size_t)tok * D + c0) = pack8(o0, o1); } }
    }
};
struct EpiOut {
    static constexpr bool PERM = true, AFTER_DRAIN = false; static constexpr int MIDK = 0;
    float* xo; unsigned char* ws; int layer;
    __device__ __forceinline__ void mid(f32x4 (&)[2][2][4][2], const Unit&, int, int, int, int) const {}
    __device__ __forceinline__ void operator()(const f32x4 (&acc)[2][2][4][2], const Unit& u, int wr, int wc, int fr, int fq) const {
        asm volatile("" : "+v"(fr), "+v"(fq));
        unsigned char* w_ = ws; float* x = xo; asm volatile("" : "+s"(w_), "+s"(x)); const float* mod_l = (const float*)(w_ + WS_MOD) + (size_t)layer * NB * 6144;
#pragma unroll
        for (int ai = 0; ai < 2; ++ai)
#pragma unroll
            for (int m = 0; m < 4; ++m) { const int tok = u.pm * 256 + ai * 128 + wr * 64 + m * 16 + fr; const int b = tok >> 13;
#pragma unroll
                for (int bj = 0; bj < 2; ++bj) { const int c0 = u.pn * 256 + bj * 128 + wc * 32 + 8 * fq;
                    float* xp = x + (size_t)tok * D + c0; const float* gp = mod_l + b * 6144 + 2048 + c0;
                    const f32x4 g0 = *(const f32x4*)gp, g1 = *(const f32x4*)(gp + 4);
                    const f32x4 x0 = *(const f32x4*)xp, x1 = *(const f32x4*)(xp + 4);
                    *(f32x4*)xp = x0 + g0 * acc[ai][bj][m][0]; *(f32x4*)(xp + 4) = x1 + g1 * acc[ai][bj][m][1]; } }
    }
};


__device__ __forceinline__ void ph_w4t(const int tid, const int bid, CP p, _Float16* W4T) {
    for (int idx = bid * 512 + tid; idx < DEPTH * 1536 * 256; idx += (int)gridDim.x * 512) { const int kq = idx & 255, n = (idx >> 8) % 1536, l = idx / (1536 * 256);
        W4T[idx] = (_Float16)(kq < 64 ? p.hf_w4[((size_t)l * 64 + kq) * 1536 + n] : 0.f); }
}
struct EpiTaps {
    static constexpr bool PERM = true, AFTER_DRAIN = false; static constexpr int MIDK = 0;
    unsigned char* ws;
    __device__ __forceinline__ void mid(f32x4 (&)[2][2][4][2], const Unit&, int, int, int, int) const {}
    __device__ __forceinline__ void operator()(const f32x4 (&acc)[2][2][4][2], const Unit& u, int wr, int wc, int fr, int fq) const {
        asm volatile("" : "+v"(fr), "+v"(fq));
        unsigned char* w_ = ws; asm volatile("" : "+s"(w_)); _Float16* FILT = (_Float16*)(w_ + WS_FILT);
#pragma unroll
        for (int ai = 0; ai < 2; ++ai)
#pragma unroll
            for (int m = 0; m < 4; ++m) { const int row = u.pm * 256 + ai * 128 + wr * 64 + m * 16 + fr; const int dir = row >= 768 ? 1 : 0, c = row - dir * 768;
                const float kc = -(3.0701134573253945f + (15.350567286626972f - 3.0701134573253945f) * (float)c * (1.0f / 767.0f)) * (1.4426950408889634f / 8191.0f);
#pragma unroll
                for (int bj = 0; bj < 2; ++bj) { const int l0 = u.pn * 256 + bj * 128 + wc * 32 + 8 * fq;
                    pg8::f16x8 o;
#pragma unroll
                    for (int i = 0; i < 8; ++i) o[i] = (_Float16)(acc[ai][bj][m][i >> 2][i & 3] * exp2f(kc * (float)(l0 + i)));
                    *(pg8::f16x8*)(FILT + (size_t)c * 16384 + dir * 8192 + l0) = o; } }
    }
};

__device__ __forceinline__ void ph_moe_prep(const int tid, const int bid, unsigned char* ws, int layer) {
    const int* CNT = (const int*)(ws + WS_CTL + CTL_CNT) + layer * 1024; const int* SEL = (const int*)(ws + WS_SEL); const int* RANK = (const int*)(ws + WS_RANK); int* POS = (int*)(ws + WS_POS);
    int base[16]; int acc = 0;
#pragma unroll
    for (int e = 0; e < 16; ++e) { base[e] = acc; acc += (__hip_atomic_load(CNT + e * 64, __ATOMIC_RELAXED, __HIP_MEMORY_SCOPE_AGENT) + 255) & ~255; }
    for (int idx = bid * 512 + tid; idx < T * 2; idx += (int)gridDim.x * 512) { const int e = SEL[idx]; int b = 0;
#pragma unroll
        for (int k = 0; k < 16; ++k) b = (k == e) ? base[k] : b;
        POS[idx] = b + RANK[idx]; }
}
struct SchedMoe {
    const int* CNT; const char* A; const char* B; const int* LIST; size_t bstrideE, tstepA, tstepB; int gather, G, c;
    __device__ __forceinline__ bool next(int i, Unit& u) const {
        const int id = i * G + c; int q = id >> 2; const int ct = id & 3; int e = 0, tile0 = 0, ce = 0;
        for (; e < 16; ++e) { ce = __builtin_amdgcn_readfirstlane(__hip_atomic_load(CNT + e * 64, __ATOMIC_RELAXED, __HIP_MEMORY_SCOPE_AGENT));   const int n = (ce + 255) >> 8; if (q < n) break; q -= n; tile0 += n; }
        if (e == 16) return false;
        u.pm = tile0 + q; u.pn = ct; u.kind = e; u.nvalid = ce - q * 256 < 256 ? ce - q * 256 : 256;
        u.B = B + (size_t)e * bstrideE + (size_t)ct * tstepB;
        if (gather) { u.A = A; u.rows = LIST + e * 16384 + q * 256; } else { u.A = A + (size_t)u.pm * tstepA; u.rows = nullptr; }
        return true;
    }
    __device__ __forceinline__ void a_ready(const Unit&) const {}
    __device__ __forceinline__ void done(const Unit&) const {}
};
struct EpiMoeUp {
    static constexpr bool PERM = true, AFTER_DRAIN = false; static constexpr int MIDK = 0;
    unsigned char* ws;
    __device__ __forceinline__ void mid(f32x4 (&)[2][2][4][2], const Unit&, int, int, int, int) const {}
    __device__ __forceinline__ void operator()(const f32x4 (&acc)[2][2][4][2], const Unit& u, int wr, int wc, int fr, int fq) const {
        asm volatile("" : "+v"(fr), "+v"(fq));
        unsigned char* w_ = ws; asm volatile("" : "+s"(w_)); bf16_t* ACT = (bf16_t*)(w_ + WS_ACT);
#pragma unroll
        for (int ai = 0; ai < 2; ++ai)
#pragma unroll
            for (int m = 0; m < 4; ++m) { const int row = u.pm * 256 + ai * 128 + wr * 64 + m * 16 + fr;
                f32x4 o0, o1;
#pragma unroll
                for (int i = 0; i < 4; ++i) { o0[i] = siluf_(acc[ai][0][m][0][i]) * acc[ai][1][m][0][i]; o1[i] = siluf_(acc[ai][0][m][1][i]) * acc[ai][1][m][1][i]; }
                *(u32x4*)(ACT + (size_t)row * DEXP + u.pn * 128 + wc * 32 + 8 * fq) = pack8(o0, o1); }
    }
};
struct EpiMoeDown {
    static constexpr bool PERM = true, AFTER_DRAIN = false; static constexpr int MIDK = 0;
    unsigned char* ws;
    __device__ __forceinline__ void mid(f32x4 (&)[2][2][4][2], const Unit&, int, int, int, int) const {}
    __device__ __forceinline__ void operator()(const f32x4 (&acc)[2][2][4][2], const Unit& u, int wr, int wc, int fr, int fq) const {
        asm volatile("" : "+v"(fr), "+v"(fq));
        unsigned char* w_ = ws; asm volatile("" : "+s"(w_)); bf16_t* YB = (bf16_t*)(w_ + WS_YB);
#pragma unroll
        for (int ai = 0; ai < 2; ++ai)
#pragma unroll
            for (int m = 0; m < 4; ++m) { const int row = u.pm * 256 + ai * 128 + wr * 64 + m * 16 + fr;
#pragma unroll
                for (int bj = 0; bj < 2; ++bj) *(u32x4*)(YB + (size_t)row * D + u.pn * 256 + bj * 128 + wc * 32 + 8 * fq) = pack8(acc[ai][bj][m][0], acc[ai][bj][m][1]); }
    }
};


typedef float f32x16 __attribute__((ext_vector_type(16)));
__device__ __forceinline__ void ph_attn(const int tid, const int bid, unsigned char* ws) {
    const bf16_t* QS = (const bf16_t*)(ws + WS_QS); const bf16_t* KS = (const bf16_t*)(ws + WS_KS); const bf16_t* VT = (const bf16_t*)(ws + WS_VT);
    bf16_t* OG = (bf16_t*)(ws + WS_OG); float* LSE = (float*)(ws + WS_LSE);
    const int lane = tid & 63, q = lane & 31, hi = lane >> 5, wave = tid >> 6;
    const float NEG = -1e30f;
    for (int it = bid * 8 + wave; it < NB * NH * (L / 32); it += (int)gridDim.x * 8) {
        const int bh = it >> 8, tile = it & 255; const int h = bh % NH, b = bh / NH, g = h >> 2, hh = h & 3;
        const int lsh = g == 0 ? 13 : (g == 1 ? 11 : 9), Ls = 1 << lsh, dsh = 13 - lsh;
        const int row0 = tile * 32, r = row0 >> lsh, m0 = row0 & (Ls - 1);
        const size_t rb = (size_t)bh * L + (size_t)r * Ls;
        pg8::bf16x8 qf[4];
#pragma unroll
        for (int s = 0; s < 4; ++s) qf[s] = *(const pg8::bf16x8*)(QS + (rb + m0 + q) * 64 + 16 * s + 8 * hi);
        f32x16 S[5]; float mx = NEG;
#pragma unroll
        for (int i = 0; i < 5; ++i) {
            const int t0 = m0 - 64 + 32 * i; const bool ok = (t0 >= 0) && (t0 < Ls);
            f32x16 a;
#pragma unroll
            for (int e = 0; e < 16; ++e) a[e] = 0.f;
            if (ok) {
#pragma unroll
                for (int s = 0; s < 4; ++s) { const pg8::bf16x8 kf = *(const pg8::bf16x8*)(KS + (rb + t0 + q) * 64 + 16 * s + 8 * hi); a = __builtin_amdgcn_mfma_f32_32x32x16_bf16(kf, qf[s], a, 0, 0, 0); }
#pragma unroll
                for (int e = 0; e < 16; ++e) { const int kk = (e & 3) + 8 * (e >> 2) + 4 * hi;
                    if (i == 0 && kk < q) a[e] = NEG;
                    if (i == 4 && kk > q) a[e] = NEG;
                    mx = fmaxf(mx, a[e]); }
            } else {
#pragma unroll
                for (int e = 0; e < 16; ++e) a[e] = NEG;
            }
            S[i] = a;
        }
        mx = fmaxf(mx, shx(mx, 32, lane));
        float l = 0.f;
#pragma unroll
        for (int i = 0; i < 5; ++i)
#pragma unroll
            for (int e = 0; e < 16; ++e) { const float pv = exp2f(S[i][e] - mx); S[i][e] = pv; l += pv; }
        l += shx(l, 32, lane);
        f32x16 o[2];
#pragma unroll
        for (int dvb = 0; dvb < 2; ++dvb) {
#pragma unroll
            for (int e = 0; e < 16; ++e) o[dvb][e] = 0.f;
        }
        const bf16_t* vrow0 = VT + (size_t)bh * L * 64 + (size_t)(r * 64 + q) * Ls + 4 * hi;
#pragma unroll
        for (int i = 0; i < 5; ++i) {
            const int t0 = m0 - 64 + 32 * i; const bool ok = (t0 >= 0) && (t0 < Ls);
            if (ok) {
#pragma unroll
                for (int s2 = 0; s2 < 2; ++s2) {
                    u32x4 pf; pf.x = pg8::cvt_pk_bf16(S[i][8 * s2 + 0], S[i][8 * s2 + 1]); pf.y = pg8::cvt_pk_bf16(S[i][8 * s2 + 2], S[i][8 * s2 + 3]);
                    pf.z = pg8::cvt_pk_bf16(S[i][8 * s2 + 4], S[i][8 * s2 + 5]); pf.w = pg8::cvt_pk_bf16(S[i][8 * s2 + 6], S[i][8 * s2 + 7]);
                    const pg8::bf16x8 pb = __builtin_bit_cast(pg8::bf16x8, pf);
#pragma unroll
                    for (int dvb = 0; dvb < 2; ++dvb) {
                        const bf16_t* vp = vrow0 + (size_t)(dvb * 32) * Ls + t0 + 16 * s2;
                        const u32x2 v0 = *(const u32x2*)vp, v1 = *(const u32x2*)(vp + 8);
                        u32x4 vv; vv.x = v0.x; vv.y = v0.y; vv.z = v1.x; vv.w = v1.y;
                        o[dvb] = __builtin_amdgcn_mfma_f32_32x32x16_bf16(__builtin_bit_cast(pg8::bf16x8, vv), pb, o[dvb], 0, 0, 0);
                    }
                }
            }
        }
        const float il = 1.f / l; const int t = ((m0 + q) << dsh) + r; const size_t tt = (size_t)b * L + t;
        bf16_t* op = OG + ((size_t)g * T + tt) * 256 + hh * 64 + 4 * hi;
#pragma unroll
        for (int dvb = 0; dvb < 2; ++dvb)
#pragma unroll
            for (int g4 = 0; g4 < 4; ++g4) { u32x2 w; w.x = pg8::cvt_pk_bf16(o[dvb][4 * g4] * il, o[dvb][4 * g4 + 1] * il); w.y = pg8::cvt_pk_bf16(o[dvb][4 * g4 + 2] * il, o[dvb][4 * g4 + 3] * il);
                *(u32x2*)(op + dvb * 32 + 8 * g4) = w; }
        if (hi == 0) LSE[((size_t)g * T + tt) * 4 + hh] = mx + log2f(l);
    }
}

#define FFT_HD __device__ __forceinline__
#define FFT_LDS __attribute__((address_space(3)))
#define FFT_ORDER(a, b) asm volatile("" : "+v"(a) : "v"(b))
#define FFT_LAUNDER(x) asm volatile("" : "+v"(x))
#define FFT_SCONST(dst, val, bits) asm volatile("s_mov_b32 %0, " #bits : "=s"(dst))
typedef float cpx __attribute__((ext_vector_type(2)));
FFT_HD inline cpx cmul(cpx a, cpx b) { cpx r; r.x = a.x * b.x - a.y * b.y; r.y = a.x * b.y + a.y * b.x; return r; }
FFT_HD inline cpx cmulc(cpx a, cpx b) { cpx r; r.x = a.x * b.x + a.y * b.y; r.y = a.y * b.x - a.x * b.y; return r; }
FFT_HD inline int FPHYS(int p) { return p + (p >> 4) + 16 * (p >> 9); }
constexpr int FFT_LDS_ELEMS = 16384 + 1024 + 512;
#define FFT_C1 0.98078528040323043f
#define FFT_S1 0.19509032201612825f
#define FFT_C2 0.92387953251128674f
#define FFT_S2 0.38268343236508978f
#define FFT_C3 0.83146961230254524f
#define FFT_S3 0.55557023301960218f
#define FFT_C4 0.70710678118654752f
struct W32C { float c1, c2, c3, c4, s1, s2, s3; };
FFT_HD inline W32C w32_consts() {
    W32C k;
    FFT_SCONST(k.c1, FFT_C1, 0x3f7b14be); FFT_SCONST(k.c2, FFT_C2, 0x3f6c835e); FFT_SCONST(k.c3, FFT_C3, 0x3f54db31); FFT_SCONST(k.c4, FFT_C4, 0x3f3504f3);
    FFT_SCONST(k.s1, FFT_S1, 0x3e47c5c2); FFT_SCONST(k.s2, FFT_S2, 0x3ec3ef15); FFT_SCONST(k.s3, FFT_S3, 0x3f0e39da);
    return k;
}
FFT_HD inline cpx w32(int m, const W32C& k) {
#define FFT_CT(q) ((q) == 0 ? 1.f : (q) == 1 ? k.c1 : (q) == 2 ? k.c2 : (q) == 3 ? k.c3 : (q) == 4 ? k.c4 : (q) == 5 ? k.s3 : (q) == 6 ? k.s2 : (q) == 7 ? k.s1 : 0.f)
    cpx r; if (m <= 8) { r.x = FFT_CT(m); r.y = -FFT_CT(8 - m); } else { r.x = -FFT_CT(16 - m); r.y = -FFT_CT(m - 8); } return r;
}
template <int R, bool INV> FFT_HD inline void dft_regs(cpx (&v)[R]) {
    const W32C kc = w32_consts();
#pragma unroll
    for (int s = R / 2; s >= 1; s >>= 1) {
#pragma unroll
        for (int g = 0; g < R; g += 2 * s) {
#pragma unroll
            for (int k = 0; k < s; ++k) {
                const cpx a = v[g + k], b = v[g + k + s];
                cpx d; d.x = a.x - b.x; d.y = a.y - b.y;
                v[g + k].x = a.x + b.x; v[g + k].y = a.y + b.y;
                const int m = k * (16 / s);
                if (m == 0) v[g + k + s] = d;
                else if (m == 8) { cpx t; if (INV) { t.x = -d.y; t.y = d.x; } else { t.x = d.y; t.y = -d.x; } v[g + k + s] = t; }
                else { const cpx w = w32(m, kc); v[g + k + s] = INV ? cmulc(d, w) : cmul(d, w); }
            }
        }
    }
}
FFT_HD constexpr int brev(int i, int bits) { int r = 0; for (int b = 0; b < bits; ++b) r |= ((i >> b) & 1) << (bits - 1 - b); return r; }
FFT_HD inline cpx small_twiddle(float th) {
    const float t2 = th * th;
    cpx r;
    r.x = 1.f + t2 * (-0.5f + t2 * (4.1666666666666664e-2f + t2 * (-1.3888888888888889e-3f + t2 * 2.48015873015873e-5f)));
    r.y = -th * (1.f + t2 * (-1.6666666666666666e-1f + t2 * (8.3333333333333332e-3f + t2 * (-1.984126984126984e-4f))));
    return r;
}
template <int R, int BITS, bool BREV_IDX, bool INV> FFT_HD inline void apply_twiddles(cpx (&v)[R], cpx w1) {
    const cpx w2 = cmul(w1, w1), w3 = cmul(w2, w1), w4 = cmul(w2, w2);
    cpx cur[4]; cur[0].x = 1.f; cur[0].y = 0.f; cur[1] = w1; cur[2] = w2; cur[3] = w3;
#pragma unroll
    for (int q = 0; q < R; ++q) {
        const int idx = BREV_IDX ? brev(q, BITS) : q;
        if (q > 0) v[idx] = INV ? cmulc(v[idx], cur[q & 3]) : cmul(v[idx], cur[q & 3]);
        if (q + 4 < R) { cur[q & 3] = cmul(cur[q & 3], w4); FFT_ORDER(cur[q & 3], v[idx]); }
    }
}
template <bool ZERO_UPPER> FFT_HD inline void fft_f1(int tid, FFT_LDS cpx* lds) {
    FFT_LAUNDER(tid);
    cpx v[32];
    FFT_LDS cpx* b1 = lds + (tid + (tid >> 4));
#pragma unroll
    for (int j = 0; j < 32; ++j) { if (ZERO_UPPER && j >= 16) { v[j].x = 0.f; v[j].y = 0.f; } else v[j] = b1[560 * j]; }
    dft_regs<32, false>(v);
    apply_twiddles<32, 5, true, false>(v, small_twiddle(6.283185307179586f * (float)tid * (1.0f / 16384.0f)));
#pragma unroll
    for (int q = 0; q < 32; ++q) b1[560 * q] = v[brev(q, 5)];
}
FFT_HD inline void fft_f2(int tid, FFT_LDS cpx* lds) {
    FFT_LAUNDER(tid);
    const int q1 = tid >> 4, a = tid & 15; cpx v[32];
    FFT_LDS cpx* b2 = lds + (560 * q1 + a);
#pragma unroll
    for (int b = 0; b < 32; ++b) v[b] = b2[17 * b];
    dft_regs<32, false>(v);
    apply_twiddles<32, 5, true, false>(v, small_twiddle(6.283185307179586f * (float)a * (1.0f / 512.0f)));
#pragma unroll
    for (int q = 0; q < 32; ++q) b2[17 * q] = v[brev(q, 5)];
}
FFT_HD inline void fft_f3(int tid, FFT_LDS const cpx* lds, cpx (&out)[2][16]) {
    FFT_LAUNDER(tid);
#pragma unroll
    for (int h = 0; h < 2; ++h) { FFT_LDS const cpx* b3 = lds + (17 * tid + 16 * (tid >> 5) + 8960 * h); cpx v[16];
#pragma unroll
        for (int i = 0; i < 16; ++i) v[i] = b3[i];
        dft_regs<16, false>(v);
#pragma unroll
        for (int k = 0; k < 16; ++k) out[h][k] = v[brev(k, 4)]; }
}
FFT_HD inline void fft_i3(int tid, cpx (&in)[2][16], FFT_LDS cpx* lds) {
    FFT_LAUNDER(tid);
#pragma unroll
    for (int h = 0; h < 2; ++h) { FFT_LDS cpx* b3 = lds + (17 * tid + 16 * (tid >> 5) + 8960 * h); cpx v[16];
#pragma unroll
        for (int k = 0; k < 16; ++k) v[k] = in[h][k];
        dft_regs<16, true>(v);
#pragma unroll
        for (int i = 0; i < 16; ++i) b3[i] = v[brev(i, 4)]; }
}
FFT_HD inline void fft_i2(int tid, FFT_LDS cpx* lds) {
    FFT_LAUNDER(tid);
    const int q1 = tid >> 4, a = tid & 15; cpx v[32];
    FFT_LDS cpx* b2 = lds + (560 * q1 + a);
#pragma unroll
    for (int q = 0; q < 32; ++q) v[q] = b2[17 * q];
    apply_twiddles<32, 5, false, true>(v, small_twiddle(6.283185307179586f * (float)a * (1.0f / 512.0f)));
    dft_regs<32, true>(v);
#pragma unroll
    for (int b = 0; b < 32; ++b) b2[17 * b] = v[brev(b, 5)];
}
FFT_HD inline void fft_i1(int tid, FFT_LDS const cpx* lds, cpx (&v)[32]) {
    FFT_LAUNDER(tid);
    FFT_LDS const cpx* b1 = lds + (tid + (tid >> 4));
#pragma unroll
    for (int q = 0; q < 32; ++q) v[q] = b1[560 * q];
    apply_twiddles<32, 5, false, true>(v, small_twiddle(6.283185307179586f * (float)tid * (1.0f / 16384.0f)));
    dft_regs<32, true>(v);
}
FFT_HD inline void fft_i1_store(int tid, FFT_LDS cpx* lds) {
    cpx v[32]; fft_i1(tid, lds, v);
    FFT_LAUNDER(tid);
    FFT_LDS cpx* b1 = lds + (tid + (tid >> 4));
#pragma unroll
    for (int j = 0; j < 16; ++j) b1[560 * j] = v[brev(j, 5)];
}

typedef _Float16 h2_t __attribute__((ext_vector_type(2)));
#define OPAQUE_PTR(T, name, expr) T name; { unsigned lo_ = __builtin_amdgcn_readfirstlane((unsigned)(uintptr_t)(expr)), hi_ = __builtin_amdgcn_readfirstlane((unsigned)((uintptr_t)(expr) >> 32)); asm volatile("" : "+s"(lo_), "+s"(hi_)); name = (T)(((uintptr_t)hi_ << 32) | lo_); }
typedef const bf16_t __attribute__((address_space(1)))* gbf_cp;
__device__ __forceinline__ float conv3(gbf_cp u, int t, float w0, float w1, float w2, float bb) {
    const float um = bf2f(u[t > 0 ? -1 : 0]), u0 = bf2f(u[0]), up = bf2f(u[t < L - 1 ? 1 : 0]);
    return (t > 0 ? um : 0.f) * w0 + u0 * w1 + (t < L - 1 ? up : 0.f) * w2 + bb;
}
__device__ __forceinline__ float conv3l(const LAS bf16_t* u, int t, float w0, float w1, float w2, float bb) {
    const float um = bf2f(u[t > 0 ? -1 : 0]), u0 = bf2f(u[0]), up = bf2f(u[t < L - 1 ? 1 : 0]);
    return (t > 0 ? um : 0.f) * w0 + u0 * w1 + (t < L - 1 ? up : 0.f) * w2 + bb;
}
constexpr int FFT_RAW_OFF = 8960 * 8;
__device__ __forceinline__ void ph_fftconv(const int tid, const int bid, CP p, int layer, unsigned char* ws, LAS unsigned char* ldsraw) {
    LAS cpx* lds = (LAS cpx*)ldsraw;
    const float* w_sc_ = p.w_sc + (size_t)layer * 3 * C3; const float* b_sc_ = p.b_sc + (size_t)layer * C3; const float* hy_bias_ = p.hy_bias + layer * HYW;
    for (int c = bid; c < HYW; c += (int)gridDim.x) {
        OPAQUE_PTR(unsigned char*, wsl, ws)
        const _Float16* FILT = (const _Float16*)(wsl + WS_FILT); const bf16_t* UT = (const bf16_t*)(wsl + WS_UT); bf16_t* YT = (bf16_t*)(wsl + WS_YT);
        h2_t KF[2][16];
        { int tl = tid; asm volatile("" : "+v"(tl)); LAS cpx* b1 = lds + (tl + (tl >> 4));
          OPAQUE_PTR(const _Float16 __attribute__((address_space(1)))*, kf, FILT + (size_t)c * 16384) OPAQUE_PTR(const float*, hy_bias, hy_bias_)
          _Float16 tp[32];
#pragma unroll
          for (int j = 0; j < 32; ++j) { const int n = tl + 512 * j; tp[j] = kf[j < 16 ? n : (n == 8192 ? 8192 : 24576 - n)]; }
#pragma unroll
          for (int j = 0; j < 32; ++j) { const int n = tl + 512 * j; cpx t; t.y = 0.f; t.x = (float)tp[j]; if (n == 8192) t.x = 0.f; if (n == 0) t.x += hy_bias[c]; b1[560 * j] = t; } }
        asm volatile("" ::: "memory");
        fft_f1<false>(tid, lds); __syncthreads(); fft_f2(tid, lds); __syncthreads();
        { cpx W[2][16]; fft_f3(tid, lds, W);
#pragma unroll
          for (int h = 0; h < 2; ++h)
#pragma unroll
              for (int kq = 0; kq < 16; ++kq) { h2_t t; t.x = (_Float16)W[h][kq].x; t.y = (_Float16)W[h][kq].y; KF[h][kq] = t; } }
        { const int c1 = HYW + c, c2 = 2 * HYW + c; int tl = tid; asm volatile("" : "+v"(tl));
          OPAQUE_PTR(const u32x4 __attribute__((address_space(1)))*, r1, UT + (size_t)c1 * T) OPAQUE_PTR(const u32x4 __attribute__((address_space(1)))*, r2, UT + (size_t)c2 * T)
          u32x4 raw[8];
#pragma unroll
          for (int m = 0; m < 4; ++m) { raw[m] = r1[tl + 512 * m]; raw[4 + m] = r2[tl + 512 * m]; }
          __syncthreads();
          LAS u32x4* rw = (LAS u32x4*)(ldsraw + FFT_RAW_OFF) + tl;
#pragma unroll
          for (int m = 0; m < 8; ++m) rw[512 * m] = raw[m];
          __syncthreads();
          OPAQUE_PTR(const float*, w_sc, w_sc_) OPAQUE_PTR(const float*, b_sc, b_sc_)
          const float a0 = w_sc[c1], a1 = w_sc[C3 + c1], a2 = w_sc[2 * C3 + c1], ab = b_sc[c1], v0 = w_sc[c2], v1 = w_sc[C3 + c2], v2 = w_sc[2 * C3 + c2], vb = b_sc[c2];
          const LAS bf16_t* u1 = (const LAS bf16_t*)(ldsraw + FFT_RAW_OFF); const LAS bf16_t* u2 = u1 + 2 * L; LAS cpx* b1 = lds + (tl + (tl >> 4));
#pragma unroll 4
          for (int j = 0; j < 16; ++j) { const int t = tl + 512 * j; cpx z;
              z.x = conv3l(u1 + t, t, a0, a1, a2, ab) * conv3l(u2 + t, t, v0, v1, v2, vb);
              z.y = conv3l(u1 + L + t, t, a0, a1, a2, ab) * conv3l(u2 + L + t, t, v0, v1, v2, vb);
              b1[560 * j] = z; } }
        __syncthreads();
        fft_f1<true>(tid, lds); __syncthreads(); fft_f2(tid, lds); __syncthreads();
        { cpx W[2][16]; fft_f3(tid, lds, W);
#pragma unroll
          for (int h = 0; h < 2; ++h)
#pragma unroll
              for (int k = 0; k < 16; ++k) { cpx kf; kf.x = (float)KF[h][k].x; kf.y = (float)KF[h][k].y; W[h][k] = cmul(W[h][k], kf); }
          fft_i3(tid, W, lds); }
        __syncthreads(); fft_i2(tid, lds); __syncthreads();
        { int tl = tid; asm volatile("" : "+v"(tl));
          OPAQUE_PTR(const u32x4 __attribute__((address_space(1)))*, r0, UT + (size_t)c * T)
          u32x4 raw[4];
#pragma unroll
          for (int m = 0; m < 4; ++m) raw[m] = r0[tl + 512 * m];
          fft_i1_store(tid, lds);
          __syncthreads();
          LAS u32x4* rw = (LAS u32x4*)(ldsraw + FFT_RAW_OFF) + tl;
#pragma unroll
          for (int m = 0; m < 4; ++m) rw[512 * m] = raw[m];
          __syncthreads();
          OPAQUE_PTR(const float*, w_sc, w_sc_) OPAQUE_PTR(const float*, b_sc, b_sc_) const float x0w = w_sc[c], x1w = w_sc[C3 + c], x2w = w_sc[2 * C3 + c], xb = b_sc[c];
          OPAQUE_PTR(bf16_t __attribute__((address_space(1)))*, yo, YT + (size_t)c * T)
          const LAS bf16_t* u0 = (const LAS bf16_t*)(ldsraw + FFT_RAW_OFF); LAS const cpx* b1 = lds + (tl + (tl >> 4));
#pragma unroll 4
          for (int j = 0; j < 16; ++j) { const int t = tl + 512 * j; const cpx u = b1[560 * j];
              yo[t] = f2bf(u.x * (1.0f / 16384.0f) * conv3l(u0 + t, t, x0w, x1w, x2w, xb));
              yo[L + t] = f2bf(u.y * (1.0f / 16384.0f) * conv3l(u0 + L + t, t, x0w, x1w, x2w, xb)); } }
        __syncthreads();
    }
}

#define XB_TMO      128
#define XB_XCNT(j)  (256  + 64 * (j))
#define XB_XSUB(j)  (1280 + 64 * (j))
#define XB_XGEN(j)  (2304 + 64 * (j))
#define XB_TOP      3328
#define XB_TOPGEN   3392
#define XCD_BAR_WORDS 3456
#define XB_SPIN_CAP (1u << 18)

__device__ __forceinline__ unsigned xb_ld(unsigned* p)              { return __hip_atomic_load(p, __ATOMIC_RELAXED, __HIP_MEMORY_SCOPE_AGENT); }
__device__ __forceinline__ unsigned xb_add(unsigned* p, unsigned v) { return __hip_atomic_fetch_add(p, v, __ATOMIC_RELAXED, __HIP_MEMORY_SCOPE_AGENT); }
__device__ __forceinline__ unsigned xb_xcc_id() { return (unsigned)__builtin_amdgcn_s_getreg((3 << 11) | 20) & 0xFu; }
#define XB_SPIN(cond, bar) do { unsigned _sp = 0; while (cond) { __builtin_amdgcn_s_sleep(1); \
    if ((++_sp & 255u) == 0u) { if (xb_ld(&(bar)[XB_TMO])) break; if (_sp > XB_SPIN_CAP) { atomicAdd(&(bar)[XB_TMO], 1u); break; } } } } while (0)

struct XcdBarrier {
    unsigned* bar; unsigned x;
    volatile LAS unsigned* st;
};

__device__ __forceinline__ XcdBarrier xcd_barrier_post(unsigned* bar, volatile LAS unsigned* st) {
    XcdBarrier b; b.bar = bar; b.x = xb_xcc_id(); b.st = st;
    if (threadIdx.x == 0) (void)xb_add(&bar[XB_XCNT(b.x)], 1u);
    return b;
}
__device__ __forceinline__ void xcd_barrier_complete(unsigned* bar, unsigned x, unsigned& nloc, unsigned& nx) {
    const unsigned G = gridDim.x * gridDim.y * gridDim.z;
    unsigned sum, cnt, mine, sp = 0u;
    for (;;) {
        sum = 0u; cnt = 0u; mine = 0u;
#pragma unroll
        for (unsigned j = 0; j < 16; ++j) { const unsigned c = xb_ld(&bar[XB_XCNT(j)]); sum += c; cnt += (c > 0u) ? 1u : 0u; mine = (j == x) ? c : mine; }
        if (sum == G) break;
        __builtin_amdgcn_s_sleep(1);
        if ((++sp & 255u) == 0u) { if (xb_ld(&bar[XB_TMO])) break; if (sp > XB_SPIN_CAP) { atomicAdd(&bar[XB_TMO], 1u); break; } }
    }
    nloc = mine > 0u ? mine : 1u; nx = cnt > 0u ? cnt : 1u;
}

__device__ __forceinline__ void xcd_barrier(const XcdBarrier& b) {
    asm volatile("s_waitcnt vmcnt(0)" ::: "memory");
    __syncthreads();
    if (threadIdx.x == 0) {
        unsigned* bar = b.bar;
        __builtin_amdgcn_s_waitcnt(0);
        unsigned nloc = b.st[0], nx = b.st[1];
        if (nloc == 0u) { xcd_barrier_complete(bar, b.x, nloc, nx); b.st[0] = nloc; b.st[1] = nx; }
        const unsigned old = xb_add(&bar[XB_XSUB(b.x)], 1u);
        const unsigned gen = old / nloc;
        if (old + 1u == (gen + 1u) * nloc) {
            __builtin_amdgcn_fence(__ATOMIC_RELEASE, "agent");
            asm volatile("s_waitcnt vmcnt(0)" ::: "memory");
            const unsigned og = xb_add(&bar[XB_TOP], 1u);
            const unsigned tg = og / nx;
            if (og + 1u == (tg + 1u) * nx) xb_add(&bar[XB_TOPGEN], 1u);
            else XB_SPIN(xb_ld(&bar[XB_TOPGEN]) == tg, bar);
            __builtin_amdgcn_fence(__ATOMIC_ACQUIRE, "agent");
            xb_add(&bar[XB_XGEN(b.x)], 1u);
            asm volatile("s_waitcnt vmcnt(0)" ::: "memory");
        } else {
            XB_SPIN(xb_ld(&bar[XB_XGEN(b.x)]) == gen, bar);
            __builtin_amdgcn_fence(__ATOMIC_ACQUIRE, "agent");
            asm volatile("s_waitcnt vmcnt(0)" ::: "memory");
        }
    }
    __syncthreads();
}

__device__ __forceinline__ void ph_ycat(const int tid, const int bid, unsigned char* ws, LAS unsigned char* lds) {
    const bf16_t* YT = (const bf16_t*)(ws + WS_YT); const bf16_t* OG = (const bf16_t*)(ws + WS_OG); const float* LSE = (const float*)(ws + WS_LSE); bf16_t* YCAT = (bf16_t*)(ws + WS_YCAT);
    const int lane = tid & 63, wave = tid >> 6;
    LAS bf16_t* tile = (LAS bf16_t*)(lds + wave * 8704);
    for (int it = bid * 8 + wave; it < 12 * 256; it += (int)gridDim.x * 8) {
        const int ch0 = (it % 12) * 64, tt0 = (it / 12) * 64;
#pragma unroll
        for (int i = 0; i < 8; ++i) { const int row = i * 8 + (lane >> 3), ck = lane & 7;
            const u32x4 v = *(const u32x4*)(YT + (size_t)(ch0 + row) * T + tt0 + ck * 8);
            LAS u32x2* d = (LAS u32x2*)(tile + row * 68 + ck * 8); u32x2 a; a.x = v.x; a.y = v.y; u32x2 b; b.x = v.z; b.y = v.w; d[0] = a; d[1] = b; }
        asm volatile("s_waitcnt lgkmcnt(0)" ::: "memory");
#pragma unroll
        for (int i = 0; i < 8; ++i) { const int tok = i * 8 + (lane >> 3), cc = lane & 7; unsigned short e[8];
#pragma unroll
            for (int q = 0; q < 8; ++q) e[q] = tile[(cc * 8 + q) * 68 + tok];
            u32x4 o; o.x = e[0] | ((unsigned)e[1] << 16); o.y = e[2] | ((unsigned)e[3] << 16); o.z = e[4] | ((unsigned)e[5] << 16); o.w = e[6] | ((unsigned)e[7] << 16);
            *(u32x4*)(YCAT + (size_t)(tt0 + tok) * D + ch0 + cc * 8) = o; }
        asm volatile("s_waitcnt lgkmcnt(0)" ::: "memory");
    }
    for (int idx = bid * 512 + tid; idx < T * 32; idx += (int)gridDim.x * 512) {
        const int tt = idx >> 5, cc0 = (idx & 31) * 8, hh = cc0 >> 6;
        const float l0 = LSE[((size_t)0 * T + tt) * 4 + hh], l1 = LSE[((size_t)1 * T + tt) * 4 + hh], l2 = LSE[((size_t)2 * T + tt) * 4 + hh];
        const float mx = fmaxf(l0, fmaxf(l1, l2)); float e0 = exp2f(l0 - mx), e1 = exp2f(l1 - mx), e2 = exp2f(l2 - mx); const float inv = 1.f / (e0 + e1 + e2); e0 *= inv; e1 *= inv; e2 *= inv;
        const u32x4 a = *(const u32x4*)(OG + ((size_t)0 * T + tt) * 256 + cc0), b = *(const u32x4*)(OG + ((size_t)1 * T + tt) * 256 + cc0), c = *(const u32x4*)(OG + ((size_t)2 * T + tt) * 256 + cc0);
        u32x4 o;
#pragma unroll
        for (int q = 0; q < 4; ++q) o[q] = pg8::cvt_pk_bf16(e0 * bflo(a[q]) + e1 * bflo(b[q]) + e2 * bflo(c[q]), e0 * bfhi(a[q]) + e1 * bfhi(b[q]) + e2 * bfhi(c[q]));
        *(u32x4*)(YCAT + (size_t)tt * D + 768 + cc0) = o;
    }
}
__device__ __forceinline__ void ph_mod(const int tid, const int bid, CP p, float* mod, LAS unsigned char* lds) {
    const int lane = tid & 63, wave = tid >> 6; LAS float* red = (LAS float*)lds;
    for (int task = bid; task < DEPTH * 96; task += (int)gridDim.x) {
        const int l = task / 96, n0 = (task % 96) * 64;
        const float* w = p.w_ada + ((size_t)l * 1024 + wave * 128) * 6144 + n0 + lane; const float* c0 = p.c + wave * 128; const float* c1 = p.c + 1024 + wave * 128;
        float a0 = 0.f, a1 = 0.f;
#pragma unroll 16
        for (int kq = 0; kq < 128; ++kq) { const float wv = w[(size_t)kq * 6144]; a0 += siluf_(c0[kq]) * wv; a1 += siluf_(c1[kq]) * wv; }
        __syncthreads();
        red[(wave * 2 + 0) * 64 + lane] = a0; red[(wave * 2 + 1) * 64 + lane] = a1;
        __syncthreads();
        if (tid < 128) { const int b = tid >> 6, n = tid & 63; float s = p.b_ada[l * 6144 + n0 + n];
#pragma unroll
            for (int wv = 0; wv < 8; ++wv) s += red[(wv * 2 + b) * 64 + n];
            mod[((size_t)l * NB + b) * 6144 + n0 + n] = s; }
    }
    __syncthreads();
}

namespace cg = cooperative_groups;
constexpr int NPHASE = 1 + 9 * DEPTH + 1;
#ifndef REPEAT_PH
#define REPEAT_PH (-1)
#endif
#ifndef PROBE_PH
#define PROBE_PH (-1)
#endif
#ifndef PROBE_DIV
#define PROBE_DIV 10.0f
#endif
constexpr int MEGA_LDS = 147456;
constexpr int XB_ST_OFF = MEGA_LDS - 64;
__global__ void __launch_bounds__(512, 2) mega(P p_unused) {
    extern __shared__ __attribute__((aligned(16))) unsigned char lds[];
    typedef const __attribute__((address_space(4))) P* KP;
    KP kp0 = (KP)__builtin_amdgcn_kernarg_segment_ptr();
    cg::grid_group grid = cg::this_grid();
    const int ph_lo = kp0->ph_lo, ph_hi = kp0->ph_hi;
    const int wave0 = __builtin_amdgcn_readfirstlane((int)(threadIdx.x >> 6));
    { volatile LAS unsigned* st0 = (volatile LAS unsigned*)((LAS unsigned char*)lds + XB_ST_OFF); if (threadIdx.x < 16) st0[threadIdx.x] = 0u; }
    __syncthreads();
    const XcdBarrier xbar = xcd_barrier_post((unsigned*)(kp0->ws + WS_CTL) + 4096, (volatile LAS unsigned*)((LAS unsigned char*)lds + XB_ST_OFF));
#define PHASE_VARS const __attribute__((address_space(4))) P& p = *pp; unsigned char* ws = p.ws; float* out = p.out; float* MOD = (float*)(ws + WS_MOD); float* ROPE = (float*)(ws + WS_ROPE); _Float16* H3 = (_Float16*)(ws + WS_H3); _Float16* W4T = (_Float16*)(ws + WS_W4T); int* SEL = (int*)(ws + WS_SEL); float* WTS = (float*)(ws + WS_WTS); int* POS = (int*)(ws + WS_POS); _Float16* FILT = (_Float16*)(ws + WS_FILT); bf16_t* XN = (bf16_t*)(ws + WS_XN); bf16_t* UT = (bf16_t*)(ws + WS_UT); bf16_t* QS = (bf16_t*)(ws + WS_QS); bf16_t* KS = (bf16_t*)(ws + WS_KS); bf16_t* VT = (bf16_t*)(ws + WS_VT); bf16_t* GATES = (bf16_t*)(ws + WS_GATES); bf16_t* YT = (bf16_t*)(ws + WS_YT); bf16_t* OG = (bf16_t*)(ws + WS_OG); float* LSE = (float*)(ws + WS_LSE); bf16_t* YCAT = (bf16_t*)(ws + WS_YCAT); bf16_t* MERGED = (bf16_t*)(ws + WS_MERGED); float* Z = (float*)(ws + WS_Z); bf16_t* X0 = (bf16_t*)(ws + WS_X0); bf16_t* ACT = (bf16_t*)(ws + WS_ACT); bf16_t* YB = (bf16_t*)(ws + WS_YB); unsigned char* sm = lds + (tid >> 8) * 8192; LAS unsigned char* ldsp = (LAS unsigned char*)lds; bf16_t* WA = (bf16_t*)(ws + WS_WA); bf16_t* WB = (bf16_t*)(ws + WS_WB); bf16_t* WCAT = (bf16_t*)(ws + WS_WCAT); bf16_t* WOUT = (bf16_t*)(ws + WS_WOUT);
    int ph = 0;
#define PHASE(...) do { if (PROBE_PH >= 0 && ph == PROBE_PH) { if (wave0 == 0) ((volatile LAS unsigned long long*)((LAS unsigned char*)lds + XB_ST_OFF + 16))[0] = __builtin_amdgcn_s_memrealtime(); } if (ph >= ph_lo && ph < ph_hi) { int tid, bid = blockIdx.x; KP pp = kp0; asm volatile("v_mbcnt_lo_u32_b32 %0, -1, 0\n\tv_mbcnt_hi_u32_b32 %0, -1, %0" : "=v"(tid)); tid += wave0 * 64; asm volatile("" : "+v"(tid), "+s"(bid), "+s"(pp)); PHASE_VARS; __VA_ARGS__; if (ph == REPEAT_PH) { xcd_barrier(xbar); __VA_ARGS__; } if (ph + 1 < ph_hi) { if (ph_hi < 0) grid.sync(); else xcd_barrier(xbar); } } if (PROBE_PH >= 0 && ph == PROBE_PH) { if (wave0 == 0) ((volatile LAS unsigned long long*)((LAS unsigned char*)lds + XB_ST_OFF + 16))[1] = __builtin_amdgcn_s_memrealtime(); } ++ph; } while (0)
    PHASE({ ph_mod(tid, bid, p, MOD, ldsp); nv_rope(tid, bid, p, ROPE); nv_h3(tid, bid, p, H3, sm); ph_w4t(tid, bid, p, W4T); __syncthreads(); ph_convert(tid, bid, p, 0, ws, ldsp); });
    for (int l = 0; l < DEPTH; ++l) {
#define mod_l (MOD + (size_t)l * NB * 6144)
        PHASE({ if (l > 0) { ph_convert(tid, bid, p, l, ws, ldsp); __syncthreads(); }
                { SchedDense S{(const char*)(W4T + (size_t)l * 1536 * 256), (const char*)(H3 + (size_t)l * L * 256), 6, 32, (int)gridDim.x, bid, (size_t)256 * 256 * 2}; EpiTaps E{ws};
                  pg8::gemm_phase<EpiTaps, SchedDense, true, true, false, true>(tid, ldsp, 256, S, E); }
                asm volatile("v_mbcnt_lo_u32_b32 %0, -1, 0\n\tv_mbcnt_hi_u32_b32 %0, -1, %0" : "=v"(tid)); tid += wave0 * 64;
                nv_norm(tid, bid, l == 0 ? p.x : out, out, p.norm1_g + l * D, mod_l, XN, l > 0, YB, POS, WTS, l > 0 ? mod_l - NB * 6144 : mod_l); });
        PHASE({ { SchedG1a S{(const char*)XN, (const char*)WA, (int)gridDim.x, bid}; EpiG1a E{ws};
                  pg8::gemm_phase<EpiG1a, SchedG1a, true, true>(tid, ldsp, 1024, S, E); }
                asm volatile("v_mbcnt_lo_u32_b32 %0, -1, 0\n\tv_mbcnt_hi_u32_b32 %0, -1, %0" : "=v"(tid)); tid += wave0 * 64;
                { SchedG1b S{(const char*)XN, (const char*)WB, (int)gridDim.x, bid}; EpiG1b E{ws};
                  pg8::gemm_phase<EpiG1b, SchedG1b, true, true, false, false, true>(tid, ldsp, 1024, S, E); } });
        PHASE({ ph_fftconv(tid, bid, p, l, ws, ldsp); ph_attn(tid, bid, ws); });
        PHASE({ ph_ycat(tid, bid, ws, ldsp); });
        PHASE({ SchedDense S{(const char*)YCAT, (const char*)WCAT, 64, 4, (int)gridDim.x, bid, 524288}; EpiMerge E{ws};
                pg8::gemm_phase<EpiMerge, SchedDense, true, true>(tid, ldsp, 1024, S, E); });
        PHASE({ SchedDense S{(const char*)MERGED, (const char*)WOUT, 64, 4, (int)gridDim.x, bid, 524288}; EpiOut E{out, ws, l};
                pg8::gemm_phase<EpiOut, SchedDense, true, true>(tid, ldsp, 1024, S, E); });
        PHASE({ ph_route(tid, bid, p, l, ws, out, ldsp); });
        PHASE({ ph_moe_prep(tid, bid, ws, l);
                SchedMoe S{(const int*)(ws + WS_CTL + CTL_CNT) + l * 1024, (const char*)XN, (const char*)(ws + WS_W13), (const int*)(ws + WS_LIST), (size_t)1024 * 1024 * 2, 0, (size_t)256 * 1024 * 2, 1, (int)gridDim.x, bid}; EpiMoeUp E{ws};
                pg8::gemm_phase<EpiMoeUp, SchedMoe, true, true, true>(tid, ldsp, 1024, S, E); });
        PHASE({ SchedMoe S{(const int*)(ws + WS_CTL + CTL_CNT) + l * 1024, (const char*)ACT, (const char*)(ws + WS_W2), nullptr, (size_t)1024 * 512 * 2, (size_t)256 * 512 * 2, (size_t)256 * 512 * 2, 0, (int)gridDim.x, bid}; EpiMoeDown E{ws};
                pg8::gemm_phase<EpiMoeDown, SchedMoe, true, true, false>(tid, ldsp, 512, S, E); });
    }
    PHASE({ nv_final(tid, bid, out, out, p.final_g, MOD + (size_t)(DEPTH - 1) * NB * 6144, YB, POS, WTS); });
    if (PROBE_PH >= 0) { xcd_barrier(xbar); if (blockIdx.x == 0 && wave0 == 0 && __builtin_amdgcn_mbcnt_lo(~0u, 0u) == 0u) { volatile LAS unsigned long long* pt = (volatile LAS unsigned long long*)((LAS unsigned char*)lds + XB_ST_OFF + 16); kp0->out[0] += (float)(pt[1] - pt[0]) * (0.01f / PROBE_DIV); } }
}
}

extern "C" void kernel_launch(void* const* d_in, const int* in_sizes, int n_in, void* d_out, int out_size, void* d_ws, size_t ws_size, hipStream_t stream) {
    if (n_in != 27 || in_sizes[0] != T * D || out_size != T * D || ws_size < WS_END) {
        fprintf(stderr, "kernel_launch: unexpected shapes / workspace (n_in %d, in0 %d, out %d, ws %zu need %zu); nothing launched\n", n_in, n_in > 0 ? in_sizes[0] : -1, out_size, ws_size, (size_t)WS_END);
        return;
    }
    static int grid_blocks = 0;
    if (!grid_blocks) {
        int dev = 0, cus = 0, per_cu = 0;
        (void)hipGetDevice(&dev); (void)hipDeviceGetAttribute(&cus, hipDeviceAttributeMultiprocessorCount, dev);
        (void)hipFuncSetAttribute((const void*)mega, hipFuncAttributeMaxDynamicSharedMemorySize, MEGA_LDS);
        if (hipOccupancyMaxActiveBlocksPerMultiprocessor(&per_cu, (const void*)mega, 512, MEGA_LDS) != hipSuccess || per_cu < 1) per_cu = 1;
        grid_blocks = cus;
        fprintf(stderr, "kernel_launch: %d CUs x %d blocks\n", cus, per_cu);
    }
    P p{};
    const float** dst = (const float**)&p;
    for (int i = 0; i < 27; ++i) dst[i] = (const float*)d_in[i];
    p.out = (float*)d_out; p.ws = (unsigned char*)d_ws;
    for (int j = 0; j < 32; ++j) p.ri.inv[j] = pow(10000.0, -(double)j / 32.0);
    p.ph_lo = 0; p.ph_hi = NPHASE;
    (void)hipMemsetAsync((unsigned char*)d_ws + WS_CTL, 0, 1 * MiB, stream);
    void* args[] = {&p};
    hipError_t e = hipLaunchCooperativeKernel((const void*)mega, dim3(grid_blocks), dim3(512), args, MEGA_LDS, stream);
    if (e != hipSuccess) fprintf(stderr, "cooperative launch failed: %s (grid %d)\n", hipGetErrorString(e), grid_blocks);
}
```

```cpp
#include <hip/hip_runtime.h>
#include <hip/hip_cooperative_groups.h>
#include <cstdio>
#include <cstdint>
#include <cmath>

typedef unsigned short bf16_t;

namespace {
constexpr int D = 1024, NB = 2, L = 8192, T = NB * L, DEPTH = 2;
constexpr int HYW = 768, C3 = 2304, NH = 12, HD = 64, ATT_OUT = 256, INC = 6656;
constexpr int HY_EMB = 33, HY_FFN = 64;
constexpr int NE = 16, DEXP = 512;
constexpr float NORM_EPS = 1e-6f;
constexpr float QSCALE = 0.125f * 1.4426950408889634f;

constexpr size_t MiB = 1u << 20;
constexpr size_t WS_CTL = 0;
constexpr size_t WS_MOD = 1 * MiB;
constexpr size_t WS_ROPE = 2 * MiB;
constexpr size_t WS_W4T = 4 * MiB;
constexpr size_t WS_H3 = 364 * MiB;
constexpr size_t WS_SEL = 8 * MiB;
constexpr size_t WS_WTS = WS_SEL + 256 * 1024;
constexpr size_t WS_POS = WS_WTS + 256 * 1024;
constexpr size_t WS_RANK = WS_POS + 256 * 1024;
constexpr size_t WS_LIST = 9 * MiB;
constexpr size_t CTL_CNT = 4096;
constexpr size_t WS_FILT = 10 * MiB;
constexpr size_t WS_WA = 34 * MiB;
constexpr size_t WS_WB = 41 * MiB;
constexpr size_t WS_WCAT = 47 * MiB;
constexpr size_t WS_WOUT = 49 * MiB;
constexpr size_t WS_W13 = 51 * MiB;
constexpr size_t WS_W2 = 83 * MiB;
constexpr size_t WS_XN = 99 * MiB;
constexpr size_t WS_UT = 131 * MiB;
constexpr size_t WS_QS = 203 * MiB;
constexpr size_t WS_KS = 227 * MiB;
constexpr size_t WS_VT = 251 * MiB;
constexpr size_t WS_GATES = 275 * MiB;
constexpr size_t WS_OG = 339 * MiB;
constexpr size_t WS_LSE = 363 * MiB;
constexpr size_t WS_END = 372 * MiB;
constexpr size_t WS_YT = WS_XN;
constexpr size_t WS_MERGED = WS_UT;
constexpr size_t WS_Z = WS_QS;
constexpr size_t WS_X0 = WS_VT;
constexpr size_t WS_YCAT = WS_QS;
constexpr size_t WS_ACT = WS_QS;
constexpr size_t WS_YB = WS_UT;

__device__ __forceinline__ float bf2f(bf16_t v) { return __uint_as_float((unsigned)v << 16); }
__device__ __forceinline__ bf16_t f2bf(float f) { unsigned u = __float_as_uint(f); return (bf16_t)((u + 0x7fffu + ((u >> 16) & 1u)) >> 16); }
__device__ __forceinline__ float sigmoidf_(float x) { return 1.f / (1.f + __expf(-x)); }
__device__ __forceinline__ float siluf_(float x) { return x / (1.f + __expf(-x)); }
__host__ __device__ __forceinline__ int dil_of_head(int h) { const int g = h >> 2; return g == 0 ? 1 : (g == 1 ? 4 : 16); }
__device__ __forceinline__ size_t qk_row(int b, int h, int t) { const int d = dil_of_head(h), Ls = L / d; return (size_t)(b * NH + h) * L + (size_t)(t % d) * Ls + (t / d); }
__device__ __forceinline__ size_t vt_off(int b, int h, int t, int dv) { const int d = dil_of_head(h), Ls = L / d; return (size_t)(b * NH + h) * L * 64 + (size_t)((t % d) * 64 + dv) * Ls + (t / d); }
__device__ __forceinline__ int permd(int d) { return d < 32 ? 2 * d : 2 * (d - 32) + 1; }

__device__ __forceinline__ float sin_rev(float r) { r = r - rintf(r); return __builtin_amdgcn_sinf(r); }
__device__ __forceinline__ float cos_rev(float r) { r = r - rintf(r); return __builtin_amdgcn_cosf(r); }
__device__ __forceinline__ float sin_rad(float x) { return sin_rev(x * 0.15915494309189535f); }
struct RopeInv { double inv[32]; };
__device__ __forceinline__ float rdlane(float v, int l) { return __int_as_float(__builtin_amdgcn_readlane(__float_as_int(v), l)); }
__device__ __forceinline__ float shx(float v, int o, int lane) { return __int_as_float(__builtin_amdgcn_ds_bpermute((lane ^ o) << 2, __float_as_int(v))); }
__device__ __forceinline__ float wave_sum(float v, int lane) {
#pragma unroll
    for (int o = 1; o < 64; o <<= 1) v += shx(v, o, lane);
    return v;
}


struct P {
    const float *x, *c, *norm1_g, *norm2_g, *w_ada, *b_ada, *w_in, *w_sc, *b_sc, *hf_w1, *hf_b1, *hf_w2, *hf_b2, *hf_w3, *hf_b3, *hf_w4, *hf_freq, *hy_bias,
                *w_br_h, *w_br_a, *w_out, *router_w, *router_bias, *moe_w1, *moe_w3, *moe_w2, *final_g;
    float* out; unsigned char* ws;
    RopeInv ri;
    int ph_lo, ph_hi;
};
typedef const __attribute__((address_space(4))) P& CP;
#define VT_ (tid & 255)
#define VLOOP(NVB) for (int vb = bid * 2 + (tid >> 8); vb < (NVB); vb += (int)gridDim.x * 2)

namespace pg8 {
#define PG8_LAS __attribute__((address_space(3)))
typedef unsigned short bf16_t;
typedef short bf16x8 __attribute__((ext_vector_type(8)));
typedef float f32x4 __attribute__((ext_vector_type(4)));
typedef unsigned u32x4 __attribute__((ext_vector_type(4)));
constexpr int BM = 256, BK = 64, HALF = 128, HTB = HALF * BK * 2  , STAGE_BYTES = 8 * HTB, NXCD = 8, WGM = 8;

__host__ __device__ __forceinline__ int lds_byte(int r, int c) { const int st = (r >> 4) * 2 + (c >> 5), rr = r & 15, cc = c & 31, ob = rr * 64 + cc * 2; return st * 1024 + (ob ^ (((ob >> 9) & 1) << 5)); }
__host__ __device__ __forceinline__ void stage_rc(int b, int& R, int& C) { const int st = b / 1024, sb = b % 1024, swz = sb ^ (((sb >> 9) & 1) << 5); R = (st >> 1) * 16 + swz / 64; C = (st & 1) * 32 + (swz % 64) / 2; }
__host__ __device__ __forceinline__ int perm32(int rho) { const int n = rho >> 4, i = rho & 15; return 8 * (i >> 2) + 4 * n + (i & 3); }

struct Unit { int pm, pn, kind, nvalid, bstride; const char* A; const char* B; const int* rows; };
__device__ __forceinline__ void tile_of(int wgid, int nM, int nN, int& pm, int& pn) {
    const int nwg = nM * nN;
    { const int q = nwg / NXCD, r = nwg % NXCD, xcd = wgid % NXCD, off = wgid / NXCD; wgid = (xcd < r ? xcd * (q + 1) : r * (q + 1) + (xcd - r) * q) + off; }
    const int nig = WGM * nN, gid = wgid / nig, fm = gid * WGM, gsz = (nM - fm) < WGM ? (nM - fm) : WGM;
    pm = __builtin_amdgcn_readfirstlane(fm + ((wgid % nig) % gsz)); pn = __builtin_amdgcn_readfirstlane((wgid % nig) / gsz);
}
typedef _Float16 f16x8 __attribute__((ext_vector_type(8)));
template <bool F16> __device__ __forceinline__ f32x4 mma16(bf16x8 a, bf16x8 b, f32x4 c) {
    if constexpr (F16) return __builtin_amdgcn_mfma_f32_16x16x32_f16(__builtin_bit_cast(f16x8, a), __builtin_bit_cast(f16x8, b), c, 0, 0, 0);
    else return __builtin_amdgcn_mfma_f32_16x16x32_bf16(a, b, c, 0, 0, 0);
}
__device__ __forceinline__ unsigned cvt_pk_bf16(float lo, float hi) { unsigned r; asm volatile("v_cvt_pk_bf16_f32 %0, %1, %2" : "=v"(r) : "v"(lo), "v"(hi)); return r; }
template <class Epi, class Sched, bool ALIGN_EPI = false, bool SP2 = false, bool GATHER = false, bool F16 = false, bool BSTRIDE = false>
__device__ __forceinline__ void gemm_phase(const int tid, PG8_LAS unsigned char* lds, const int K, const Sched& S, const Epi& E) {
    const int wid = __builtin_amdgcn_readfirstlane(tid >> 6), lane = tid & 63, wr = wid >> 2, wc = wid & 3, fr = lane & 15, fq = lane >> 4;
    const int nt = K / BK;
    unsigned voffA[2], voffB[2];
#pragma unroll
    for (int i = 0; i < 2; ++i) { int R, C; stage_rc(tid * 16 + i * 8192, R, C); const int Rb = Epi::PERM ? ((R & ~31) + perm32(R & 31)) : R;
        voffA[i] = (unsigned)(R * K + C) * 2u; voffB[i] = (unsigned)(Rb * K + C) * 2u; }
    const size_t kstep = (size_t)(BK * 2);
    const size_t hstep = (size_t)HALF * K * 2;
    const unsigned ldsw = (unsigned)wid * 1024u;
    const int aoff = lds_byte(wr * 64 + fr, fq * 8), boff = lds_byte(wc * 32 + fr, fq * 8);
#define PG8_SA(b, h) (((b) * 2 + (h)) * HTB)
#define PG8_SB(b, h) ((4 + (b) * 2 + (h)) * HTB)
#define PG8_STAGE(bufoff, gbase, voff) do { _Pragma("unroll") for (int _i = 0; _i < 2; ++_i) \
        __builtin_amdgcn_global_load_lds((const unsigned*)((const char*)(gbase) + (voff)[_i]), (PG8_LAS unsigned*)(lds + (bufoff) + ldsw + _i * 8192), 16, 0, 0); } while (0)
#define PG8_STAGEA(bufoff, gbase, h, VG) do { if constexpr (GATHER) { PG8_STAGE(bufoff, gbase, VG[h]); } else { PG8_STAGE(bufoff, (gbase) + (h) * hstep, voffA); } } while (0)
#define PG8_STAGEB(bufoff, gbase, h, VB) do { if constexpr (BSTRIDE) { PG8_STAGE(bufoff, gbase, VB[h]); } else { PG8_STAGE(bufoff, (gbase) + (h) * hstep, voffB); } } while (0)
#define PG8_LDA(dst, b, h) do { _Pragma("unroll") for (int m = 0; m < 4; ++m) _Pragma("unroll") for (int k = 0; k < 2; ++k) dst[m][k] = *(const PG8_LAS bf16x8*)(lds + PG8_SA(b, h) + aoff + m * 2048 + k * 1024); } while (0)
#define PG8_LDB(dst, b, h) do { _Pragma("unroll") for (int n = 0; n < 2; ++n) _Pragma("unroll") for (int k = 0; k < 2; ++k) dst[n][k] = *(const PG8_LAS bf16x8*)(lds + PG8_SB(b, h) + boff + n * 2048 + k * 1024); } while (0)
#define PG8_MMA(ai, bj, At, Bt) do { __builtin_amdgcn_s_setprio(1); _Pragma("unroll") for (int m = 0; m < 4; ++m) _Pragma("unroll") for (int n = 0; n < 2; ++n) _Pragma("unroll") for (int k = 0; k < 2; ++k) \
        acc[ai][bj][m][n] = mma16<F16>(Bt[n][k], At[m][k], acc[ai][bj][m][n]); __builtin_amdgcn_s_setprio(0); } while (0)
#define PG8_WAIT_V(n) asm volatile("s_waitcnt vmcnt(" #n ")" ::: "memory")
#define PG8_WAIT_L(n) asm volatile("s_waitcnt lgkmcnt(" #n ")" ::: "memory")
#define PG8_BAR __builtin_amdgcn_s_barrier()
#define PG8_SCHED __builtin_amdgcn_sched_barrier(0)
    Unit cur, nxt; int ui = 0;
    if (!S.next(0, cur)) return;
    unsigned vgc[2][2] = {{0u, 0u}, {0u, 0u}}, vgn[2][2] = {{0u, 0u}, {0u, 0u}}, vga[2][2] = {{0u, 0u}, {0u, 0u}}; int Rg[2], Cg[2];
#pragma unroll
    for (int i = 0; i < 2; ++i) stage_rc(tid * 16 + i * 8192, Rg[i], Cg[i]);
#define PG8_LOADVG(dst, U) do { _Pragma("unroll") for (int h_ = 0; h_ < 2; ++h_) _Pragma("unroll") for (int i_ = 0; i_ < 2; ++i_) { const int r_ = h_ * HALF + Rg[i_]; const int tk_ = r_ < (U).nvalid ? (U).rows[r_] : 0; dst[h_][i_] = (unsigned)tk_ * (unsigned)(K * 2) + (unsigned)(Cg[i_] * 2); } } while (0)
    if constexpr (GATHER) PG8_LOADVG(vgc, cur);
    unsigned vbc[2][2] = {{0u, 0u}, {0u, 0u}}, vbn[2][2] = {{0u, 0u}, {0u, 0u}}, vbb[2][2] = {{0u, 0u}, {0u, 0u}}; int RBg[2];
#pragma unroll
    for (int i = 0; i < 2; ++i) RBg[i] = Epi::PERM ? ((Rg[i] & ~31) + perm32(Rg[i] & 31)) : Rg[i];
#define PG8_LOADVB(dst, U) do { _Pragma("unroll") for (int h_ = 0; h_ < 2; ++h_) _Pragma("unroll") for (int i_ = 0; i_ < 2; ++i_) dst[h_][i_] = (unsigned)(((h_ * HALF + RBg[i_]) * (U).bstride) * K + Cg[i_]) * 2u; } while (0)
    if constexpr (BSTRIDE) PG8_LOADVB(vbc, cur);
    f32x4 acc[2][2][4][2];
#pragma unroll
    for (int a = 0; a < 2; ++a)
#pragma unroll
        for (int b = 0; b < 2; ++b)
#pragma unroll
            for (int m = 0; m < 4; ++m)
#pragma unroll
                for (int n = 0; n < 2; ++n) acc[a][b][m][n] = (f32x4){0.f, 0.f, 0.f, 0.f};
    bf16x8 At[4][2], B0[2][2], B1[2][2];
    const char* cA = cur.A; const char* cB = cur.B;
    S.a_ready(cur);
    if constexpr (SP2) {
        PG8_STAGEB(PG8_SB(0, 0), cB, 0, vbc); PG8_STAGEB(PG8_SB(0, 1), cB, 1, vbc); PG8_STAGEA(PG8_SA(0, 0), cA, 0, vgc); PG8_STAGEA(PG8_SA(0, 1), cA, 1, vgc);
        if (wr == 1) PG8_BAR;
        PG8_WAIT_V(2); PG8_BAR;
        PG8_STAGEB(PG8_SB(1, 0), cB + kstep, 0, vbc); PG8_STAGEA(PG8_SA(1, 0), cA + kstep, 0, vgc); PG8_STAGEB(PG8_SB(1, 1), cB + kstep, 1, vbc);
        PG8_WAIT_V(6); PG8_BAR;
    } else {
        PG8_STAGEB(PG8_SB(0, 0), cB, 0, vbc); PG8_STAGEA(PG8_SA(0, 0), cA, 0, vgc); PG8_STAGEB(PG8_SB(0, 1), cB, 1, vbc); PG8_STAGEA(PG8_SA(0, 1), cA, 1, vgc);
        if (wr == 1) PG8_BAR;
        PG8_WAIT_V(4); PG8_BAR;
        PG8_STAGEB(PG8_SB(1, 0), cB + kstep, 0, vbc); PG8_STAGEA(PG8_SA(1, 0), cA + kstep, 0, vgc); PG8_STAGEB(PG8_SB(1, 1), cB + kstep, 1, vbc);
        PG8_WAIT_V(6); PG8_BAR;
    }
    for (;;) {
        const bool has_next = S.next(ui + 1, nxt);
        const char* nA = has_next ? nxt.A : cA; const char* nB = has_next ? nxt.B : cB;
        if constexpr (GATHER) { if (has_next) PG8_LOADVG(vgn, nxt); }
        if constexpr (BSTRIDE) { if (has_next) PG8_LOADVB(vbn, nxt); }
        for (int t = 0; t < nt; t += 2) {
            if constexpr (Epi::MIDK > 0) { if (t == Epi::MIDK) { int ln_; asm volatile("v_mbcnt_lo_u32_b32 %0, -1, 0\n\tv_mbcnt_hi_u32_b32 %0, -1, %0" : "=v"(ln_)); E.mid(acc, cur, wr, wc, ln_ & 15, ln_ >> 4); } }
            const bool last = (t == nt - 2);
            if constexpr (GATHER) { _Pragma("unroll") for (int h_ = 0; h_ < 2; ++h_) _Pragma("unroll") for (int i_ = 0; i_ < 2; ++i_) vga[h_][i_] = (last && has_next) ? vgn[h_][i_] : vgc[h_][i_]; }
            if constexpr (BSTRIDE) { _Pragma("unroll") for (int h_ = 0; h_ < 2; ++h_) _Pragma("unroll") for (int i_ = 0; i_ < 2; ++i_) vbb[h_][i_] = (last && has_next) ? vbn[h_][i_] : vbc[h_][i_]; }
            const char* a1 = cA + (size_t)(t + 1) * kstep;
            const char* a2 = last ? nA : cA + (size_t)(t + 2) * kstep; const char* b2 = last ? nB : cB + (size_t)(t + 2) * kstep;
            const char* a3 = a2 + kstep; const char* b3 = b2 + kstep;
            if (last && has_next) S.a_ready(nxt);
            if constexpr (SP2) {
            PG8_LDB(B0, 0, 0); PG8_LDB(B1, 0, 1); PG8_SCHED; PG8_LDA(At, 0, 0); PG8_STAGEA(PG8_SA(1, 1), a1, 1, vgc);
            PG8_WAIT_V(8); PG8_WAIT_L(0); PG8_BAR; PG8_MMA(0, 0, At, B0); PG8_MMA(0, 1, At, B1); PG8_BAR; PG8_SCHED;
            PG8_LDA(At, 0, 1); PG8_STAGEB(PG8_SB(0, 0), b2, 0, vbb); PG8_STAGEB(PG8_SB(0, 1), b2, 1, vbb); PG8_STAGEA(PG8_SA(0, 0), a2, 0, vga);
            PG8_WAIT_V(8); PG8_WAIT_L(0); PG8_BAR; PG8_MMA(1, 0, At, B0); PG8_MMA(1, 1, At, B1); PG8_BAR; PG8_SCHED;
            PG8_LDB(B0, 1, 0); PG8_LDB(B1, 1, 1); PG8_SCHED; PG8_LDA(At, 1, 0); PG8_STAGEA(PG8_SA(0, 1), a2, 1, vga);
            PG8_WAIT_V(8); PG8_WAIT_L(0); PG8_BAR; PG8_MMA(0, 0, At, B0); PG8_MMA(0, 1, At, B1); PG8_BAR; PG8_SCHED;
            PG8_LDA(At, 1, 1); PG8_STAGEB(PG8_SB(1, 0), b3, 0, vbb); PG8_STAGEB(PG8_SB(1, 1), b3, 1, vbb); PG8_STAGEA(PG8_SA(1, 0), a3, 0, vga);
            PG8_WAIT_V(8); PG8_WAIT_L(0); PG8_BAR; PG8_MMA(1, 0, At, B0); PG8_MMA(1, 1, At, B1); PG8_BAR; PG8_SCHED;
            } else {
            PG8_LDB(B0, 0, 0); PG8_SCHED; PG8_LDA(At, 0, 0); PG8_STAGEA(PG8_SA(1, 1), a1, 1, vgc);
            PG8_WAIT_L(8); PG8_BAR; PG8_WAIT_L(0); PG8_MMA(0, 0, At, B0); PG8_BAR; PG8_SCHED;
            PG8_LDB(B1, 0, 1); PG8_STAGEB(PG8_SB(0, 0), b2, 0, vbb);
            PG8_BAR; PG8_WAIT_L(0); PG8_MMA(0, 1, At, B1); PG8_BAR;
            PG8_LDA(At, 0, 1); PG8_STAGEA(PG8_SA(0, 0), a2, 0, vga);
            PG8_BAR; PG8_WAIT_L(0); PG8_MMA(1, 0, At, B0); PG8_BAR; PG8_SCHED;
            PG8_STAGEB(PG8_SB(0, 1), b2, 1, vbb);
            PG8_WAIT_V(6); PG8_BAR; PG8_MMA(1, 1, At, B1); PG8_BAR;
            PG8_LDB(B0, 1, 0); PG8_SCHED; PG8_LDA(At, 1, 0); PG8_STAGEA(PG8_SA(0, 1), a2, 1, vga);
            PG8_WAIT_L(8); PG8_BAR; PG8_WAIT_L(0); PG8_MMA(0, 0, At, B0); PG8_BAR; PG8_SCHED;
            PG8_LDB(B1, 1, 1); PG8_STAGEB(PG8_SB(1, 0), b3, 0, vbb);
            PG8_BAR; PG8_WAIT_L(0); PG8_MMA(0, 1, At, B1); PG8_BAR;
            PG8_LDA(At, 1, 1); PG8_STAGEA(PG8_SA(1, 0), a3, 0, vga);
            PG8_BAR; PG8_WAIT_L(0); PG8_MMA(1, 0, At, B0); PG8_BAR; PG8_SCHED;
            PG8_STAGEB(PG8_SB(1, 1), b3, 1, vbb);
            PG8_WAIT_V(6); PG8_BAR; PG8_MMA(1, 1, At, B1); PG8_BAR;
            }
        }
        if constexpr (ALIGN_EPI) { if (wr == 0) PG8_BAR; }
        if constexpr (!Epi::AFTER_DRAIN) { int ln_; asm volatile("v_mbcnt_lo_u32_b32 %0, -1, 0\n\tv_mbcnt_hi_u32_b32 %0, -1, %0" : "=v"(ln_)); E(acc, cur, wr, wc, ln_ & 15, ln_ >> 4); S.done(cur); }
        if (!has_next) break;
#pragma unroll
        for (int a = 0; a < 2; ++a)
#pragma unroll
            for (int b = 0; b < 2; ++b)
#pragma unroll
                for (int m = 0; m < 4; ++m)
#pragma unroll
                    for (int n = 0; n < 2; ++n) acc[a][b][m][n] = (f32x4){0.f, 0.f, 0.f, 0.f};
        cur = nxt; cA = nA; cB = nB; ++ui;
        if constexpr (GATHER) { _Pragma("unroll") for (int h_ = 0; h_ < 2; ++h_) _Pragma("unroll") for (int i_ = 0; i_ < 2; ++i_) vgc[h_][i_] = vgn[h_][i_]; }
        if constexpr (BSTRIDE) { _Pragma("unroll") for (int h_ = 0; h_ < 2; ++h_) _Pragma("unroll") for (int i_ = 0; i_ < 2; ++i_) vbc[h_][i_] = vbn[h_][i_]; }
        if constexpr (ALIGN_EPI) { if (wr == 1) PG8_BAR; }
    }
    PG8_WAIT_V(0);
    if constexpr (!ALIGN_EPI) { if (wr == 0) PG8_BAR; }
    PG8_BAR;
    if constexpr (Epi::AFTER_DRAIN) { E.fused(acc, cur, wr, wc, fr, fq, lds, wid, lane); S.done(cur); }
#undef PG8_SA
#undef PG8_STAGEA
#undef PG8_STAGEB
#undef PG8_LOADVB
#undef PG8_LOADVG
#undef PG8_SB
#undef PG8_STAGE
#undef PG8_LDA
#undef PG8_LDB
#undef PG8_MMA
#undef PG8_WAIT_V
#undef PG8_WAIT_L
#undef PG8_BAR
#undef PG8_SCHED
}
}

#define LAS __attribute__((address_space(3)))
using pg8::f32x4; using pg8::u32x4; using pg8::Unit;
__device__ __forceinline__ u32x4 pack8(const f32x4 a, const f32x4 b) { u32x4 w; w.x = pg8::cvt_pk_bf16(a[0], a[1]); w.y = pg8::cvt_pk_bf16(a[2], a[3]); w.z = pg8::cvt_pk_bf16(b[0], b[1]); w.w = pg8::cvt_pk_bf16(b[2], b[3]); return w; }
__device__ __forceinline__ float bflo(unsigned x) { return __uint_as_float(x << 16); }
__device__ __forceinline__ float bfhi(unsigned x) { return __uint_as_float(x & 0xffff0000u); }
typedef unsigned u32x2 __attribute__((ext_vector_type(2)));
__device__ __forceinline__ void nv_rope(const int tid, const int bid, CP p, float* rope) {
    VLOOP(1024) { const int idx = vb * 256 + VT_; const int j = idx % 32, pos = idx / 32;
        double rev = (double)pos * p.ri.inv[j] * 0.15915494309189535; rev -= floor(rev);
        rope[idx * 2] = cos_rev((float)rev); rope[idx * 2 + 1] = sin_rev((float)rev); }
}
__device__ __forceinline__ void nv_h3(const int tid, const int bid, CP p, _Float16* h3, unsigned char* sm) {
    float (*zs)[64] = (float (*)[64])sm; float (*hs)[64] = (float (*)[64])(sm + 1024);
    VLOOP(DEPTH * L / 4) {
        const int wv = VT_ >> 6, j = VT_ & 63;
        const int gi = vb * 4 + wv; const int layer = gi / L, l = gi % L;
        const float tpos = (float)l / (float)(L - 1);
        const float wrev = (float)l / (float)L;
        __syncthreads();
        if (j < HY_EMB) {
            float z;
            if (j == 0) z = tpos;
            else { const int i = (j - 1) % 16; const float f = 1e-4f + (15.0f - 1e-4f) * (float)i / 15.0f; z = (j <= 16) ? cos_rev(f * wrev) : -sin_rev(f * wrev); }
            zs[wv][j] = z;
        }
        __syncthreads();
        const float fr = p.hf_freq[layer * 64 + j];
        float a = p.hf_b1[layer * 64 + j];
        for (int i = 0; i < HY_EMB; ++i) a += zs[wv][i] * p.hf_w1[(layer * HY_EMB + i) * 64 + j];
        float h = sin_rad(fr * a);
        hs[wv][j] = h; __syncthreads();
        a = p.hf_b2[layer * 64 + j];
        for (int i = 0; i < 64; ++i) a += hs[wv][i] * p.hf_w2[(layer * 64 + i) * 64 + j];
        h = sin_rad(fr * a); __syncthreads();
        hs[wv][j] = h; __syncthreads();
        a = p.hf_b3[layer * 64 + j];
        for (int i = 0; i < 64; ++i) a += hs[wv][i] * p.hf_w3[(layer * 64 + i) * 64 + j];
        h = sin_rad(fr * a);
        h3[(size_t)gi * 256 + j] = (_Float16)h; h3[(size_t)gi * 256 + 64 + j] = (_Float16)0.f; h3[(size_t)gi * 256 + 128 + j] = (_Float16)0.f; h3[(size_t)gi * 256 + 192 + j] = (_Float16)0.f;
    }
}
template <bool COMBINE, bool FINAL>
__device__ __forceinline__ void ph_norm(const int tid, const int bid, const float* x_in, float* x_out, const float* g, const float* mod_l, bf16_t* XN, const bf16_t* YB, const int* POS, const float* WTS, const float* mod_prev) {
    const int lane = tid & 63, wave = tid >> 6;
    for (int row0 = (bid * 8 + wave) * 2; row0 < T; row0 += (int)gridDim.x * 16) {
        const int b = row0 / L;
        f32x4 xv[2][4]; u32x2 ya[2][4], yb[2][4]; float w0[2] = {0.f, 0.f}, w1[2] = {0.f, 0.f};
        if (COMBINE) {
            int p0[2], p1[2];
#pragma unroll
            for (int r = 0; r < 2; ++r) { const int row = row0 + r; p0[r] = POS[row * 2]; p1[r] = POS[row * 2 + 1]; w0[r] = WTS[row * 2]; w1[r] = WTS[row * 2 + 1]; }
#pragma unroll
            for (int r = 0; r < 2; ++r)
#pragma unroll
                for (int j = 0; j < 4; ++j) { const int col = j * 256 + lane * 4; ya[r][j] = *(const u32x2*)(YB + (size_t)p0[r] * D + col); yb[r][j] = *(const u32x2*)(YB + (size_t)p1[r] * D + col); }
        }
#pragma unroll
        for (int r = 0; r < 2; ++r)
#pragma unroll
            for (int j = 0; j < 4; ++j) xv[r][j] = *(const f32x4*)(x_in + (size_t)(row0 + r) * D + j * 256 + lane * 4);
        float ss[2] = {0.f, 0.f};
#pragma unroll
        for (int r = 0; r < 2; ++r)
#pragma unroll
            for (int j = 0; j < 4; ++j) { const int col = j * 256 + lane * 4;
                if (COMBINE) { const f32x4 g2v = *(const f32x4*)(mod_prev + b * 6144 + 5 * 1024 + col);
#pragma unroll
                    for (int i = 0; i < 4; ++i) { const float y = w0[r] * (i & 1 ? bfhi(ya[r][j][i >> 1]) : bflo(ya[r][j][i >> 1])) + w1[r] * (i & 1 ? bfhi(yb[r][j][i >> 1]) : bflo(yb[r][j][i >> 1])); xv[r][j][i] += g2v[i] * y; } }
                ss[r] += xv[r][j][0] * xv[r][j][0] + xv[r][j][1] * xv[r][j][1] + xv[r][j][2] * xv[r][j][2] + xv[r][j][3] * xv[r][j][3];
                if (!FINAL) *(f32x4*)(x_out + (size_t)(row0 + r) * D + col) = xv[r][j]; }
#pragma unroll
        for (int r = 0; r < 2; ++r) ss[r] = wave_sum(ss[r], lane);
#pragma unroll
        for (int r = 0; r < 2; ++r) { const float rstd = rsqrtf(ss[r] * (1.0f / D) + NORM_EPS);
#pragma unroll
            for (int j = 0; j < 4; ++j) { const int col = j * 256 + lane * 4; const f32x4 gv = *(const f32x4*)(g + col);
                if (FINAL) { *(f32x4*)(x_out + (size_t)(row0 + r) * D + col) = xv[r][j] * rstd * gv; }
                else { const f32x4 sc = *(const f32x4*)(mod_l + b * 6144 + 1024 + col), sh = *(const f32x4*)(mod_l + b * 6144 + col);
                    const f32x4 y = xv[r][j] * rstd * gv * (sc + 1.f) + sh;
                    u32x2 o; o.x = pg8::cvt_pk_bf16(y[0], y[1]); o.y = pg8::cvt_pk_bf16(y[2], y[3]);
                    *(u32x2*)(XN + (size_t)(row0 + r) * D + col) = o; } } }
    }
}
__device__ __forceinline__ void nv_gemm1(const int tid, const int bid, const bf16_t* XN, const float* w_in, const float* rope, bf16_t* UT, bf16_t* QS, bf16_t* KS, bf16_t* VT, bf16_t* GATES, unsigned char* smraw) {
    float (*sm)[256] = (float (*)[256])smraw;
    VLOOP(26 * (T / 8)) {
        const int tx = VT_; const int n = (vb % 26) * 256 + tx, t0 = (vb / 26) * 8;
        float acc[8];
#pragma unroll
        for (int i = 0; i < 8; ++i) acc[i] = 0.f;
        for (int k = 0; k < D; ++k) { const float w = w_in[(size_t)k * INC + n];
#pragma unroll
            for (int i = 0; i < 8; ++i) acc[i] += bf2f(XN[(size_t)(t0 + i) * D + k]) * w; }
        __syncthreads();
#pragma unroll
        for (int i = 0; i < 8; ++i) sm[i][tx] = acc[i];
        __syncthreads();
#pragma unroll
        for (int i = 0; i < 8; ++i) {
            const int tt = t0 + i, b = tt / L, t = tt % L;
            if (n < C3) UT[(size_t)n * T + tt] = f2bf(acc[i]);
            else if (n < C3 + 2 * HYW) {
                const int isk = n >= C3 + HYW; const int cc = n - C3 - isk * HYW; const int h = cc / 64, d = cc % 64;
                if (d < 32) {
                    const float a = acc[i], bb = sm[i][tx + 32];
                    const float cs = rope[(t * 32 + d) * 2], sn = rope[(t * 32 + d) * 2 + 1];
                    float o1 = a * cs - bb * sn, o2 = bb * cs + a * sn;
                    if (!isk) { o1 *= QSCALE; o2 *= QSCALE; }
                    bf16_t* dst = (isk ? KS : QS) + qk_row(b, h, t) * 64;
                    dst[permd(d)] = f2bf(o1); dst[permd(d + 32)] = f2bf(o2);
                }
            } else if (n < C3 + 3 * HYW) { const int cc = n - C3 - 2 * HYW; VT[vt_off(b, cc / 64, t, cc % 64)] = f2bf(acc[i]); }
            else GATES[(size_t)tt * 2048 + (n - (C3 + 3 * HYW))] = f2bf(sigmoidf_(acc[i]));
        }
    }
}
__device__ __forceinline__ void nv_merge(const int tid, const int bid, const bf16_t* YCAT, const float* w_br_h, const float* w_br_a, const bf16_t* GATES, bf16_t* MERGED) {
    VLOOP(4 * (T / 8)) { const int n = (vb % 4) * 256 + VT_, t0 = (vb / 4) * 8;
        float a1[8], a2[8];
#pragma unroll
        for (int i = 0; i < 8; ++i) { a1[i] = 0.f; a2[i] = 0.f; }
        for (int k = 0; k < 768; ++k) { const float w = w_br_h[(size_t)k * D + n];
#pragma unroll
            for (int i = 0; i < 8; ++i) a1[i] += bf2f(YCAT[(size_t)(t0 + i) * D + k]) * w; }
        for (int k = 0; k < 256; ++k) { const float w = w_br_a[(size_t)k * D + n];
#pragma unroll
            for (int i = 0; i < 8; ++i) a2[i] += bf2f(YCAT[(size_t)(t0 + i) * D + 768 + k]) * w; }
#pragma unroll
        for (int i = 0; i < 8; ++i) { const size_t tt = t0 + i; MERGED[tt * D + n] = f2bf(bf2f(GATES[tt * 2048 + n]) * a1[i] + bf2f(GATES[tt * 2048 + 1024 + n]) * a2[i]); } }
}
__device__ __forceinline__ void nv_out(const int tid, const int bid, const bf16_t* MERGED, const float* w_out, const float* mod_l, float* x) {
    VLOOP(4 * (T / 8)) { const int n = (vb % 4) * 256 + VT_, t0 = (vb / 4) * 8;
        float a[8];
#pragma unroll
        for (int i = 0; i < 8; ++i) a[i] = 0.f;
        for (int k = 0; k < D; ++k) { const float w = w_out[(size_t)k * D + n];
#pragma unroll
            for (int i = 0; i < 8; ++i) a[i] += bf2f(MERGED[(size_t)(t0 + i) * D + k]) * w; }
#pragma unroll
        for (int i = 0; i < 8; ++i) { const size_t tt = t0 + i; const int b = (int)(tt / L); x[tt * D + n] += mod_l[b * 6144 + 2 * 1024 + n] * a[i]; } }
}
__device__ __forceinline__ void ph_route(const int tid, const int bid, CP p, int layer, unsigned char* ws, float* x, LAS unsigned char* lds) {
    const int lane = tid & 63, wave = tid >> 6;
    LAS float* rwt = (LAS float*)lds;
    LAS int* sel_l = (LAS int*)(lds + 65536);
    LAS int* cntw = (LAS int*)(lds + 65536 + 512);
    LAS int* base_l = (LAS int*)(lds + 65536 + 1024);
    const float* g = p.norm2_g + layer * D; const float* mod_l = (const float*)(ws + WS_MOD) + (size_t)layer * NB * 6144;
    bf16_t* XN = (bf16_t*)(ws + WS_XN); int* SEL = (int*)(ws + WS_SEL); float* WTS = (float*)(ws + WS_WTS); int* CNT = (int*)(ws + WS_CTL + CTL_CNT) + layer * 1024;     int* LIST = (int*)(ws + WS_LIST); int* RANK = (int*)(ws + WS_RANK);
    for (int i = tid; i < 1024 * 4; i += 512) { const int col = i >> 2, e4 = (i & 3) * 4; const float4 w = *(const float4*)(p.router_w + (size_t)col * 16 + e4);
        rwt[(e4 + 0) * 1024 + col] = w.x; rwt[(e4 + 1) * 1024 + col] = w.y; rwt[(e4 + 2) * 1024 + col] = w.z; rwt[(e4 + 3) * 1024 + col] = w.w; }
    const float rbias = p.router_bias[lane & 15];
    __syncthreads();
    for (int blk = bid; blk < T / 64; blk += (int)gridDim.x) {
        const int b = (blk * 64) / L;
        f32x4 xn[4];
#pragma unroll
        for (int j = 0; j < 4; ++j) xn[j] = *(const f32x4*)(x + (size_t)(blk * 64 + wave) * D + j * 256 + lane * 4);
#pragma unroll 1
        for (int it = 0; it < 8; ++it) {
            const int rl = it * 8 + wave, row = blk * 64 + rl;
            f32x4 v[4]; float ss = 0.f;
#pragma unroll
            for (int j = 0; j < 4; ++j) { v[j] = xn[j]; ss += v[j][0] * v[j][0] + v[j][1] * v[j][1] + v[j][2] * v[j][2] + v[j][3] * v[j][3]; }
            if (it < 7) {
#pragma unroll
                for (int j = 0; j < 4; ++j) xn[j] = *(const f32x4*)(x + (size_t)(row + 8) * D + j * 256 + lane * 4);
            }
            ss = wave_sum(ss, lane);
            const float rstd = rsqrtf(ss * (1.0f / D) + NORM_EPS);
#pragma unroll
            for (int j = 0; j < 4; ++j) { const int col = j * 256 + lane * 4;
                const f32x4 gv = *(const f32x4*)(g + col), sc = *(const f32x4*)(mod_l + b * 6144 + 4 * 1024 + col), sh = *(const f32x4*)(mod_l + b * 6144 + 3 * 1024 + col);
                v[j] = v[j] * rstd * gv * (sc + 1.f) + sh;
                u32x2 o; o.x = pg8::cvt_pk_bf16(v[j][0], v[j][1]); o.y = pg8::cvt_pk_bf16(v[j][2], v[j][3]);
                *(u32x2*)(XN + (size_t)row * D + col) = o; }
            float lg[16];
#pragma unroll
            for (int e = 0; e < 16; ++e) { float a = 0.f;
#pragma unroll
                for (int j = 0; j < 4; ++j) { const f32x4 w = *(const LAS f32x4*)(rwt + e * 1024 + j * 256 + lane * 4); a += v[j][0] * w[0] + v[j][1] * w[1] + v[j][2] * w[2] + v[j][3] * w[3]; }
                lg[e] = a; }
#pragma unroll
            for (int e = 0; e < 16; ++e) lg[e] = wave_sum(lg[e], lane);
            float mylg = lg[0];
#pragma unroll
            for (int e = 1; e < 16; ++e) mylg = ((lane & 15) == e) ? lg[e] : mylg;
            const float sc = 1.f / (1.f + expf(-mylg)), bi = sc + rbias;
            const float q1 = shx(bi, 1, lane), q2 = shx(bi, 2, lane), q3 = shx(bi, 3, lane);
            float m1 = fmaxf(fmaxf(bi, q1), fmaxf(q2, q3));
            const float gs = fmaxf(fmaxf(fmaxf(bi + q1, bi + q2), fmaxf(bi + q3, q1 + q2)), fmaxf(q1 + q3, q2 + q3)); (void)m1;
            const float g0 = rdlane(gs, 0), g1 = rdlane(gs, 4), g2 = rdlane(gs, 8), g3 = rdlane(gs, 12);
            int sel = 0; float best = g0; if (g1 > best) { best = g1; sel = 1; } if (g2 > best) { best = g2; sel = 2; } if (g3 > best) { best = g3; sel = 3; }
            sel = __builtin_amdgcn_readfirstlane(sel);
            float gv4[4], gs4[4];
#pragma unroll
            for (int i = 0; i < 4; ++i) { gv4[i] = rdlane(bi, sel * 4 + i); gs4[i] = rdlane(sc, sel * 4 + i); }
            int i1 = 0; float t1 = gv4[0];
#pragma unroll
            for (int i = 1; i < 4; ++i) { if (gv4[i] > t1) { t1 = gv4[i]; i1 = i; } }
            int i2 = 0; float t2 = -1e30f;
#pragma unroll
            for (int i = 0; i < 4; ++i) { if (i != i1 && gv4[i] > t2) { t2 = gv4[i]; i2 = i; } }
            float s1 = 0.f, s2 = 0.f;
#pragma unroll
            for (int i = 0; i < 4; ++i) { s1 = (i == i1) ? gs4[i] : s1; s2 = (i == i2) ? gs4[i] : s2; }
            if (lane == 0) { const int e1 = sel * 4 + i1, e2 = sel * 4 + i2; const float s = s1 + s2;
                SEL[row * 2] = e1; SEL[row * 2 + 1] = e2; WTS[row * 2] = s1 / s; WTS[row * 2 + 1] = s2 / s;
                sel_l[rl * 2] = e1; sel_l[rl * 2 + 1] = e2; }
        }
        __syncthreads();
        int my_e = 0, my_r = 0;
        if (tid < 128) { my_e = sel_l[tid];
#pragma unroll
            for (int q = 0; q < 16; ++q) { const unsigned long long m = __ballot(my_e == q); if (my_e == q) my_r = __popcll(m & ((1ull << lane) - 1ull)); if (lane == 0) cntw[wave * 16 + q] = __popcll(m); } }
        __syncthreads();
        if (tid < 16) { const int cnt = cntw[tid] + cntw[16 + tid]; base_l[tid] = cnt ? atomicAdd(CNT + tid * 64, cnt) : 0; }
        __syncthreads();
        if (tid < 128) { const int r = base_l[my_e] + my_r + (wave == 1 ? cntw[my_e] : 0), row = blk * 64 + (tid >> 1); LIST[my_e * 16384 + r] = row; RANK[row * 2 + (tid & 1)] = r; }
        __syncthreads();
    }
}
__device__ __forceinline__ void nv_moe_up(const int tid, const int bid, const bf16_t* XN, const int* SEL, const float* w1, const float* w3, bf16_t* ACT) {
    VLOOP(T * 2) { const int rs = vb; const int tok = rs >> 1; const int e = SEL[rs];
        const float* W1 = w1 + (size_t)e * D * DEXP; const float* W3 = w3 + (size_t)e * D * DEXP;
        const int f = VT_;
        float a1 = 0.f, a3 = 0.f, c1 = 0.f, c3 = 0.f;
        for (int k = 0; k < D; ++k) { const float h = bf2f(XN[(size_t)tok * D + k]); a1 += h * W1[(size_t)k * DEXP + f]; a3 += h * W3[(size_t)k * DEXP + f]; c1 += h * W1[(size_t)k * DEXP + 256 + f]; c3 += h * W3[(size_t)k * DEXP + 256 + f]; }
        ACT[(size_t)rs * DEXP + f] = f2bf(siluf_(a1) * a3); ACT[(size_t)rs * DEXP + 256 + f] = f2bf(siluf_(c1) * c3); }
}
__device__ __forceinline__ void nv_moe_down(const int tid, const int bid, const bf16_t* ACT, const int* SEL, const float* w2, bf16_t* YB) {
    VLOOP(T * 2) { const int rs = vb; const int e = SEL[rs];
        const float* W2 = w2 + (size_t)e * DEXP * D;
        float a[4] = {0.f, 0.f, 0.f, 0.f};
        for (int k = 0; k < DEXP; ++k) { const float h = bf2f(ACT[(size_t)rs * DEXP + k]);
#pragma unroll
            for (int j = 0; j < 4; ++j) a[j] += h * W2[(size_t)k * D + j * 256 + VT_]; }
#pragma unroll
        for (int j = 0; j < 4; ++j) YB[(size_t)rs * D + j * 256 + VT_] = f2bf(a[j]); }
}


__device__ __forceinline__ void cvt_item(const float* W, int ldw, int ncol0, bf16_t* WT, int ldk, int koff, int rowmap, int rowbase, int nblk, int item, LAS float* scr, int lane) {
    const int kb = item / nblk, nb = item % nblk, k0 = 64 * kb, n0 = 32 * nb;
#pragma unroll
    for (int i = 0; i < 8; ++i) { const int kk = 8 * i + (lane >> 3), nn = (lane & 7) * 4; const float4 w4 = *(const float4*)(W + (size_t)(k0 + kk) * ldw + ncol0 + n0 + nn);
        LAS float* d = scr + kk * 33 + nn; d[0] = w4.x; d[1] = w4.y; d[2] = w4.z; d[3] = w4.w; }
    asm volatile("s_waitcnt lgkmcnt(0)" ::: "memory");
    const int c = lane & 7;
#pragma unroll
    for (int j = 0; j < 4; ++j) { const int n = (lane >> 3) + 8 * j; const LAS float* s = scr + (8 * c) * 33 + n; const int nrel = n0 + n;
        const int row = rowbase + (rowmap == 0 ? nrel : (rowmap == 1 ? ((nrel & ~63) + permd(nrel & 63)) : ((nrel >> 7) * 256 + (nrel & 127))));
        u32x4 o; o.x = pg8::cvt_pk_bf16(s[0 * 33], s[1 * 33]); o.y = pg8::cvt_pk_bf16(s[2 * 33], s[3 * 33]); o.z = pg8::cvt_pk_bf16(s[4 * 33], s[5 * 33]); o.w = pg8::cvt_pk_bf16(s[6 * 33], s[7 * 33]);
        *(u32x4*)(WT + (size_t)row * ldk + koff + k0 + 8 * c) = o; }
    asm volatile("s_waitcnt lgkmcnt(0)" ::: "memory");
}
__device__ __forceinline__ void ph_convert(const int tid, const int bid, CP p, int layer, unsigned char* ws, LAS unsigned char* lds) {
    const int lane = tid & 63, wave = tid >> 6;
    LAS float* scr = (LAS float*)(lds + wave * 8704);
    const float* w_in = p.w_in + (size_t)layer * D * INC;
    bf16_t* WA = (bf16_t*)(ws + WS_WA); bf16_t* WB = (bf16_t*)(ws + WS_WB); bf16_t* WCAT = (bf16_t*)(ws + WS_WCAT); bf16_t* WOUT = (bf16_t*)(ws + WS_WOUT);
    bf16_t* W13 = (bf16_t*)(ws + WS_W13); bf16_t* W2 = (bf16_t*)(ws + WS_W2);
    const int gw = bid * 8 + wave, NGW = gridDim.x * 8;
    for (int it = gw; it < 16640; it += NGW) {
        int r = it;
        if (r < 768) { cvt_item(w_in, INC, 2304, WA, 1024, 0, 1, 0, 48, r, scr, lane); continue; } r -= 768;
        if (r < 1024) { cvt_item(w_in, INC, 4608, WA, 1024, 0, 0, 1536, 64, r, scr, lane); continue; } r -= 1024;
        if (r < 1152) { cvt_item(w_in, INC, 0, WB, 1024, 0, 0, 0, 72, r, scr, lane); continue; } r -= 1152;
        if (r < 384) { cvt_item(w_in, INC, 3840, WB, 1024, 0, 0, 2304, 24, r, scr, lane); continue; } r -= 384;
        if (r < 384) { cvt_item(p.w_br_h + (size_t)layer * HYW * D, D, 0, WCAT, 1024, 0, 0, 0, 32, r, scr, lane); continue; } r -= 384;
        if (r < 128) { cvt_item(p.w_br_a + (size_t)layer * ATT_OUT * D, D, 0, WCAT, 1024, 768, 0, 0, 32, r, scr, lane); continue; } r -= 128;
        if (r < 512) { cvt_item(p.w_out + (size_t)layer * D * D, D, 0, WOUT, 1024, 0, 0, 0, 32, r, scr, lane); continue; } r -= 512;
        const int e = r / 768; r -= e * 768;
        if (r < 256) cvt_item(p.moe_w1 + ((size_t)layer * NE + e) * D * DEXP, DEXP, 0, W13 + (size_t)e * 1024 * 1024, 1024, 0, 2, 0, 16, r, scr, lane);
        else if (r < 512) cvt_item(p.moe_w3 + ((size_t)layer * NE + e) * D * DEXP, DEXP, 0, W13 + (size_t)e * 1024 * 1024, 1024, 0, 2, 128, 16, r - 256, scr, lane);
        else cvt_item(p.moe_w2 + ((size_t)layer * NE + e) * DEXP * D, D, 0, W2 + (size_t)e * 1024 * 512, 512, 0, 0, 0, 32, r - 512, scr, lane);
    }
}

struct SchedG1a {
    const char *XN, *WA; int G, c;
    __device__ __forceinline__ bool next(int i, Unit& u) const {
        const int id = i * G + c; if (id >= 896) return false;
        pg8::tile_of(id, 64, 14, u.pm, u.pn); u.kind = 0; u.bstride = 1; u.A = XN + (size_t)u.pm * 524288; u.B = WA + (size_t)u.pn * 524288; return true;
    }
    __device__ __forceinline__ void a_ready(const Unit&) const {}
    __device__ __forceinline__ void done(const Unit&) const {}
};
struct SchedG1b {
    const char *XN, *WB; int G, c;
    __device__ __forceinline__ bool next(int i, Unit& u) const {
        const int id = i * G + c; if (id >= 768) return false;
        pg8::tile_of(id, 12, 64, u.pm, u.pn); u.kind = 1; u.A = WB + (size_t)u.pm * 524288;
        if (u.pm < 9) { u.bstride = 1; u.B = XN + (size_t)u.pn * 524288; u.nvalid = 0; }
        else { const int lsh = u.pm == 9 ? 13 : (u.pm == 10 ? 11 : 9), d = 1 << (13 - lsh), b = u.pn >> 5, v0 = (u.pn & 31) * 256, r = v0 >> lsh, m0 = v0 & ((1 << lsh) - 1);
            u.bstride = d; u.nvalid = r; u.B = XN + (size_t)(b * L + m0 * d + r) * 2048; }
        return true;
    }
    __device__ __forceinline__ void a_ready(const Unit&) const {}
    __device__ __forceinline__ void done(const Unit&) const {}
};
struct SchedDense {
    const char *A, *B; int nM, nN, G, c; size_t tstep;
    __device__ __forceinline__ bool next(int i, Unit& u) const {
        const int id = i * G + c; if (id >= nM * nN) return false;
        pg8::tile_of(id, nM, nN, u.pm, u.pn); u.kind = 0; u.A = A + (size_t)u.pm * tstep; u.B = B + (size_t)u.pn * tstep; return true;
    }
    __device__ __forceinline__ void a_ready(const Unit&) const {}
    __device__ __forceinline__ void done(const Unit&) const {}
};
struct EpiG1a {
    static constexpr bool PERM = true, AFTER_DRAIN = false; static constexpr int MIDK = 0;
    unsigned char* ws;
    __device__ __forceinline__ void mid(f32x4 (&)[2][2][4][2], const Unit&, int, int, int, int) const {}
    __device__ __forceinline__ void operator()(const f32x4 (&acc)[2][2][4][2], const Unit& u, int wr, int wc, int fr, int fq) const {
        asm volatile("" : "+v"(fr), "+v"(fq));
        unsigned wlo_ = __builtin_amdgcn_readfirstlane((unsigned)(uintptr_t)ws), whi_ = __builtin_amdgcn_readfirstlane((unsigned)((uintptr_t)ws >> 32)); asm volatile("" : "+s"(wlo_), "+s"(whi_));
        unsigned char* w_ = (unsigned char*)(((uintptr_t)whi_ << 32) | wlo_);
        bf16_t *UT = (bf16_t*)(w_ + WS_UT), *QS = (bf16_t*)(w_ + WS_QS), *KS = (bf16_t*)(w_ + WS_KS), *VT = (bf16_t*)(w_ + WS_VT), *GATES = (bf16_t*)(w_ + WS_GATES); const float* rope = (const float*)(w_ + WS_ROPE);
        const int colt = u.pn * 256;
        if (colt < 1536) {
            const int isk = colt >= 768; const int pc = (wc * 32 + 8 * fq) & 63, j0 = pc >> 1; bf16_t* dstb = isk ? KS : QS;
            const int tok0 = u.pm * 256 + wr * 64 + fr;
            f32x4 rc[2][2];
            { const int t = tok0 & 8191; rc[0][0] = *(const f32x4*)(rope + ((size_t)t * 32 + j0) * 2); rc[0][1] = *(const f32x4*)(rope + ((size_t)t * 32 + j0 + 2) * 2); }
#pragma unroll
            for (int gi = 0; gi < 8; ++gi) { const int ai = gi >> 2, m = gi & 3; const int tok = tok0 + ai * 128 + m * 16; const int b = tok >> 13, t = tok & 8191;
                if (gi < 7) { const int tn = (tok0 + ((gi + 1) >> 2) * 128 + ((gi + 1) & 3) * 16) & 8191; rc[(gi + 1) & 1][0] = *(const f32x4*)(rope + ((size_t)tn * 32 + j0) * 2); rc[(gi + 1) & 1][1] = *(const f32x4*)(rope + ((size_t)tn * 32 + j0 + 2) * 2); }
                const f32x4 r0 = rc[gi & 1][0], r1 = rc[gi & 1][1];
#pragma unroll
                for (int bj = 0; bj < 2; ++bj) { const int cc = colt - isk * 768 + bj * 128 + wc * 32 + 8 * fq, h = cc >> 6;
                    const f32x4 v0 = acc[ai][bj][m][0], v1 = acc[ai][bj][m][1];
                    f32x4 o0, o1;
                    o0[0] = v0[0] * r0[0] - v0[1] * r0[1]; o0[1] = v0[1] * r0[0] + v0[0] * r0[1]; o0[2] = v0[2] * r0[2] - v0[3] * r0[3]; o0[3] = v0[3] * r0[2] + v0[2] * r0[3];
                    o1[0] = v1[0] * r1[0] - v1[1] * r1[1]; o1[1] = v1[1] * r1[0] + v1[0] * r1[1]; o1[2] = v1[2] * r1[2] - v1[3] * r1[3]; o1[3] = v1[3] * r1[2] + v1[2] * r1[3];
                    if (!isk) { o0 = o0 * QSCALE; o1 = o1 * QSCALE; }
                    *(u32x4*)(dstb + qk_row(b, h, t) * 64 + pc) = pack8(o0, o1); }
                asm volatile("" ::: "memory"); }
        } else {
#pragma unroll
            for (int ai = 0; ai < 2; ++ai)
#pragma unroll
                for (int m = 0; m < 4; ++m) { const int tok = u.pm * 256 + ai * 128 + wr * 64 + m * 16 + fr;
#pragma unroll
                    for (int bj = 0; bj < 2; ++bj) { const int c0 = colt + bj * 128 + wc * 32 + 8 * fq;
                        f32x4 s0, s1;
#pragma unroll
                        for (int i = 0; i < 4; ++i) { s0[i] = sigmoidf_(acc[ai][bj][m][0][i]); s1[i] = sigmoidf_(acc[ai][bj][m][1][i]); }
                        *(u32x4*)(GATES + (size_t)tok * 2048 + (c0 - 1536)) = pack8(s0, s1); } }
        }
    }
};
struct EpiG1b {
    static constexpr bool PERM = true, AFTER_DRAIN = false; static constexpr int MIDK = 0;
    unsigned char* ws;
    __device__ __forceinline__ void mid(f32x4 (&)[2][2][4][2], const Unit&, int, int, int, int) const {}
    __device__ __forceinline__ void operator()(const f32x4 (&acc)[2][2][4][2], const Unit& u, int wr, int wc, int fr, int fq) const {
        asm volatile("" : "+v"(fr), "+v"(fq));
        unsigned wlo_ = __builtin_amdgcn_readfirstlane((unsigned)(uintptr_t)ws), whi_ = __builtin_amdgcn_readfirstlane((unsigned)((uintptr_t)ws >> 32)); asm volatile("" : "+s"(wlo_), "+s"(whi_));
        unsigned char* w_ = (unsigned char*)(((uintptr_t)whi_ << 32) | wlo_);
        bf16_t *UT = (bf16_t*)(w_ + WS_UT), *QS = (bf16_t*)(w_ + WS_QS), *KS = (bf16_t*)(w_ + WS_KS), *VT = (bf16_t*)(w_ + WS_VT), *GATES = (bf16_t*)(w_ + WS_GATES); const float* rope = (const float*)(w_ + WS_ROPE);
        {
#pragma unroll
            for (int ai = 0; ai < 2; ++ai)
#pragma unroll
                for (int m = 0; m < 4; ++m) { const int row = u.pm * 256 + ai * 128 + wr * 64 + m * 16 + fr;
#pragma unroll
                    for (int bj = 0; bj < 2; ++bj) { const int vi = bj * 128 + wc * 32 + 8 * fq;
                        const u32x4 w = pack8(acc[ai][bj][m][0], acc[ai][bj][m][1]);
                        if (u.pm < 9) *(u32x4*)(UT + (size_t)row * T + u.pn * 256 + vi) = w;
                        else { const int lsh = u.pm == 9 ? 13 : (u.pm == 10 ? 11 : 9); const int cc = row - 2304, h = cc >> 6, dv = cc & 63, b = u.pn >> 5, m0 = ((u.pn & 31) * 256) & ((1 << lsh) - 1);
                            *(u32x4*)(VT + (size_t)(b * NH + h) * L * 64 + ((size_t)(u.nvalid * 64 + dv) << lsh) + m0 + vi) = w; } }
                    asm volatile("" ::: "memory"); }
        }
    }
};
struct EpiMerge {
    static constexpr bool PERM = true, AFTER_DRAIN = false; static constexpr int MIDK = 12;
    unsigned char* ws;
    __device__ __forceinline__ void mid(f32x4 (&acc)[2][2][4][2], const Unit& u, int wr, int wc, int fr, int fq) const {
        asm volatile("" : "+v"(fr), "+v"(fq));
        unsigned char* w_ = ws; asm volatile("" : "+s"(w_)); const bf16_t* GATES = (const bf16_t*)(w_ + WS_GATES);
        const bf16_t* gp = GATES + (size_t)(u.pm * 256 + wr * 64 + fr) * 2048 + u.pn * 256 + wc * 32 + 8 * fq;
        u32x4 gb[2][4];
#pragma unroll
        for (int bj = 0; bj < 2; ++bj) { gb[0][bj * 2] = *(const u32x4*)(gp + bj * 128); gb[0][bj * 2 + 1] = *(const u32x4*)(gp + 1024 + bj * 128); }
#pragma unroll
        for (int gi = 0; gi < 8; ++gi) { const int ai = gi >> 2, m = gi & 3;
            if (gi < 7) { const bf16_t* gn = gp + (size_t)(((gi + 1) >> 2) * 128 + ((gi + 1) & 3) * 16) * 2048;
#pragma unroll
                for (int bj = 0; bj < 2; ++bj) { gb[(gi + 1) & 1][bj * 2] = *(const u32x4*)(gn + bj * 128); gb[(gi + 1) & 1][bj * 2 + 1] = *(const u32x4*)(gn + 1024 + bj * 128); } }
#pragma unroll
            for (int bj = 0; bj < 2; ++bj) { const u32x4 g1 = gb[gi & 1][bj * 2], g2 = gb[gi & 1][bj * 2 + 1];
#pragma unroll
                for (int i = 0; i < 4; ++i) { const float rl = bflo(g1[i]) * __builtin_amdgcn_rcpf(fmaxf(bflo(g2[i]), 1e-20f)), rh = bfhi(g1[i]) * __builtin_amdgcn_rcpf(fmaxf(bfhi(g2[i]), 1e-20f));
                    acc[ai][bj][m][i >> 1][(i & 1) * 2] *= rl; acc[ai][bj][m][i >> 1][(i & 1) * 2 + 1] *= rh; } }
            asm volatile("" : "+v"(acc[ai][0][m][0]), "+v"(acc[ai][0][m][1]), "+v"(acc[ai][1][m][0]), "+v"(acc[ai][1][m][1]) :: "memory"); }
    }
    __device__ __forceinline__ void operator()(const f32x4 (&acc)[2][2][4][2], const Unit& u, int wr, int wc, int fr, int fq) const {
        asm volatile("" : "+v"(fr), "+v"(fq));
        unsigned char* w_ = ws; asm volatile("" : "+s"(w_)); const bf16_t* GATES = (const bf16_t*)(w_ + WS_GATES); bf16_t* MERGED = (bf16_t*)(w_ + WS_MERGED);
        const bf16_t* gp = GATES + (size_t)(u.pm * 256 + wr * 64 + fr) * 2048 + 1024 + u.pn * 256 + wc * 32 + 8 * fq;
        bf16_t* op = MERGED + (size_t)(u.pm * 256 + wr * 64 + fr) * D + u.pn * 256 + wc * 32 + 8 * fq;
        u32x4 gb[2][2];
#pragma unroll
        for (int bj = 0; bj < 2; ++bj) gb[0][bj] = *(const u32x4*)(gp + bj * 128);
#pragma unroll
        for (int gi = 0; gi < 8; ++gi) { const int ai = gi >> 2, m = gi & 3;
            if (gi < 7) { const bf16_t* gn = gp + (size_t)(((gi + 1) >> 2) * 128 + ((gi + 1) & 3) * 16) * 2048;
#pragma unroll
                for (int bj = 0; bj < 2; ++bj) gb[(gi + 1) & 1][bj] = *(const u32x4*)(gn + bj * 128); }
#pragma unroll
            for (int bj = 0; bj < 2; ++bj) { const u32x4 g2 = gb[gi & 1][bj];
                f32x4 o0 = acc[ai][bj][m][0], o1 = acc[ai][bj][m][1];
                o0[0] *= fmaxf(bflo(g2[0]), 1e-20f); o0[1] *= fmaxf(bfhi(g2[0]), 1e-20f); o0[2] *= fmaxf(bflo(g2[1]), 1e-20f); o0[3] *= fmaxf(bfhi(g2[1]), 1e-20f);
                o1[0] *= fmaxf(bflo(g2[2]), 1e-20f); o1[1] *= fmaxf(bfhi(g2[2]), 1e-20f); o1[2] *= fmaxf(bflo(g2[3]), 1e-20f); o1[3] *= fmaxf(bfhi(g2[3]), 1e-20f);
                *(u32x4*)(op + (size_t)(ai * 128 + m * 16) * D + bj * 128) = pack8(o0, o1); }
            asm volatile("" ::: "memory"); }
    }
};
struct EpiOut {
    static constexpr bool PERM = true, AFTER_DRAIN = false; static constexpr int MIDK = 0;
    float* xo; unsigned char* ws; int layer;
    __device__ __forceinline__ void mid(f32x4 (&)[2][2][4][2], const Unit&, int, int, int, int) const {}
    __device__ __forceinline__ void operator()(const f32x4 (&acc)[2][2][4][2], const Unit& u, int wr, int wc, int fr, int fq) const {
        asm volatile("" : "+v"(fr), "+v"(fq));
        unsigned char* w_ = ws; float* x = xo; asm volatile("" : "+s"(w_), "+s"(x)); const float* mod_l = (const float*)(w_ + WS_MOD) + (size_t)layer * NB * 6144;
#pragma unroll
        for (int ai = 0; ai < 2; ++ai)
#pragma unroll
            for (int m = 0; m < 4; ++m) { const int tok = u.pm * 256 + ai * 128 + wr * 64 + m * 16 + fr; const int b = tok >> 13;
#pragma unroll
                for (int bj = 0; bj < 2; ++bj) { const int c0 = u.pn * 256 + bj * 128 + wc * 32 + 8 * fq;
                    float* xp = x + (size_t)tok * D + c0; const float* gp = mod_l + b * 6144 + 2048 + c0;
                    const f32x4 g0 = *(const f32x4*)gp, g1 = *(const f32x4*)(gp + 4);
                    const f32x4 x0 = *(const f32x4*)xp, x1 = *(const f32x4*)(xp + 4);
                    *(f32x4*)xp = x0 + g0 * acc[ai][bj][m][0]; *(f32x4*)(xp + 4) = x1 + g1 * acc[ai][bj][m][1]; } }
    }
};


__device__ __forceinline__ void ph_w4t(const int tid, const int bid, CP p, _Float16* W4T) {
    for (int idx = bid * 512 + tid; idx < DEPTH * 1536 * 256; idx += (int)gridDim.x * 512) { const int kq = idx & 255, n = (idx >> 8) % 1536, l = idx / (1536 * 256);
        W4T[idx] = (_Float16)(kq < 64 ? p.hf_w4[((size_t)l * 64 + kq) * 1536 + n] : 0.f); }
}
struct EpiTaps {
    static constexpr bool PERM = true, AFTER_DRAIN = false; static constexpr int MIDK = 0;
    unsigned char* ws;
    __device__ __forceinline__ void mid(f32x4 (&)[2][2][4][2], const Unit&, int, int, int, int) const {}
    __device__ __forceinline__ void operator()(const f32x4 (&acc)[2][2][4][2], const Unit& u, int wr, int wc, int fr, int fq) const {
        asm volatile("" : "+v"(fr), "+v"(fq));
        unsigned char* w_ = ws; asm volatile("" : "+s"(w_)); _Float16* FILT = (_Float16*)(w_ + WS_FILT);
#pragma unroll
        for (int ai = 0; ai < 2; ++ai)
#pragma unroll
            for (int m = 0; m < 4; ++m) { const int row = u.pm * 256 + ai * 128 + wr * 64 + m * 16 + fr; const int dir = row >= 768 ? 1 : 0, c = row - dir * 768;
                const float kc = -(3.0701134573253945f + (15.350567286626972f - 3.0701134573253945f) * (float)c * (1.0f / 767.0f)) * (1.4426950408889634f / 8191.0f);
#pragma unroll
                for (int bj = 0; bj < 2; ++bj) { const int l0 = u.pn * 256 + bj * 128 + wc * 32 + 8 * fq;
                    pg8::f16x8 o;
#pragma unroll
                    for (int i = 0; i < 8; ++i) o[i] = (_Float16)(acc[ai][bj][m][i >> 2][i & 3] * exp2f(kc * (float)(l0 + i)));
                    *(pg8::f16x8*)(FILT + (size_t)c * 16384 + dir * 8192 + l0) = o; } }
    }
};

__device__ __forceinline__ void ph_moe_prep(const int tid, const int bid, unsigned char* ws, int layer) {
    const int* CNT = (const int*)(ws + WS_CTL + CTL_CNT) + layer * 1024; const int* SEL = (const int*)(ws + WS_SEL); const int* RANK = (const int*)(ws + WS_RANK); int* POS = (int*)(ws + WS_POS);
    int base[16]; int acc = 0;
#pragma unroll
    for (int e = 0; e < 16; ++e) { base[e] = acc; acc += (__hip_atomic_load(CNT + e * 64, __ATOMIC_RELAXED, __HIP_MEMORY_SCOPE_AGENT) + 255) & ~255; }
    for (int idx = bid * 512 + tid; idx < T * 2; idx += (int)gridDim.x * 512) { const int e = SEL[idx]; int b = 0;
#pragma unroll
        for (int k = 0; k < 16; ++k) b = (k == e) ? base[k] : b;
        POS[idx] = b + RANK[idx]; }
}
struct SchedMoe {
    const int* CNT; const char* A; const char* B; const int* LIST; size_t bstrideE, tstepA, tstepB; int gather, G, c;
    __device__ __forceinline__ bool next(int i, Unit& u) const {
        const int id = i * G + c; int q = id >> 2; const int ct = id & 3; int e = 0, tile0 = 0, ce = 0;
        for (; e < 16; ++e) { ce = __builtin_amdgcn_readfirstlane(__hip_atomic_load(CNT + e * 64, __ATOMIC_RELAXED, __HIP_MEMORY_SCOPE_AGENT));   const int n = (ce + 255) >> 8; if (q < n) break; q -= n; tile0 += n; }
        if (e == 16) return false;
        u.pm = tile0 + q; u.pn = ct; u.kind = e; u.nvalid = ce - q * 256 < 256 ? ce - q * 256 : 256;
        u.B = B + (size_t)e * bstrideE + (size_t)ct * tstepB;
        if (gather) { u.A = A; u.rows = LIST + e * 16384 + q * 256; } else { u.A = A + (size_t)u.pm * tstepA; u.rows = nullptr; }
        return true;
    }
    __device__ __forceinline__ void a_ready(const Unit&) const {}
    __device__ __forceinline__ void done(const Unit&) const {}
};
struct EpiMoeUp {
    static constexpr bool PERM = true, AFTER_DRAIN = false; static constexpr int MIDK = 0;
    unsigned char* ws;
    __device__ __forceinline__ void mid(f32x4 (&)[2][2][4][2], const Unit&, int, int, int, int) const {}
    __device__ __forceinline__ void operator()(const f32x4 (&acc)[2][2][4][2], const Unit& u, int wr, int wc, int fr, int fq) const {
        asm volatile("" : "+v"(fr), "+v"(fq));
        unsigned char* w_ = ws; asm volatile("" : "+s"(w_)); bf16_t* ACT = (bf16_t*)(w_ + WS_ACT);
#pragma unroll
        for (int ai = 0; ai < 2; ++ai)
#pragma unroll
            for (int m = 0; m < 4; ++m) { const int row = u.pm * 256 + ai * 128 + wr * 64 + m * 16 + fr;
                f32x4 o0, o1;
#pragma unroll
                for (int i = 0; i < 4; ++i) { o0[i] = siluf_(acc[ai][0][m][0][i]) * acc[ai][1][m][0][i]; o1[i] = siluf_(acc[ai][0][m][1][i]) * acc[ai][1][m][1][i]; }
                *(u32x4*)(ACT + (size_t)row * DEXP + u.pn * 128 + wc * 32 + 8 * fq) = pack8(o0, o1); }
    }
};
struct EpiMoeDown {
    static constexpr bool PERM = true, AFTER_DRAIN = false; static constexpr int MIDK = 0;
    unsigned char* ws;
    __device__ __forceinline__ void mid(f32x4 (&)[2][2][4][2], const Unit&, int, int, int, int) const {}
    __device__ __forceinline__ void operator()(const f32x4 (&acc)[2][2][4][2], const Unit& u, int wr, int wc, int fr, int fq) const {
        asm volatile("" : "+v"(fr), "+v"(fq));
        unsigned char* w_ = ws; asm volatile("" : "+s"(w_)); bf16_t* YB = (bf16_t*)(w_ + WS_YB);
#pragma unroll
        for (int ai = 0; ai < 2; ++ai)
#pragma unroll
            for (int m = 0; m < 4; ++m) { const int row = u.pm * 256 + ai * 128 + wr * 64 + m * 16 + fr;
#pragma unroll
                for (int bj = 0; bj < 2; ++bj) *(u32x4*)(YB + (size_t)row * D + u.pn * 256 + bj * 128 + wc * 32 + 8 * fq) = pack8(acc[ai][bj][m][0], acc[ai][bj][m][1]); }
    }
};


typedef float f32x16 __attribute__((ext_vector_type(16)));
__device__ __forceinline__ void ph_attn(const int tid, const int bid, unsigned char* ws) {
    const bf16_t* QS = (const bf16_t*)(ws + WS_QS); const bf16_t* KS = (const bf16_t*)(ws + WS_KS); const bf16_t* VT = (const bf16_t*)(ws + WS_VT);
    bf16_t* OG = (bf16_t*)(ws + WS_OG); float* LSE = (float*)(ws + WS_LSE);
    const int lane = tid & 63, q = lane & 31, hi = lane >> 5, wave = tid >> 6;
    const float NEG = -1e30f;
    for (int it = bid * 8 + wave; it < NB * NH * (L / 32); it += (int)gridDim.x * 8) {
        const int bh = it >> 8, tile = it & 255; const int h = bh % NH, b = bh / NH, g = h >> 2, hh = h & 3;
        const int lsh = g == 0 ? 13 : (g == 1 ? 11 : 9), Ls = 1 << lsh, dsh = 13 - lsh;
        const int row0 = tile * 32, r = row0 >> lsh, m0 = row0 & (Ls - 1);
        const size_t rb = (size_t)bh * L + (size_t)r * Ls;
        bool ok[5];
#pragma unroll
        for (int i = 0; i < 5; ++i) { const int t0 = m0 - 64 + 32 * i; ok[i] = (t0 >= 0) && (t0 < Ls); }
        pg8::bf16x8 qf[4], kfr[5][4];
#pragma unroll
        for (int s = 0; s < 4; ++s) qf[s] = *(const pg8::bf16x8*)(QS + (rb + m0 + q) * 64 + 16 * s + 8 * hi);
#pragma unroll
        for (int i = 0; i < 5; ++i) { const int t0 = m0 - 64 + 32 * i; const int tc = ok[i] ? t0 : m0;
#pragma unroll
            for (int s = 0; s < 4; ++s) kfr[i][s] = *(const pg8::bf16x8*)(KS + (rb + tc + q) * 64 + 16 * s + 8 * hi); }
        f32x16 S[5]; float mx = NEG;
#pragma unroll
        for (int i = 0; i < 5; ++i) {
            f32x16 a;
#pragma unroll
            for (int e = 0; e < 16; ++e) a[e] = 0.f;
#pragma unroll
            for (int s = 0; s < 4; ++s) a = __builtin_amdgcn_mfma_f32_32x32x16_bf16(kfr[i][s], qf[s], a, 0, 0, 0);
            S[i] = a;
        }
        const bf16_t* vrow0 = VT + (size_t)bh * L * 64 + (size_t)(r * 64 + q) * Ls + 4 * hi;
        u32x2 vfr[5][2][2][2];
#pragma unroll
        for (int i = 0; i < 5; ++i) { const int t0 = m0 - 64 + 32 * i; const int tc = ok[i] ? t0 : m0;
#pragma unroll
            for (int s2 = 0; s2 < 2; ++s2)
#pragma unroll
                for (int dvb = 0; dvb < 2; ++dvb) { const bf16_t* vp = vrow0 + (size_t)(dvb * 32) * Ls + tc + 16 * s2; vfr[i][s2][dvb][0] = *(const u32x2*)vp; vfr[i][s2][dvb][1] = *(const u32x2*)(vp + 8); } }
#pragma unroll
        for (int i = 0; i < 5; ++i) {
#pragma unroll
            for (int e = 0; e < 16; ++e) { const int kk = (e & 3) + 8 * (e >> 2) + 4 * hi;
                if (!ok[i]) S[i][e] = NEG;
                if (i == 0 && kk < q) S[i][e] = NEG;
                if (i == 4 && kk > q) S[i][e] = NEG;
                mx = fmaxf(mx, S[i][e]); }
        }
        mx = fmaxf(mx, shx(mx, 32, lane));
        float l = 0.f;
#pragma unroll
        for (int i = 0; i < 5; ++i)
#pragma unroll
            for (int e = 0; e < 16; ++e) { const float pv = exp2f(S[i][e] - mx); S[i][e] = pv; l += pv; }
        l += shx(l, 32, lane);
        f32x16 o[2];
#pragma unroll
        for (int dvb = 0; dvb < 2; ++dvb) {
#pragma unroll
            for (int e = 0; e < 16; ++e) o[dvb][e] = 0.f;
        }
#pragma unroll
        for (int i = 0; i < 5; ++i) {
#pragma unroll
            for (int s2 = 0; s2 < 2; ++s2) {
                u32x4 pf; pf.x = pg8::cvt_pk_bf16(S[i][8 * s2 + 0], S[i][8 * s2 + 1]); pf.y = pg8::cvt_pk_bf16(S[i][8 * s2 + 2], S[i][8 * s2 + 3]);
                pf.z = pg8::cvt_pk_bf16(S[i][8 * s2 + 4], S[i][8 * s2 + 5]); pf.w = pg8::cvt_pk_bf16(S[i][8 * s2 + 6], S[i][8 * s2 + 7]);
                const pg8::bf16x8 pb = __builtin_bit_cast(pg8::bf16x8, pf);
#pragma unroll
                for (int dvb = 0; dvb < 2; ++dvb) {
                    u32x4 vv; vv.x = vfr[i][s2][dvb][0].x; vv.y = vfr[i][s2][dvb][0].y; vv.z = vfr[i][s2][dvb][1].x; vv.w = vfr[i][s2][dvb][1].y;
                    o[dvb] = __builtin_amdgcn_mfma_f32_32x32x16_bf16(__builtin_bit_cast(pg8::bf16x8, vv), pb, o[dvb], 0, 0, 0);
                }
            }
        }
        const float il = 1.f / l; const int t = ((m0 + q) << dsh) + r; const size_t tt = (size_t)b * L + t;
        bf16_t* op = OG + ((size_t)g * T + tt) * 256 + hh * 64 + 4 * hi;
#pragma unroll
        for (int dvb = 0; dvb < 2; ++dvb)
#pragma unroll
            for (int g4 = 0; g4 < 4; ++g4) { u32x2 w; w.x = pg8::cvt_pk_bf16(o[dvb][4 * g4] * il, o[dvb][4 * g4 + 1] * il); w.y = pg8::cvt_pk_bf16(o[dvb][4 * g4 + 2] * il, o[dvb][4 * g4 + 3] * il);
                *(u32x2*)(op + dvb * 32 + 8 * g4) = w; }
        if (hi == 0) LSE[((size_t)g * T + tt) * 4 + hh] = mx + log2f(l);
    }
}

#define FFT_HD __device__ __forceinline__
#define FFT_LDS __attribute__((address_space(3)))
#define FFT_ORDER(a, b) asm volatile("" : "+v"(a) : "v"(b))
#define FFT_LAUNDER(x) asm volatile("" : "+v"(x))
#define FFT_SCONST(dst, val, bits) asm volatile("s_mov_b32 %0, " #bits : "=s"(dst))
typedef float cpx __attribute__((ext_vector_type(2)));
FFT_HD inline cpx cmul(cpx a, cpx b) { cpx r; r.x = a.x * b.x - a.y * b.y; r.y = a.x * b.y + a.y * b.x; return r; }
FFT_HD inline cpx cmulc(cpx a, cpx b) { cpx r; r.x = a.x * b.x + a.y * b.y; r.y = a.y * b.x - a.x * b.y; return r; }
FFT_HD inline int FPHYS(int p) { return p + (p >> 4) + 16 * (p >> 9); }
constexpr int FFT_LDS_ELEMS = 16384 + 1024 + 512;
#define FFT_C1 0.98078528040323043f
#define FFT_S1 0.19509032201612825f
#define FFT_C2 0.92387953251128674f
#define FFT_S2 0.38268343236508978f
#define FFT_C3 0.83146961230254524f
#define FFT_S3 0.55557023301960218f
#define FFT_C4 0.70710678118654752f
struct W32C { float c1, c2, c3, c4, s1, s2, s3; };
FFT_HD inline W32C w32_consts() {
    W32C k;
    FFT_SCONST(k.c1, FFT_C1, 0x3f7b14be); FFT_SCONST(k.c2, FFT_C2, 0x3f6c835e); FFT_SCONST(k.c3, FFT_C3, 0x3f54db31); FFT_SCONST(k.c4, FFT_C4, 0x3f3504f3);
    FFT_SCONST(k.s1, FFT_S1, 0x3e47c5c2); FFT_SCONST(k.s2, FFT_S2, 0x3ec3ef15); FFT_SCONST(k.s3, FFT_S3, 0x3f0e39da);
    return k;
}
FFT_HD inline cpx w32(int m, const W32C& k) {
#define FFT_CT(q) ((q) == 0 ? 1.f : (q) == 1 ? k.c1 : (q) == 2 ? k.c2 : (q) == 3 ? k.c3 : (q) == 4 ? k.c4 : (q) == 5 ? k.s3 : (q) == 6 ? k.s2 : (q) == 7 ? k.s1 : 0.f)
    cpx r; if (m <= 8) { r.x = FFT_CT(m); r.y = -FFT_CT(8 - m); } else { r.x = -FFT_CT(16 - m); r.y = -FFT_CT(m - 8); } return r;
}
template <int R, bool INV> FFT_HD inline void dft_regs(cpx (&v)[R]) {
    const W32C kc = w32_consts();
#pragma unroll
    for (int s = R / 2; s >= 1; s >>= 1) {
#pragma unroll
        for (int g = 0; g < R; g += 2 * s) {
#pragma unroll
            for (int k = 0; k < s; ++k) {
                const cpx a = v[g + k], b = v[g + k + s];
                cpx d; d.x = a.x - b.x; d.y = a.y - b.y;
                v[g + k].x = a.x + b.x; v[g + k].y = a.y + b.y;
                const int m = k * (16 / s);
                if (m == 0) v[g + k + s] = d;
                else if (m == 8) { cpx t; if (INV) { t.x = -d.y; t.y = d.x; } else { t.x = d.y; t.y = -d.x; } v[g + k + s] = t; }
                else { const cpx w = w32(m, kc); v[g + k + s] = INV ? cmulc(d, w) : cmul(d, w); }
            }
        }
    }
}
FFT_HD constexpr int brev(int i, int bits) { int r = 0; for (int b = 0; b < bits; ++b) r |= ((i >> b) & 1) << (bits - 1 - b); return r; }
FFT_HD inline cpx small_twiddle(float th) {
    const float t2 = th * th;
    cpx r;
    r.x = 1.f + t2 * (-0.5f + t2 * (4.1666666666666664e-2f + t2 * (-1.3888888888888889e-3f + t2 * 2.48015873015873e-5f)));
    r.y = -th * (1.f + t2 * (-1.6666666666666666e-1f + t2 * (8.3333333333333332e-3f + t2 * (-1.984126984126984e-4f))));
    return r;
}
template <int R, int BITS, bool BREV_IDX, bool INV> FFT_HD inline void apply_twiddles(cpx (&v)[R], cpx w1) {
    const cpx w2 = cmul(w1, w1), w3 = cmul(w2, w1), w4 = cmul(w2, w2);
    cpx cur[4]; cur[0].x = 1.f; cur[0].y = 0.f; cur[1] = w1; cur[2] = w2; cur[3] = w3;
#pragma unroll
    for (int q = 0; q < R; ++q) {
        const int idx = BREV_IDX ? brev(q, BITS) : q;
        if (q > 0) v[idx] = INV ? cmulc(v[idx], cur[q & 3]) : cmul(v[idx], cur[q & 3]);
        if (q + 4 < R) { cur[q & 3] = cmul(cur[q & 3], w4); FFT_ORDER(cur[q & 3], v[idx]); }
    }
}
template <bool ZERO_UPPER> FFT_HD inline void fft_f1(int tid, FFT_LDS cpx* lds) {
    FFT_LAUNDER(tid);
    cpx v[32];
    FFT_LDS cpx* b1 = lds + (tid + (tid >> 4));
#pragma unroll
    for (int j = 0; j < 32; ++j) { if (ZERO_UPPER && j >= 16) { v[j].x = 0.f; v[j].y = 0.f; } else v[j] = b1[560 * j]; }
    dft_regs<32, false>(v);
    apply_twiddles<32, 5, true, false>(v, small_twiddle(6.283185307179586f * (float)tid * (1.0f / 16384.0f)));
#pragma unroll
    for (int q = 0; q < 32; ++q) b1[560 * q] = v[brev(q, 5)];
}
FFT_HD inline void fft_f2(int tid, FFT_LDS cpx* lds) {
    FFT_LAUNDER(tid);
    const int q1 = tid >> 4, a = tid & 15; cpx v[32];
    FFT_LDS cpx* b2 = lds + (560 * q1 + a);
#pragma unroll
    for (int b = 0; b < 32; ++b) v[b] = b2[17 * b];
    dft_regs<32, false>(v);
    apply_twiddles<32, 5, true, false>(v, small_twiddle(6.283185307179586f * (float)a * (1.0f / 512.0f)));
#pragma unroll
    for (int q = 0; q < 32; ++q) b2[17 * q] = v[brev(q, 5)];
}
FFT_HD inline void fft_f3(int tid, FFT_LDS const cpx* lds, cpx (&out)[2][16]) {
    FFT_LAUNDER(tid);
#pragma unroll
    for (int h = 0; h < 2; ++h) { FFT_LDS const cpx* b3 = lds + (17 * tid + 16 * (tid >> 5) + 8960 * h); cpx v[16];
#pragma unroll
        for (int i = 0; i < 16; ++i) v[i] = b3[i];
        dft_regs<16, false>(v);
#pragma unroll
        for (int k = 0; k < 16; ++k) out[h][k] = v[brev(k, 4)]; }
}
FFT_HD inline void fft_i3(int tid, cpx (&in)[2][16], FFT_LDS cpx* lds) {
    FFT_LAUNDER(tid);
#pragma unroll
    for (int h = 0; h < 2; ++h) { FFT_LDS cpx* b3 = lds + (17 * tid + 16 * (tid >> 5) + 8960 * h); cpx v[16];
#pragma unroll
        for (int k = 0; k < 16; ++k) v[k] = in[h][k];
        dft_regs<16, true>(v);
#pragma unroll
        for (int i = 0; i < 16; ++i) b3[i] = v[brev(i, 4)]; }
}
FFT_HD inline void fft_i2(int tid, FFT_LDS cpx* lds) {
    FFT_LAUNDER(tid);
    const int q1 = tid >> 4, a = tid & 15; cpx v[32];
    FFT_LDS cpx* b2 = lds + (560 * q1 + a);
#pragma unroll
    for (int q = 0; q < 32; ++q) v[q] = b2[17 * q];
    apply_twiddles<32, 5, false, true>(v, small_twiddle(6.283185307179586f * (float)a * (1.0f / 512.0f)));
    dft_regs<32, true>(v);
#pragma unroll
    for (int b = 0; b < 32; ++b) b2[17 * b] = v[brev(b, 5)];
}
FFT_HD inline void fft_i1(int tid, FFT_LDS const cpx* lds, cpx (&v)[32]) {
    FFT_LAUNDER(tid);
    FFT_LDS const cpx* b1 = lds + (tid + (tid >> 4));
#pragma unroll
    for (int q = 0; q < 32; ++q) v[q] = b1[560 * q];
    apply_twiddles<32, 5, false, true>(v, small_twiddle(6.283185307179586f * (float)tid * (1.0f / 16384.0f)));
    dft_regs<32, true>(v);
}
FFT_HD inline void fft_i1_store(int tid, FFT_LDS cpx* lds) {
    cpx v[32]; fft_i1(tid, lds, v);
    FFT_LAUNDER(tid);
    FFT_LDS cpx* b1 = lds + (tid + (tid >> 4));
#pragma unroll
    for (int j = 0; j < 16; ++j) b1[560 * j] = v[brev(j, 5)];
}

typedef _Float16 h2_t __attribute__((ext_vector_type(2)));
#define OPAQUE_PTR(T, name, expr) T name; { unsigned lo_ = __builtin_amdgcn_readfirstlane((unsigned)(uintptr_t)(expr)), hi_ = __builtin_amdgcn_readfirstlane((unsigned)((uintptr_t)(expr) >> 32)); asm volatile("" : "+s"(lo_), "+s"(hi_)); name = (T)(((uintptr_t)hi_ << 32) | lo_); }
typedef const bf16_t __attribute__((address_space(1)))* gbf_cp;
__device__ __forceinline__ float conv3(gbf_cp u, int t, float w0, float w1, float w2, float bb) {
    const float um = bf2f(u[t > 0 ? -1 : 0]), u0 = bf2f(u[0]), up = bf2f(u[t < L - 1 ? 1 : 0]);
    return (t > 0 ? um : 0.f) * w0 + u0 * w1 + (t < L - 1 ? up : 0.f) * w2 + bb;
}
__device__ __forceinline__ float conv3l(const LAS bf16_t* u, int t, float w0, float w1, float w2, float bb) {
    const float um = bf2f(u[t > 0 ? -1 : 0]), u0 = bf2f(u[0]), up = bf2f(u[t < L - 1 ? 1 : 0]);
    return (t > 0 ? um : 0.f) * w0 + u0 * w1 + (t < L - 1 ? up : 0.f) * w2 + bb;
}
constexpr int FFT_RAW_OFF = 8960 * 8;
__device__ __forceinline__ void ph_fftconv(const int tid, const int bid, CP p, int layer, unsigned char* ws, LAS unsigned char* ldsraw) {
    LAS cpx* lds = (LAS cpx*)ldsraw;
    const float* w_sc_ = p.w_sc + (size_t)layer * 3 * C3; const float* b_sc_ = p.b_sc + (size_t)layer * C3; const float* hy_bias_ = p.hy_bias + layer * HYW;
    for (int c = bid; c < HYW; c += (int)gridDim.x) {
        OPAQUE_PTR(unsigned char*, wsl, ws)
        const _Float16* FILT = (const _Float16*)(wsl + WS_FILT); const bf16_t* UT = (const bf16_t*)(wsl + WS_UT); bf16_t* YT = (bf16_t*)(wsl + WS_YT);
        h2_t KF[2][16];
        { int tl = tid; asm volatile("" : "+v"(tl)); LAS cpx* b1 = lds + (tl + (tl >> 4));
          OPAQUE_PTR(const _Float16 __attribute__((address_space(1)))*, kf, FILT + (size_t)c * 16384) OPAQUE_PTR(const float*, hy_bias, hy_bias_)
          _Float16 tp[32];
#pragma unroll
          for (int j = 0; j < 32; ++j) { const int n = tl + 512 * j; tp[j] = kf[j < 16 ? n : (n == 8192 ? 8192 : 24576 - n)]; }
#pragma unroll
          for (int j = 0; j < 32; ++j) { const int n = tl + 512 * j; cpx t; t.y = 0.f; t.x = (float)tp[j]; if (n == 8192) t.x = 0.f; if (n == 0) t.x += hy_bias[c]; b1[560 * j] = t; } }
        asm volatile("" ::: "memory");
        fft_f1<false>(tid, lds); __syncthreads(); fft_f2(tid, lds); __syncthreads();
        { cpx W[2][16]; fft_f3(tid, lds, W);
#pragma unroll
          for (int h = 0; h < 2; ++h)
#pragma unroll
              for (int kq = 0; kq < 16; ++kq) { h2_t t; t.x = (_Float16)W[h][kq].x; t.y = (_Float16)W[h][kq].y; KF[h][kq] = t; } }
        { const int c1 = HYW + c, c2 = 2 * HYW + c; int tl = tid; asm volatile("" : "+v"(tl));
          OPAQUE_PTR(const u32x4 __attribute__((address_space(1)))*, r1, UT + (size_t)c1 * T) OPAQUE_PTR(const u32x4 __attribute__((address_space(1)))*, r2, UT + (size_t)c2 * T)
          u32x4 raw[8];
#pragma unroll
          for (int m = 0; m < 4; ++m) { raw[m] = r1[tl + 512 * m]; raw[4 + m] = r2[tl + 512 * m]; }
          __syncthreads();
          LAS u32x4* rw = (LAS u32x4*)(ldsraw + FFT_RAW_OFF) + tl;
#pragma unroll
          for (int m = 0; m < 8; ++m) rw[512 * m] = raw[m];
          __syncthreads();
          OPAQUE_PTR(const float*, w_sc, w_sc_) OPAQUE_PTR(const float*, b_sc, b_sc_)
          const float a0 = w_sc[c1], a1 = w_sc[C3 + c1], a2 = w_sc[2 * C3 + c1], ab = b_sc[c1], v0 = w_sc[c2], v1 = w_sc[C3 + c2], v2 = w_sc[2 * C3 + c2], vb = b_sc[c2];
          const LAS bf16_t* u1 = (const LAS bf16_t*)(ldsraw + FFT_RAW_OFF); const LAS bf16_t* u2 = u1 + 2 * L; LAS cpx* b1 = lds + (tl + (tl >> 4));
#pragma unroll 4
          for (int j = 0; j < 16; ++j) { const int t = tl + 512 * j; cpx z;
              z.x = conv3l(u1 + t, t, a0, a1, a2, ab) * conv3l(u2 + t, t, v0, v1, v2, vb);
              z.y = conv3l(u1 + L + t, t, a0, a1, a2, ab) * conv3l(u2 + L + t, t, v0, v1, v2, vb);
              b1[560 * j] = z; } }
        __syncthreads();
        fft_f1<true>(tid, lds); __syncthreads(); fft_f2(tid, lds); __syncthreads();
        { cpx W[2][16]; fft_f3(tid, lds, W);
#pragma unroll
          for (int h = 0; h < 2; ++h)
#pragma unroll
              for (int k = 0; k < 16; ++k) { cpx kf; kf.x = (float)KF[h][k].x; kf.y = (float)KF[h][k].y; W[h][k] = cmul(W[h][k], kf); }
          fft_i3(tid, W, lds); }
        __syncthreads(); fft_i2(tid, lds); __syncthreads();
        { int tl = tid; asm volatile("" : "+v"(tl));
          OPAQUE_PTR(const u32x4 __attribute__((address_space(1)))*, r0, UT + (size_t)c * T)
          u32x4 raw[4];
#pragma unroll
          for (int m = 0; m < 4; ++m) raw[m] = r0[tl + 512 * m];
          fft_i1_store(tid, lds);
          __syncthreads();
          LAS u32x4* rw = (LAS u32x4*)(ldsraw + FFT_RAW_OFF) + tl;
#pragma unroll
          for (int m = 0; m < 4; ++m) rw[512 * m] = raw[m];
          __syncthreads();
          OPAQUE_PTR(const float*, w_sc, w_sc_) OPAQUE_PTR(const float*, b_sc, b_sc_) const float x0w = w_sc[c], x1w = w_sc[C3 + c], x2w = w_sc[2 * C3 + c], xb = b_sc[c];
          OPAQUE_PTR(bf16_t __attribute__((address_space(1)))*, yo, YT + (size_t)c * T)
          const LAS bf16_t* u0 = (const LAS bf16_t*)(ldsraw + FFT_RAW_OFF); LAS const cpx* b1 = lds + (tl + (tl >> 4));
#pragma unroll 4
          for (int j = 0; j < 16; ++j) { const int t = tl + 512 * j; const cpx u = b1[560 * j];
              yo[t] = f2bf(u.x * (1.0f / 16384.0f) * conv3l(u0 + t, t, x0w, x1w, x2w, xb));
              yo[L + t] = f2bf(u.y * (1.0f / 16384.0f) * conv3l(u0 + L + t, t, x0w, x1w, x2w, xb)); } }
        __syncthreads();
    }
}

#define XB_TMO      128
#define XB_XCNT(j)  (256  + 64 * (j))
#define XB_XSUB(j)  (1280 + 64 * (j))
#define XB_XGEN(j)  (2304 + 64 * (j))
#define XB_TOP      3328
#define XB_TOPGEN   3392
#define XCD_BAR_WORDS 3456
#define XB_SPIN_CAP (1u << 18)

__device__ __forceinline__ unsigned xb_ld(unsigned* p)              { return __hip_atomic_load(p, __ATOMIC_RELAXED, __HIP_MEMORY_SCOPE_AGENT); }
__device__ __forceinline__ unsigned xb_add(unsigned* p, unsigned v) { return __hip_atomic_fetch_add(p, v, __ATOMIC_RELAXED, __HIP_MEMORY_SCOPE_AGENT); }
__device__ __forceinline__ unsigned xb_xcc_id() { return (unsigned)__builtin_amdgcn_s_getreg((3 << 11) | 20) & 0xFu; }
#define XB_SPIN(cond, bar) do { unsigned _sp = 0; while (cond) { __builtin_amdgcn_s_sleep(1); \
    if ((++_sp & 255u) == 0u) { if (xb_ld(&(bar)[XB_TMO])) break; if (_sp > XB_SPIN_CAP) { atomicAdd(&(bar)[XB_TMO], 1u); break; } } } } while (0)

struct XcdBarrier {
    unsigned* bar; unsigned x;
    volatile LAS unsigned* st;
};

__device__ __forceinline__ XcdBarrier xcd_barrier_post(unsigned* bar, volatile LAS unsigned* st) {
    XcdBarrier b; b.bar = bar; b.x = xb_xcc_id(); b.st = st;
    if (threadIdx.x == 0) (void)xb_add(&bar[XB_XCNT(b.x)], 1u);
    return b;
}
__device__ __forceinline__ void xcd_barrier_complete(unsigned* bar, unsigned x, unsigned& nloc, unsigned& nx) {
    const unsigned G = gridDim.x * gridDim.y * gridDim.z;
    unsigned sum, cnt, mine, sp = 0u;
    for (;;) {
        sum = 0u; cnt = 0u; mine = 0u;
#pragma unroll
        for (unsigned j = 0; j < 16; ++j) { const unsigned c = xb_ld(&bar[XB_XCNT(j)]); sum += c; cnt += (c > 0u) ? 1u : 0u; mine = (j == x) ? c : mine; }
        if (sum == G) break;
        __builtin_amdgcn_s_sleep(1);
        if ((++sp & 255u) == 0u) { if (xb_ld(&bar[XB_TMO])) break; if (sp > XB_SPIN_CAP) { atomicAdd(&bar[XB_TMO], 1u); break; } }
    }
    nloc = mine > 0u ? mine : 1u; nx = cnt > 0u ? cnt : 1u;
}

__device__ __forceinline__ void xcd_barrier(const XcdBarrier& b) {
    asm volatile("s_waitcnt vmcnt(0)" ::: "memory");
    __syncthreads();
    if (threadIdx.x == 0) {
        unsigned* bar = b.bar;
        __builtin_amdgcn_s_waitcnt(0);
        unsigned nloc = b.st[0], nx = b.st[1];
        if (nloc == 0u) { xcd_barrier_complete(bar, b.x, nloc, nx); b.st[0] = nloc; b.st[1] = nx; }
        const unsigned old = xb_add(&bar[XB_XSUB(b.x)], 1u);
        const unsigned gen = old / nloc;
        if (old + 1u == (gen + 1u) * nloc) {
            __builtin_amdgcn_fence(__ATOMIC_RELEASE, "agent");
            asm volatile("s_waitcnt vmcnt(0)" ::: "memory");
            const unsigned og = xb_add(&bar[XB_TOP], 1u);
            const unsigned tg = og / nx;
            if (og + 1u == (tg + 1u) * nx) xb_add(&bar[XB_TOPGEN], 1u);
            else XB_SPIN(xb_ld(&bar[XB_TOPGEN]) == tg, bar);
            __builtin_amdgcn_fence(__ATOMIC_ACQUIRE, "agent");
            xb_add(&bar[XB_XGEN(b.x)], 1u);
            asm volatile("s_waitcnt vmcnt(0)" ::: "memory");
        } else {
            XB_SPIN(xb_ld(&bar[XB_XGEN(b.x)]) == gen, bar);
            __builtin_amdgcn_fence(__ATOMIC_ACQUIRE, "agent");
            asm volatile("s_waitcnt vmcnt(0)" ::: "memory");
        }
    }
    __syncthreads();
}

__device__ __forceinline__ void ph_ycat(const int tid, const int bid, unsigned char* ws, LAS unsigned char* lds) {
    const bf16_t* YT = (const bf16_t*)(ws + WS_YT); const bf16_t* OG = (const bf16_t*)(ws + WS_OG); const float* LSE = (const float*)(ws + WS_LSE); bf16_t* YCAT = (bf16_t*)(ws + WS_YCAT);
    const int lane = tid & 63, wave = tid >> 6;
    LAS bf16_t* tile = (LAS bf16_t*)(lds + wave * 8704);
    for (int it = bid * 8 + wave; it < 12 * 256; it += (int)gridDim.x * 8) {
        const int ch0 = (it % 12) * 64, tt0 = (it / 12) * 64;
#pragma unroll
        for (int i = 0; i < 8; ++i) { const int row = i * 8 + (lane >> 3), ck = lane & 7;
            const u32x4 v = *(const u32x4*)(YT + (size_t)(ch0 + row) * T + tt0 + ck * 8);
            LAS u32x2* d = (LAS u32x2*)(tile + row * 68 + ck * 8); u32x2 a; a.x = v.x; a.y = v.y; u32x2 b; b.x = v.z; b.y = v.w; d[0] = a; d[1] = b; }
        asm volatile("s_waitcnt lgkmcnt(0)" ::: "memory");
#pragma unroll
        for (int i = 0; i < 8; ++i) { const int tok = i * 8 + (lane >> 3), cc = lane & 7; unsigned short e[8];
#pragma unroll
            for (int q = 0; q < 8; ++q) e[q] = tile[(cc * 8 + q) * 68 + tok];
            u32x4 o; o.x = e[0] | ((unsigned)e[1] << 16); o.y = e[2] | ((unsigned)e[3] << 16); o.z = e[4] | ((unsigned)e[5] << 16); o.w = e[6] | ((unsigned)e[7] << 16);
            *(u32x4*)(YCAT + (size_t)(tt0 + tok) * D + ch0 + cc * 8) = o; }
        asm volatile("s_waitcnt lgkmcnt(0)" ::: "memory");
    }
    for (int idx = bid * 512 + tid; idx < T * 32; idx += (int)gridDim.x * 512) {
        const int tt = idx >> 5, cc0 = (idx & 31) * 8, hh = cc0 >> 6;
        const float l0 = LSE[((size_t)0 * T + tt) * 4 + hh], l1 = LSE[((size_t)1 * T + tt) * 4 + hh], l2 = LSE[((size_t)2 * T + tt) * 4 + hh];
        const float mx = fmaxf(l0, fmaxf(l1, l2)); float e0 = exp2f(l0 - mx), e1 = exp2f(l1 - mx), e2 = exp2f(l2 - mx); const float inv = 1.f / (e0 + e1 + e2); e0 *= inv; e1 *= inv; e2 *= inv;
        const u32x4 a = *(const u32x4*)(OG + ((size_t)0 * T + tt) * 256 + cc0), b = *(const u32x4*)(OG + ((size_t)1 * T + tt) * 256 + cc0), c = *(const u32x4*)(OG + ((size_t)2 * T + tt) * 256 + cc0);
        u32x4 o;
#pragma unroll
        for (int q = 0; q < 4; ++q) o[q] = pg8::cvt_pk_bf16(e0 * bflo(a[q]) + e1 * bflo(b[q]) + e2 * bflo(c[q]), e0 * bfhi(a[q]) + e1 * bfhi(b[q]) + e2 * bfhi(c[q]));
        *(u32x4*)(YCAT + (size_t)tt * D + 768 + cc0) = o;
    }
}
__device__ __forceinline__ void ph_mod(const int tid, const int bid, CP p, float* mod, LAS unsigned char* lds) {
    const int lane = tid & 63, wave = tid >> 6; LAS float* red = (LAS float*)lds;
    for (int task = bid; task < DEPTH * 96; task += (int)gridDim.x) {
        const int l = task / 96, n0 = (task % 96) * 64;
        const float* w = p.w_ada + ((size_t)l * 1024 + wave * 128) * 6144 + n0 + lane; const float* c0 = p.c + wave * 128; const float* c1 = p.c + 1024 + wave * 128;
        float a0 = 0.f, a1 = 0.f;
#pragma unroll 16
        for (int kq = 0; kq < 128; ++kq) { const float wv = w[(size_t)kq * 6144]; a0 += siluf_(c0[kq]) * wv; a1 += siluf_(c1[kq]) * wv; }
        __syncthreads();
        red[(wave * 2 + 0) * 64 + lane] = a0; red[(wave * 2 + 1) * 64 + lane] = a1;
        __syncthreads();
        if (tid < 128) { const int b = tid >> 6, n = tid & 63; float s = p.b_ada[l * 6144 + n0 + n];
#pragma unroll
            for (int wv = 0; wv < 8; ++wv) s += red[(wv * 2 + b) * 64 + n];
            mod[((size_t)l * NB + b) * 6144 + n0 + n] = s; }
    }
    __syncthreads();
}

namespace cg = cooperative_groups;
constexpr int NPHASE = 1 + 9 * DEPTH + 1;
#ifndef REPEAT_PH
#define REPEAT_PH (-1)
#endif
#ifndef PROBE_PH
#define PROBE_PH (-1)
#endif
#ifndef PROBE_DIV
#define PROBE_DIV 10.0f
#endif
constexpr int MEGA_LDS = 147456;
constexpr int XB_ST_OFF = MEGA_LDS - 64;
__global__ void __launch_bounds__(512, 2) mega(P p_unused) {
    extern __shared__ __attribute__((aligned(16))) unsigned char lds[];
    typedef const __attribute__((address_space(4))) P* KP;
    KP kp0 = (KP)__builtin_amdgcn_kernarg_segment_ptr();
    cg::grid_group grid = cg::this_grid();
    const int ph_lo = kp0->ph_lo, ph_hi = kp0->ph_hi;
    const int wave0 = __builtin_amdgcn_readfirstlane((int)(threadIdx.x >> 6));
    { volatile LAS unsigned* st0 = (volatile LAS unsigned*)((LAS unsigned char*)lds + XB_ST_OFF); if (threadIdx.x < 16) st0[threadIdx.x] = 0u; }
    __syncthreads();
    const XcdBarrier xbar = xcd_barrier_post((unsigned*)(kp0->ws + WS_CTL) + 4096, (volatile LAS unsigned*)((LAS unsigned char*)lds + XB_ST_OFF));
#define PHASE_VARS const __attribute__((address_space(4))) P& p = *pp; unsigned char* ws = p.ws; float* out = p.out; float* MOD = (float*)(ws + WS_MOD); float* ROPE = (float*)(ws + WS_ROPE); _Float16* H3 = (_Float16*)(ws + WS_H3); _Float16* W4T = (_Float16*)(ws + WS_W4T); int* SEL = (int*)(ws + WS_SEL); float* WTS = (float*)(ws + WS_WTS); int* POS = (int*)(ws + WS_POS); _Float16* FILT = (_Float16*)(ws + WS_FILT); bf16_t* XN = (bf16_t*)(ws + WS_XN); bf16_t* UT = (bf16_t*)(ws + WS_UT); bf16_t* QS = (bf16_t*)(ws + WS_QS); bf16_t* KS = (bf16_t*)(ws + WS_KS); bf16_t* VT = (bf16_t*)(ws + WS_VT); bf16_t* GATES = (bf16_t*)(ws + WS_GATES); bf16_t* YT = (bf16_t*)(ws + WS_YT); bf16_t* OG = (bf16_t*)(ws + WS_OG); float* LSE = (float*)(ws + WS_LSE); bf16_t* YCAT = (bf16_t*)(ws + WS_YCAT); bf16_t* MERGED = (bf16_t*)(ws + WS_MERGED); float* Z = (float*)(ws + WS_Z); bf16_t* X0 = (bf16_t*)(ws + WS_X0); bf16_t* ACT = (bf16_t*)(ws + WS_ACT); bf16_t* YB = (bf16_t*)(ws + WS_YB); unsigned char* sm = lds + (tid >> 8) * 8192; LAS unsigned char* ldsp = (LAS unsigned char*)lds; bf16_t* WA = (bf16_t*)(ws + WS_WA); bf16_t* WB = (bf16_t*)(ws + WS_WB); bf16_t* WCAT = (bf16_t*)(ws + WS_WCAT); bf16_t* WOUT = (bf16_t*)(ws + WS_WOUT);
    int ph = 0;
#define PHASE(...) do { if (PROBE_PH >= 0 && ph == PROBE_PH) { if (wave0 == 0) ((volatile LAS unsigned long long*)((LAS unsigned char*)lds + XB_ST_OFF + 16))[0] = __builtin_amdgcn_s_memrealtime(); } if (ph >= ph_lo && ph < ph_hi) { int tid, bid = blockIdx.x; KP pp = kp0; asm volatile("v_mbcnt_lo_u32_b32 %0, -1, 0\n\tv_mbcnt_hi_u32_b32 %0, -1, %0" : "=v"(tid)); tid += wave0 * 64; asm volatile("" : "+v"(tid), "+s"(bid), "+s"(pp)); PHASE_VARS; __VA_ARGS__; if (ph == REPEAT_PH) { xcd_barrier(xbar); __VA_ARGS__; } if (ph + 1 < ph_hi) { if (ph_hi < 0) grid.sync(); else xcd_barrier(xbar); } } if (PROBE_PH >= 0 && ph == PROBE_PH) { if (wave0 == 0) ((volatile LAS unsigned long long*)((LAS unsigned char*)lds + XB_ST_OFF + 16))[1] = __builtin_amdgcn_s_memrealtime(); } ++ph; } while (0)
    PHASE({ ph_mod(tid, bid, p, MOD, ldsp); nv_rope(tid, bid, p, ROPE); nv_h3(tid, bid, p, H3, sm); ph_w4t(tid, bid, p, W4T); __syncthreads(); ph_convert(tid, bid, p, 0, ws, ldsp); });
    for (int l = 0; l < DEPTH; ++l) {
#define mod_l (MOD + (size_t)l * NB * 6144)
        PHASE({ if (l > 0) { ph_convert(tid, bid, p, l, ws, ldsp); __syncthreads(); }
                { SchedDense S{(const char*)(W4T + (size_t)l * 1536 * 256), (const char*)(H3 + (size_t)l * L * 256), 6, 32, (int)gridDim.x, bid, (size_t)256 * 256 * 2}; EpiTaps E{ws};
                  pg8::gemm_phase<EpiTaps, SchedDense, true, true, false, true>(tid, ldsp, 256, S, E); }
                asm volatile("v_mbcnt_lo_u32_b32 %0, -1, 0\n\tv_mbcnt_hi_u32_b32 %0, -1, %0" : "=v"(tid)); tid += wave0 * 64;
                if (l == 0) ph_norm<false, false>(tid, bid, p.x, out, p.norm1_g, mod_l, XN, YB, POS, WTS, mod_l);
                else ph_norm<true, false>(tid, bid, out, out, p.norm1_g + l * D, mod_l, XN, YB, POS, WTS, mod_l - NB * 6144); });
        PHASE({ { SchedG1a S{(const char*)XN, (const char*)WA, (int)gridDim.x, bid}; EpiG1a E{ws};
                  pg8::gemm_phase<EpiG1a, SchedG1a, true, true>(tid, ldsp, 1024, S, E); }
                asm volatile("v_mbcnt_lo_u32_b32 %0, -1, 0\n\tv_mbcnt_hi_u32_b32 %0, -1, %0" : "=v"(tid)); tid += wave0 * 64;
                { SchedG1b S{(const char*)XN, (const char*)WB, (int)gridDim.x, bid}; EpiG1b E{ws};
                  pg8::gemm_phase<EpiG1b, SchedG1b, true, true, false, false, true>(tid, ldsp, 1024, S, E); } });
        PHASE({ ph_fftconv(tid, bid, p, l, ws, ldsp); ph_attn(tid, bid, ws); });
        PHASE({ ph_ycat(tid, bid, ws, ldsp); });
        PHASE({ SchedDense S{(const char*)YCAT, (const char*)WCAT, 64, 4, (int)gridDim.x, bid, 524288}; EpiMerge E{ws};
                pg8::gemm_phase<EpiMerge, SchedDense, true, true>(tid, ldsp, 1024, S, E); });
        PHASE({ SchedDense S{(const char*)MERGED, (const char*)WOUT, 64, 4, (int)gridDim.x, bid, 524288}; EpiOut E{out, ws, l};
                pg8::gemm_phase<EpiOut, SchedDense, true, true>(tid, ldsp, 1024, S, E); });
        PHASE({ ph_route(tid, bid, p, l, ws, out, ldsp); });
        PHASE({ ph_moe_prep(tid, bid, ws, l);
                SchedMoe S{(const int*)(ws + WS_CTL + CTL_CNT) + l * 1024, (const char*)XN, (const char*)(ws + WS_W13), (const int*)(ws + WS_LIST), (size_t)1024 * 1024 * 2, 0, (size_t)256 * 1024 * 2, 1, (int)gridDim.x, bid}; EpiMoeUp E{ws};
                pg8::gemm_phase<EpiMoeUp, SchedMoe, true, true, true>(tid, ldsp, 1024, S, E); });
        PHASE({ SchedMoe S{(const int*)(ws + WS_CTL + CTL_CNT) + l * 1024, (const char*)ACT, (const char*)(ws + WS_W2), nullptr, (size_t)1024 * 512 * 2, (size_t)256 * 512 * 2, (size_t)256 * 512 * 2, 0, (int)gridDim.x, bid}; EpiMoeDown E{ws};
                pg8::gemm_phase<EpiMoeDown, SchedMoe, true, true, false>(tid, ldsp, 512, S, E); });
    }
    PHASE({ ph_norm<true, true>(tid, bid, out, out, p.final_g, MOD, nullptr, YB, POS, WTS, MOD + (size_t)(DEPTH - 1) * NB * 6144); });
    if (PROBE_PH >= 0) { xcd_barrier(xbar); if (blockIdx.x == 0 && wave0 == 0 && __builtin_amdgcn_mbcnt_lo(~0u, 0u) == 0u) { volatile LAS unsigned long long* pt = (volatile LAS unsigned long long*)((LAS unsigned char*)lds + XB_ST_OFF + 16); kp0->out[0] += (float)(pt[1] - pt[0]) * (0.01f / PROBE_DIV); } }
}
}

extern "C" void kernel_launch(void* const* d_in, const int* in_sizes, int n_in, void* d_out, int out_size, void* d_ws, size_t ws_size, hipStream_t stream) {
    if (n_in != 27 || in_sizes[0] != T * D || out_size != T * D || ws_size < WS_END) {
        fprintf(stderr, "kernel_launch: unexpected shapes / workspace (n_in %d, in0 %d, out %d, ws %zu need %zu); nothing launched\n", n_in, n_in > 0 ? in_sizes[0] : -1, out_size, ws_size, (size_t)WS_END);
        return;
    }
    static int grid_blocks = 0;
    if (!grid_blocks) {
        int dev = 0, cus = 0, per_cu = 0;
        (void)hipGetDevice(&dev); (void)hipDeviceGetAttribute(&cus, hipDeviceAttributeMultiprocessorCount, dev);
        (void)hipFuncSetAttribute((const void*)mega, hipFuncAttributeMaxDynamicSharedMemorySize, MEGA_LDS);
        if (hipOccupancyMaxActiveBlocksPerMultiprocessor(&per_cu, (const void*)mega, 512, MEGA_LDS) != hipSuccess || per_cu < 1) per_cu = 1;
        grid_blocks = cus;
        fprintf(stderr, "kernel_launch: %d CUs x %d blocks\n", cus, per_cu);
    }
    P p{};
    const float** dst = (const float**)&p;
    for (int i = 0; i < 27; ++i) dst[i] = (const float*)d_in[i];
    p.out = (float*)d_out; p.ws = (unsigned char*)d_ws;
    for (int j = 0; j < 32; ++j) p.ri.inv[j] = pow(10000.0, -(double)j / 32.0);
    p.ph_lo = 0; p.ph_hi = NPHASE;
    (void)hipMemsetAsync((unsigned char*)d_ws + WS_CTL, 0, 1 * MiB, stream);
    void* args[] = {&p};
    hipError_t e = hipLaunchCooperativeKernel((const void*)mega, dim3(grid_blocks), dim3(512), args, MEGA_LDS, stream);
    if (e != hipSuccess) fprintf(stderr, "cooperative launch failed: %s (grid %d)\n", hipGetErrorString(e), grid_blocks);
}
```

```cpp
#include <hip/hip_runtime.h>
#include <hip/hip_cooperative_groups.h>
#include <cstdio>
#include <cstdint>
#include <cmath>

typedef unsigned short bf16_t;

namespace {
constexpr int D = 1024, NB = 2, L = 8192, T = NB * L, DEPTH = 2;
constexpr int HYW = 768, C3 = 2304, NH = 12, HD = 64, ATT_OUT = 256, INC = 6656;
constexpr int HY_EMB = 33, HY_FFN = 64;
constexpr int NE = 16, DEXP = 512;
constexpr float NORM_EPS = 1e-6f;
constexpr float QSCALE = 0.125f * 1.4426950408889634f;

constexpr size_t MiB = 1u << 20;
constexpr size_t WS_CTL = 0;
constexpr size_t WS_MOD = 1 * MiB;
constexpr size_t WS_ROPE = 2 * MiB;
constexpr size_t WS_W4T = 4 * MiB;
constexpr size_t WS_H3 = 364 * MiB;
constexpr size_t WS_SEL = 8 * MiB;
constexpr size_t WS_WTS = WS_SEL + 256 * 1024;
constexpr size_t WS_POS = WS_WTS + 256 * 1024;
constexpr size_t WS_RANK = WS_POS + 256 * 1024;
constexpr size_t WS_LIST = 9 * MiB;
constexpr size_t CTL_CNT = 4096;
constexpr size_t WS_FILT = 10 * MiB;
constexpr size_t WS_WA = 34 * MiB;
constexpr size_t WS_WB = 41 * MiB;
constexpr size_t WS_WCAT = 47 * MiB;
constexpr size_t WS_WOUT = 49 * MiB;
constexpr size_t WS_W13 = 51 * MiB;
constexpr size_t WS_W2 = 83 * MiB;
constexpr size_t WS_XN = 99 * MiB;
constexpr size_t WS_UT = 131 * MiB;
constexpr size_t WS_QS = 203 * MiB;
constexpr size_t WS_KS = 227 * MiB;
constexpr size_t WS_VT = 251 * MiB;
constexpr size_t WS_GATES = 275 * MiB;
constexpr size_t WS_OG = 339 * MiB;
constexpr size_t WS_LSE = 363 * MiB;
constexpr size_t WS_END = 372 * MiB;
constexpr size_t WS_YT = WS_XN;
constexpr size_t WS_MERGED = WS_UT;
constexpr size_t WS_Z = WS_QS;
constexpr size_t WS_X0 = WS_VT;
constexpr size_t WS_YCAT = WS_QS;
constexpr size_t WS_ACT = WS_QS;
constexpr size_t WS_YB = WS_UT;

__device__ __forceinline__ float bf2f(bf16_t v) { return __uint_as_float((unsigned)v << 16); }
__device__ __forceinline__ bf16_t f2bf(float f) { unsigned u = __float_as_uint(f); return (bf16_t)((u + 0x7fffu + ((u >> 16) & 1u)) >> 16); }
__device__ __forceinline__ float sigmoidf_(float x) { return 1.f / (1.f + __expf(-x)); }
__device__ __forceinline__ float siluf_(float x) { return x / (1.f + __expf(-x)); }
__host__ __device__ __forceinline__ int dil_of_head(int h) { const int g = h >> 2; return g == 0 ? 1 : (g == 1 ? 4 : 16); }
__device__ __forceinline__ size_t qk_row(int b, int h, int t) { const int d = dil_of_head(h), Ls = L / d; return (size_t)(b * NH + h) * L + (size_t)(t % d) * Ls + (t / d); }
__device__ __forceinline__ size_t vt_off(int b, int h, int t, int dv) { const int d = dil_of_head(h), Ls = L / d; return (size_t)(b * NH + h) * L * 64 + (size_t)((t % d) * 64 + dv) * Ls + (t / d); }
__device__ __forceinline__ int permd(int d) { return d < 32 ? 2 * d : 2 * (d - 32) + 1; }

__device__ __forceinline__ float sin_rev(float r) { r = r - rintf(r); return __builtin_amdgcn_sinf(r); }
__device__ __forceinline__ float cos_rev(float r) { r = r - rintf(r); return __builtin_amdgcn_cosf(r); }
__device__ __forceinline__ float sin_rad(float x) { return sin_rev(x * 0.15915494309189535f); }
struct RopeInv { double inv[32]; };
__device__ __forceinline__ float rdlane(float v, int l) { return __int_as_float(__builtin_amdgcn_readlane(__float_as_int(v), l)); }
__device__ __forceinline__ float shx(float v, int o, int lane) { return __int_as_float(__builtin_amdgcn_ds_bpermute((lane ^ o) << 2, __float_as_int(v))); }
__device__ __forceinline__ float wave_sum(float v, int lane) {
#pragma unroll
    for (int o = 1; o < 64; o <<= 1) v += shx(v, o, lane);
    return v;
}


struct P {
    const float *x, *c, *norm1_g, *norm2_g, *w_ada, *b_ada, *w_in, *w_sc, *b_sc, *hf_w1, *hf_b1, *hf_w2, *hf_b2, *hf_w3, *hf_b3, *hf_w4, *hf_freq, *hy_bias,
                *w_br_h, *w_br_a, *w_out, *router_w, *router_bias, *moe_w1, *moe_w3, *moe_w2, *final_g;
    float* out; unsigned char* ws;
    RopeInv ri;
    int ph_lo, ph_hi;
};
typedef const __attribute__((address_space(4))) P& CP;
#define VT_ (tid & 255)
#define VLOOP(NVB) for (int vb = bid * 2 + (tid >> 8); vb < (NVB); vb += (int)gridDim.x * 2)

namespace pg8 {
#define PG8_LAS __attribute__((address_space(3)))
typedef unsigned short bf16_t;
typedef short bf16x8 __attribute__((ext_vector_type(8)));
typedef float f32x4 __attribute__((ext_vector_type(4)));
typedef unsigned u32x4 __attribute__((ext_vector_type(4)));
constexpr int BM = 256, BK = 64, HALF = 128, HTB = HALF * BK * 2  , STAGE_BYTES = 8 * HTB, NXCD = 8, WGM = 8;

__host__ __device__ __forceinline__ int lds_byte(int r, int c) { const int st = (r >> 4) * 2 + (c >> 5), rr = r & 15, cc = c & 31, ob = rr * 64 + cc * 2; return st * 1024 + (ob ^ (((ob >> 9) & 1) << 5)); }
__host__ __device__ __forceinline__ void stage_rc(int b, int& R, int& C) { const int st = b / 1024, sb = b % 1024, swz = sb ^ (((sb >> 9) & 1) << 5); R = (st >> 1) * 16 + swz / 64; C = (st & 1) * 32 + (swz % 64) / 2; }
__host__ __device__ __forceinline__ int perm32(int rho) { const int n = rho >> 4, i = rho & 15; return 8 * (i >> 2) + 4 * n + (i & 3); }

struct Unit { int pm, pn, kind, nvalid, bstride; const char* A; const char* B; const int* rows; };
__device__ __forceinline__ void tile_of(int wgid, int nM, int nN, int& pm, int& pn) {
    const int nwg = nM * nN;
    { const int q = nwg / NXCD, r = nwg % NXCD, xcd = wgid % NXCD, off = wgid / NXCD; wgid = (xcd < r ? xcd * (q + 1) : r * (q + 1) + (xcd - r) * q) + off; }
    const int nig = WGM * nN, gid = wgid / nig, fm = gid * WGM, gsz = (nM - fm) < WGM ? (nM - fm) : WGM;
    pm = __builtin_amdgcn_readfirstlane(fm + ((wgid % nig) % gsz)); pn = __builtin_amdgcn_readfirstlane((wgid % nig) / gsz);
}
typedef _Float16 f16x8 __attribute__((ext_vector_type(8)));
template <bool F16> __device__ __forceinline__ f32x4 mma16(bf16x8 a, bf16x8 b, f32x4 c) {
    if constexpr (F16) return __builtin_amdgcn_mfma_f32_16x16x32_f16(__builtin_bit_cast(f16x8, a), __builtin_bit_cast(f16x8, b), c, 0, 0, 0);
    else return __builtin_amdgcn_mfma_f32_16x16x32_bf16(a, b, c, 0, 0, 0);
}
__device__ __forceinline__ unsigned cvt_pk_bf16(float lo, float hi) { unsigned r; asm volatile("v_cvt_pk_bf16_f32 %0, %1, %2" : "=v"(r) : "v"(lo), "v"(hi)); return r; }
template <class Epi, class Sched, bool ALIGN_EPI = false, bool SP2 = false, bool GATHER = false, bool F16 = false, bool BSTRIDE = false>
__device__ __forceinline__ void gemm_phase(const int tid, PG8_LAS unsigned char* lds, const int K, const Sched& S, const Epi& E) {
    const int wid = __builtin_amdgcn_readfirstlane(tid >> 6), lane = tid & 63, wr = wid >> 2, wc = wid & 3, fr = lane & 15, fq = lane >> 4;
    const int nt = K / BK;
    unsigned voffA[2], voffB[2];
#pragma unroll
    for (int i = 0; i < 2; ++i) { int R, C; stage_rc(tid * 16 + i * 8192, R, C); const int Rb = Epi::PERM ? ((R & ~31) + perm32(R & 31)) : R;
        voffA[i] = (unsigned)(R * K + C) * 2u; voffB[i] = (unsigned)(Rb * K + C) * 2u; }
    const size_t kstep = (size_t)(BK * 2);
    const size_t hstep = (size_t)HALF * K * 2;
    const unsigned ldsw = (unsigned)wid * 1024u;
    const int aoff = lds_byte(wr * 64 + fr, fq * 8), boff = lds_byte(wc * 32 + fr, fq * 8);
#define PG8_SA(b, h) (((b) * 2 + (h)) * HTB)
#define PG8_SB(b, h) ((4 + (b) * 2 + (h)) * HTB)
#define PG8_STAGE(bufoff, gbase, voff) do { _Pragma("unroll") for (int _i = 0; _i < 2; ++_i) \
        __builtin_amdgcn_global_load_lds((const unsigned*)((const char*)(gbase) + (voff)[_i]), (PG8_LAS unsigned*)(lds + (bufoff) + ldsw + _i * 8192), 16, 0, 0); } while (0)
#define PG8_STAGEA(bufoff, gbase, h, VG) do { if constexpr (GATHER) { PG8_STAGE(bufoff, gbase, VG[h]); } else { PG8_STAGE(bufoff, (gbase) + (h) * hstep, voffA); } } while (0)
#define PG8_STAGEB(bufoff, gbase, h, VB) do { if constexpr (BSTRIDE) { PG8_STAGE(bufoff, gbase, VB[h]); } else { PG8_STAGE(bufoff, (gbase) + (h) * hstep, voffB); } } while (0)
#define PG8_LDA(dst, b, h) do { _Pragma("unroll") for (int m = 0; m < 4; ++m) _Pragma("unroll") for (int k = 0; k < 2; ++k) dst[m][k] = *(const PG8_LAS bf16x8*)(lds + PG8_SA(b, h) + aoff + m * 2048 + k * 1024); } while (0)
#define PG8_LDB(dst, b, h) do { _Pragma("unroll") for (int n = 0; n < 2; ++n) _Pragma("unroll") for (int k = 0; k < 2; ++k) dst[n][k] = *(const PG8_LAS bf16x8*)(lds + PG8_SB(b, h) + boff + n * 2048 + k * 1024); } while (0)
#define PG8_MMA(ai, bj, At, Bt) do { __builtin_amdgcn_s_setprio(1); _Pragma("unroll") for (int m = 0; m < 4; ++m) _Pragma("unroll") for (int n = 0; n < 2; ++n) _Pragma("unroll") for (int k = 0; k < 2; ++k) \
        acc[ai][bj][m][n] = mma16<F16>(Bt[n][k], At[m][k], acc[ai][bj][m][n]); __builtin_amdgcn_s_setprio(0); } while (0)
#define PG8_WAIT_V(n) asm volatile("s_waitcnt vmcnt(" #n ")" ::: "memory")
#define PG8_WAIT_L(n) asm volatile("s_waitcnt lgkmcnt(" #n ")" ::: "memory")
#define PG8_BAR __builtin_amdgcn_s_barrier()
#define PG8_SCHED __builtin_amdgcn_sched_barrier(0)
    Unit cur, nxt; int ui = 0;
    if (!S.next(0, cur)) return;
    unsigned vgc[2][2] = {{0u, 0u}, {0u, 0u}}, vgn[2][2] = {{0u, 0u}, {0u, 0u}}, vga[2][2] = {{0u, 0u}, {0u, 0u}}; int Rg[2], Cg[2];
#pragma unroll
    for (int i = 0; i < 2; ++i) stage_rc(tid * 16 + i * 8192, Rg[i], Cg[i]);
#define PG8_LOADVG(dst, U) do { _Pragma("unroll") for (int h_ = 0; h_ < 2; ++h_) _Pragma("unroll") for (int i_ = 0; i_ < 2; ++i_) { const int r_ = h_ * HALF + Rg[i_]; const int tk_ = r_ < (U).nvalid ? (U).rows[r_] : 0; dst[h_][i_] = (unsigned)tk_ * (unsigned)(K * 2) + (unsigned)(Cg[i_] * 2); } } while (0)
    if constexpr (GATHER) PG8_LOADVG(vgc, cur);
    unsigned vbc[2][2] = {{0u, 0u}, {0u, 0u}}, vbn[2][2] = {{0u, 0u}, {0u, 0u}}, vbb[2][2] = {{0u, 0u}, {0u, 0u}}; int RBg[2];
#pragma unroll
    for (int i = 0; i < 2; ++i) RBg[i] = Epi::PERM ? ((Rg[i] & ~31) + perm32(Rg[i] & 31)) : Rg[i];
#define PG8_LOADVB(dst, U) do { _Pragma("unroll") for (int h_ = 0; h_ < 2; ++h_) _Pragma("unroll") for (int i_ = 0; i_ < 2; ++i_) dst[h_][i_] = (unsigned)(((h_ * HALF + RBg[i_]) * (U).bstride) * K + Cg[i_]) * 2u; } while (0)
    if constexpr (BSTRIDE) PG8_LOADVB(vbc, cur);
    f32x4 acc[2][2][4][2];
#pragma unroll
    for (int a = 0; a < 2; ++a)
#pragma unroll
        for (int b = 0; b < 2; ++b)
#pragma unroll
            for (int m = 0; m < 4; ++m)
#pragma unroll
                for (int n = 0; n < 2; ++n) acc[a][b][m][n] = (f32x4){0.f, 0.f, 0.f, 0.f};
    bf16x8 At[4][2], B0[2][2], B1[2][2];
    const char* cA = cur.A; const char* cB = cur.B;
    S.a_ready(cur);
    if constexpr (SP2) {
        PG8_STAGEB(PG8_SB(0, 0), cB, 0, vbc); PG8_STAGEB(PG8_SB(0, 1), cB, 1, vbc); PG8_STAGEA(PG8_SA(0, 0), cA, 0, vgc); PG8_STAGEA(PG8_SA(0, 1), cA, 1, vgc);
        if (wr == 1) PG8_BAR;
        PG8_WAIT_V(2); PG8_BAR;
        PG8_STAGEB(PG8_SB(1, 0), cB + kstep, 0, vbc); PG8_STAGEA(PG8_SA(1, 0), cA + kstep, 0, vgc); PG8_STAGEB(PG8_SB(1, 1), cB + kstep, 1, vbc);
        PG8_WAIT_V(6); PG8_BAR;
    } else {
        PG8_STAGEB(PG8_SB(0, 0), cB, 0, vbc); PG8_STAGEA(PG8_SA(0, 0), cA, 0, vgc); PG8_STAGEB(PG8_SB(0, 1), cB, 1, vbc); PG8_STAGEA(PG8_SA(0, 1), cA, 1, vgc);
        if (wr == 1) PG8_BAR;
        PG8_WAIT_V(4); PG8_BAR;
        PG8_STAGEB(PG8_SB(1, 0), cB + kstep, 0, vbc); PG8_STAGEA(PG8_SA(1, 0), cA + kstep, 0, vgc); PG8_STAGEB(PG8_SB(1, 1), cB + kstep, 1, vbc);
        PG8_WAIT_V(6); PG8_BAR;
    }
    for (;;) {
        const bool has_next = S.next(ui + 1, nxt);
        const char* nA = has_next ? nxt.A : cA; const char* nB = has_next ? nxt.B : cB;
        if constexpr (GATHER) { if (has_next) PG8_LOADVG(vgn, nxt); }
        if constexpr (BSTRIDE) { if (has_next) PG8_LOADVB(vbn, nxt); }
        for (int t = 0; t < nt; t += 2) {
            if constexpr (Epi::MIDK > 0) { if (t == Epi::MIDK) { int ln_; asm volatile("v_mbcnt_lo_u32_b32 %0, -1, 0\n\tv_mbcnt_hi_u32_b32 %0, -1, %0" : "=v"(ln_)); E.mid(acc, cur, wr, wc, ln_ & 15, ln_ >> 4); } }
            const bool last = (t == nt - 2);
            if constexpr (GATHER) { _Pragma("unroll") for (int h_ = 0; h_ < 2; ++h_) _Pragma("unroll") for (int i_ = 0; i_ < 2; ++i_) vga[h_][i_] = (last && has_next) ? vgn[h_][i_] : vgc[h_][i_]; }
            if constexpr (BSTRIDE) { _Pragma("unroll") for (int h_ = 0; h_ < 2; ++h_) _Pragma("unroll") for (int i_ = 0; i_ < 2; ++i_) vbb[h_][i_] = (last && has_next) ? vbn[h_][i_] : vbc[h_][i_]; }
            const char* a1 = cA + (size_t)(t + 1) * kstep;
            const char* a2 = last ? nA : cA + (size_t)(t + 2) * kstep; const char* b2 = last ? nB : cB + (size_t)(t + 2) * kstep;
            const char* a3 = a2 + kstep; const char* b3 = b2 + kstep;
            if (last && has_next) S.a_ready(nxt);
            if constexpr (SP2) {
            PG8_LDB(B0, 0, 0); PG8_LDB(B1, 0, 1); PG8_SCHED; PG8_LDA(At, 0, 0); PG8_STAGEA(PG8_SA(1, 1), a1, 1, vgc);
            PG8_WAIT_V(8); PG8_WAIT_L(0); PG8_BAR; PG8_MMA(0, 0, At, B0); PG8_MMA(0, 1, At, B1); PG8_BAR; PG8_SCHED;
            PG8_LDA(At, 0, 1); PG8_STAGEB(PG8_SB(0, 0), b2, 0, vbb); PG8_STAGEB(PG8_SB(0, 1), b2, 1, vbb); PG8_STAGEA(PG8_SA(0, 0), a2, 0, vga);
            PG8_WAIT_V(8); PG8_WAIT_L(0); PG8_BAR; PG8_MMA(1, 0, At, B0); PG8_MMA(1, 1, At, B1); PG8_BAR; PG8_SCHED;
            PG8_LDB(B0, 1, 0); PG8_LDB(B1, 1, 1); PG8_SCHED; PG8_LDA(At, 1, 0); PG8_STAGEA(PG8_SA(0, 1), a2, 1, vga);
            PG8_WAIT_V(8); PG8_WAIT_L(0); PG8_BAR; PG8_MMA(0, 0, At, B0); PG8_MMA(0, 1, At, B1); PG8_BAR; PG8_SCHED;
            PG8_LDA(At, 1, 1); PG8_STAGEB(PG8_SB(1, 0), b3, 0, vbb); PG8_STAGEB(PG8_SB(1, 1), b3, 1, vbb); PG8_STAGEA(PG8_SA(1, 0), a3, 0, vga);
            PG8_WAIT_V(8); PG8_WAIT_L(0); PG8_BAR; PG8_MMA(1, 0, At, B0); PG8_MMA(1, 1, At, B1); PG8_BAR; PG8_SCHED;
            } else {
            PG8_LDB(B0, 0, 0); PG8_SCHED; PG8_LDA(At, 0, 0); PG8_STAGEA(PG8_SA(1, 1), a1, 1, vgc);
            PG8_WAIT_L(8); PG8_BAR; PG8_WAIT_L(0); PG8_MMA(0, 0, At, B0); PG8_BAR; PG8_SCHED;
            PG8_LDB(B1, 0, 1); PG8_STAGEB(PG8_SB(0, 0), b2, 0, vbb);
            PG8_BAR; PG8_WAIT_L(0); PG8_MMA(0, 1, At, B1); PG8_BAR;
            PG8_LDA(At, 0, 1); PG8_STAGEA(PG8_SA(0, 0), a2, 0, vga);
            PG8_BAR; PG8_WAIT_L(0); PG8_MMA(1, 0, At, B0); PG8_BAR; PG8_SCHED;
            PG8_STAGEB(PG8_SB(0, 1), b2, 1, vbb);
            PG8_WAIT_V(6); PG8_BAR; PG8_MMA(1, 1, At, B1); PG8_BAR;
            PG8_LDB(B0, 1, 0); PG8_SCHED; PG8_LDA(At, 1, 0); PG8_STAGEA(PG8_SA(0, 1), a2, 1, vga);
            PG8_WAIT_L(8); PG8_BAR; PG8_WAIT_L(0); PG8_MMA(0, 0, At, B0); PG8_BAR; PG8_SCHED;
            PG8_LDB(B1, 1, 1); PG8_STAGEB(PG8_SB(1, 0), b3, 0, vbb);
            PG8_BAR; PG8_WAIT_L(0); PG8_MMA(0, 1, At, B1); PG8_BAR;
            PG8_LDA(At, 1, 1); PG8_STAGEA(PG8_SA(1, 0), a3, 0, vga);
            PG8_BAR; PG8_WAIT_L(0); PG8_MMA(1, 0, At, B0); PG8_BAR; PG8_SCHED;
            PG8_STAGEB(PG8_SB(1, 1), b3, 1, vbb);
            PG8_WAIT_V(6); PG8_BAR; PG8_MMA(1, 1, At, B1); PG8_BAR;
            }
        }
        if constexpr (ALIGN_EPI) { if (wr == 0) PG8_BAR; }
        if constexpr (!Epi::AFTER_DRAIN) { int ln_; asm volatile("v_mbcnt_lo_u32_b32 %0, -1, 0\n\tv_mbcnt_hi_u32_b32 %0, -1, %0" : "=v"(ln_)); E(acc, cur, wr, wc, ln_ & 15, ln_ >> 4); S.done(cur); }
        if (!has_next) break;
#pragma unroll
        for (int a = 0; a < 2; ++a)
#pragma unroll
            for (int b = 0; b < 2; ++b)
#pragma unroll
                for (int m = 0; m < 4; ++m)
#pragma unroll
                    for (int n = 0; n < 2; ++n) acc[a][b][m][n] = (f32x4){0.f, 0.f, 0.f, 0.f};
        cur = nxt; cA = nA; cB = nB; ++ui;
        if constexpr (GATHER) { _Pragma("unroll") for (int h_ = 0; h_ < 2; ++h_) _Pragma("unroll") for (int i_ = 0; i_ < 2; ++i_) vgc[h_][i_] = vgn[h_][i_]; }
        if constexpr (BSTRIDE) { _Pragma("unroll") for (int h_ = 0; h_ < 2; ++h_) _Pragma("unroll") for (int i_ = 0; i_ < 2; ++i_) vbc[h_][i_] = vbn[h_][i_]; }
        if constexpr (ALIGN_EPI) { if (wr == 1) PG8_BAR; }
    }
    PG8_WAIT_V(0);
    if constexpr (!ALIGN_EPI) { if (wr == 0) PG8_BAR; }
    PG8_BAR;
    if constexpr (Epi::AFTER_DRAIN) { E.fused(acc, cur, wr, wc, fr, fq, lds, wid, lane); S.done(cur); }
#undef PG8_SA
#undef PG8_STAGEA
#undef PG8_STAGEB
#undef PG8_LOADVB
#undef PG8_LOADVG
#undef PG8_SB
#undef PG8_STAGE
#undef PG8_LDA
#undef PG8_LDB
#undef PG8_MMA
#undef PG8_WAIT_V
#undef PG8_WAIT_L
#undef PG8_BAR
#undef PG8_SCHED
}
}

#define LAS __attribute__((address_space(3)))
using pg8::f32x4; using pg8::u32x4; using pg8::Unit;
__device__ __forceinline__ u32x4 pack8(const f32x4 a, const f32x4 b) { u32x4 w; w.x = pg8::cvt_pk_bf16(a[0], a[1]); w.y = pg8::cvt_pk_bf16(a[2], a[3]); w.z = pg8::cvt_pk_bf16(b[0], b[1]); w.w = pg8::cvt_pk_bf16(b[2], b[3]); return w; }
__device__ __forceinline__ float bflo(unsigned x) { return __uint_as_float(x << 16); }
__device__ __forceinline__ float bfhi(unsigned x) { return __uint_as_float(x & 0xffff0000u); }
typedef unsigned u32x2 __attribute__((ext_vector_type(2)));
__device__ __forceinline__ void nv_rope(const int tid, const int bid, CP p, float* rope) {
    VLOOP(1024) { const int idx = vb * 256 + VT_; const int j = idx % 32, pos = idx / 32;
        double rev = (double)pos * p.ri.inv[j] * 0.15915494309189535; rev -= floor(rev);
        rope[idx * 2] = cos_rev((float)rev); rope[idx * 2 + 1] = sin_rev((float)rev); }
}
__device__ __forceinline__ void nv_h3(const int tid, const int bid, CP p, _Float16* h3, unsigned char* sm) {
    float (*zs)[64] = (float (*)[64])sm; float (*hs)[64] = (float (*)[64])(sm + 1024);
    VLOOP(DEPTH * L / 4) {
        const int wv = VT_ >> 6, j = VT_ & 63;
        const int gi = vb * 4 + wv; const int layer = gi / L, l = gi % L;
        const float tpos = (float)l / (float)(L - 1);
        const float wrev = (float)l / (float)L;
        __syncthreads();
        if (j < HY_EMB) {
            float z;
            if (j == 0) z = tpos;
            else { const int i = (j - 1) % 16; const float f = 1e-4f + (15.0f - 1e-4f) * (float)i / 15.0f; z = (j <= 16) ? cos_rev(f * wrev) : -sin_rev(f * wrev); }
            zs[wv][j] = z;
        }
        __syncthreads();
        const float fr = p.hf_freq[layer * 64 + j];
        float a = p.hf_b1[layer * 64 + j];
        for (int i = 0; i < HY_EMB; ++i) a += zs[wv][i] * p.hf_w1[(layer * HY_EMB + i) * 64 + j];
        float h = sin_rad(fr * a);
        hs[wv][j] = h; __syncthreads();
        a = p.hf_b2[layer * 64 + j];
        for (int i = 0; i < 64; ++i) a += hs[wv][i] * p.hf_w2[(layer * 64 + i) * 64 + j];
        h = sin_rad(fr * a); __syncthreads();
        hs[wv][j] = h; __syncthreads();
        a = p.hf_b3[layer * 64 + j];
        for (int i = 0; i < 64; ++i) a += hs[wv][i] * p.hf_w3[(layer * 64 + i) * 64 + j];
        h = sin_rad(fr * a);
        h3[(size_t)gi * 256 + j] = (_Float16)h; h3[(size_t)gi * 256 + 64 + j] = (_Float16)0.f; h3[(size_t)gi * 256 + 128 + j] = (_Float16)0.f; h3[(size_t)gi * 256 + 192 + j] = (_Float16)0.f;
    }
}
template <bool COMBINE, bool FINAL>
__device__ __forceinline__ void ph_norm(const int tid, const int bid, const float* x_in, float* x_out, const float* g, const float* mod_l, bf16_t* XN, const bf16_t* YB, const int* POS, const float* WTS, const float* mod_prev) {
    const int lane = tid & 63, wave = tid >> 6;
    for (int row0 = (bid * 8 + wave) * 2; row0 < T; row0 += (int)gridDim.x * 16) {
        const int b = row0 / L;
        f32x4 xv[2][4]; u32x2 ya[2][4], yb[2][4]; float w0[2] = {0.f, 0.f}, w1[2] = {0.f, 0.f};
        if (COMBINE) {
            int p0[2], p1[2];
#pragma unroll
            for (int r = 0; r < 2; ++r) { const int row = row0 + r; p0[r] = POS[row * 2]; p1[r] = POS[row * 2 + 1]; w0[r] = WTS[row * 2]; w1[r] = WTS[row * 2 + 1]; }
#pragma unroll
            for (int r = 0; r < 2; ++r)
#pragma unroll
                for (int j = 0; j < 4; ++j) { const int col = j * 256 + lane * 4; ya[r][j] = *(const u32x2*)(YB + (size_t)p0[r] * D + col); yb[r][j] = *(const u32x2*)(YB + (size_t)p1[r] * D + col); }
        }
#pragma unroll
        for (int r = 0; r < 2; ++r)
#pragma unroll
            for (int j = 0; j < 4; ++j) xv[r][j] = *(const f32x4*)(x_in + (size_t)(row0 + r) * D + j * 256 + lane * 4);
        float ss[2] = {0.f, 0.f};
#pragma unroll
        for (int r = 0; r < 2; ++r)
#pragma unroll
            for (int j = 0; j < 4; ++j) { const int col = j * 256 + lane * 4;
                if (COMBINE) { const f32x4 g2v = *(const f32x4*)(mod_prev + b * 6144 + 5 * 1024 + col);
#pragma unroll
                    for (int i = 0; i < 4; ++i) { const float y = w0[r] * (i & 1 ? bfhi(ya[r][j][i >> 1]) : bflo(ya[r][j][i >> 1])) + w1[r] * (i & 1 ? bfhi(yb[r][j][i >> 1]) : bflo(yb[r][j][i >> 1])); xv[r][j][i] += g2v[i] * y; } }
                ss[r] += xv[r][j][0] * xv[r][j][0] + xv[r][j][1] * xv[r][j][1] + xv[r][j][2] * xv[r][j][2] + xv[r][j][3] * xv[r][j][3];
                if (!FINAL) *(f32x4*)(x_out + (size_t)(row0 + r) * D + col) = xv[r][j]; }
#pragma unroll
        for (int r = 0; r < 2; ++r) ss[r] = wave_sum(ss[r], lane);
#pragma unroll
        for (int r = 0; r < 2; ++r) { const float rstd = rsqrtf(ss[r] * (1.0f / D) + NORM_EPS);
#pragma unroll
            for (int j = 0; j < 4; ++j) { const int col = j * 256 + lane * 4; const f32x4 gv = *(const f32x4*)(g + col);
                if (FINAL) { *(f32x4*)(x_out + (size_t)(row0 + r) * D + col) = xv[r][j] * rstd * gv; }
                else { const f32x4 sc = *(const f32x4*)(mod_l + b * 6144 + 1024 + col), sh = *(const f32x4*)(mod_l + b * 6144 + col);
                    const f32x4 y = xv[r][j] * rstd * gv * (sc + 1.f) + sh;
                    u32x2 o; o.x = pg8::cvt_pk_bf16(y[0], y[1]); o.y = pg8::cvt_pk_bf16(y[2], y[3]);
                    *(u32x2*)(XN + (size_t)(row0 + r) * D + col) = o; } } }
    }
}
__device__ __forceinline__ void nv_gemm1(const int tid, const int bid, const bf16_t* XN, const float* w_in, const float* rope, bf16_t* UT, bf16_t* QS, bf16_t* KS, bf16_t* VT, bf16_t* GATES, unsigned char* smraw) {
    float (*sm)[256] = (float (*)[256])smraw;
    VLOOP(26 * (T / 8)) {
        const int tx = VT_; const int n = (vb % 26) * 256 + tx, t0 = (vb / 26) * 8;
        float acc[8];
#pragma unroll
        for (int i = 0; i < 8; ++i) acc[i] = 0.f;
        for (int k = 0; k < D; ++k) { const float w = w_in[(size_t)k * INC + n];
#pragma unroll
            for (int i = 0; i < 8; ++i) acc[i] += bf2f(XN[(size_t)(t0 + i) * D + k]) * w; }
        __syncthreads();
#pragma unroll
        for (int i = 0; i < 8; ++i) sm[i][tx] = acc[i];
        __syncthreads();
#pragma unroll
        for (int i = 0; i < 8; ++i) {
            const int tt = t0 + i, b = tt / L, t = tt % L;
            if (n < C3) UT[(size_t)n * T + tt] = f2bf(acc[i]);
            else if (n < C3 + 2 * HYW) {
                const int isk = n >= C3 + HYW; const int cc = n - C3 - isk * HYW; const int h = cc / 64, d = cc % 64;
                if (d < 32) {
                    const float a = acc[i], bb = sm[i][tx + 32];
                    const float cs = rope[(t * 32 + d) * 2], sn = rope[(t * 32 + d) * 2 + 1];
                    float o1 = a * cs - bb * sn, o2 = bb * cs + a * sn;
                    if (!isk) { o1 *= QSCALE; o2 *= QSCALE; }
                    bf16_t* dst = (isk ? KS : QS) + qk_row(b, h, t) * 64;
                    dst[permd(d)] = f2bf(o1); dst[permd(d + 32)] = f2bf(o2);
                }
            } else if (n < C3 + 3 * HYW) { const int cc = n - C3 - 2 * HYW; VT[vt_off(b, cc / 64, t, cc % 64)] = f2bf(acc[i]); }
            else GATES[(size_t)tt * 2048 + (n - (C3 + 3 * HYW))] = f2bf(sigmoidf_(acc[i]));
        }
    }
}
__device__ __forceinline__ void nv_merge(const int tid, const int bid, const bf16_t* YCAT, const float* w_br_h, const float* w_br_a, const bf16_t* GATES, bf16_t* MERGED) {
    VLOOP(4 * (T / 8)) { const int n = (vb % 4) * 256 + VT_, t0 = (vb / 4) * 8;
        float a1[8], a2[8];
#pragma unroll
        for (int i = 0; i < 8; ++i) { a1[i] = 0.f; a2[i] = 0.f; }
        for (int k = 0; k < 768; ++k) { const float w = w_br_h[(size_t)k * D + n];
#pragma unroll
            for (int i = 0; i < 8; ++i) a1[i] += bf2f(YCAT[(size_t)(t0 + i) * D + k]) * w; }
        for (int k = 0; k < 256; ++k) { const float w = w_br_a[(size_t)k * D + n];
#pragma unroll
            for (int i = 0; i < 8; ++i) a2[i] += bf2f(YCAT[(size_t)(t0 + i) * D + 768 + k]) * w; }
#pragma unroll
        for (int i = 0; i < 8; ++i) { const size_t tt = t0 + i; MERGED[tt * D + n] = f2bf(bf2f(GATES[tt * 2048 + n]) * a1[i] + bf2f(GATES[tt * 2048 + 1024 + n]) * a2[i]); } }
}
__device__ __forceinline__ void nv_out(const int tid, const int bid, const bf16_t* MERGED, const float* w_out, const float* mod_l, float* x) {
    VLOOP(4 * (T / 8)) { const int n = (vb % 4) * 256 + VT_, t0 = (vb / 4) * 8;
        float a[8];
#pragma unroll
        for (int i = 0; i < 8; ++i) a[i] = 0.f;
        for (int k = 0; k < D; ++k) { const float w = w_out[(size_t)k * D + n];
#pragma unroll
            for (int i = 0; i < 8; ++i) a[i] += bf2f(MERGED[(size_t)(t0 + i) * D + k]) * w; }
#pragma unroll
        for (int i = 0; i < 8; ++i) { const size_t tt = t0 + i; const int b = (int)(tt / L); x[tt * D + n] += mod_l[b * 6144 + 2 * 1024 + n] * a[i]; } }
}
__device__ __forceinline__ void ph_route(const int tid, const int bid, CP p, int layer, unsigned char* ws, float* x, LAS unsigned char* lds) {
    const int lane = tid & 63, wave = tid >> 6;
    LAS float* rwt = (LAS float*)lds;
    LAS int* sel_l = (LAS int*)(lds + 65536);
    LAS int* cntw = (LAS int*)(lds + 65536 + 512);
    LAS int* base_l = (LAS int*)(lds + 65536 + 1024);
    const float* g = p.norm2_g + layer * D; const float* mod_l = (const float*)(ws + WS_MOD) + (size_t)layer * NB * 6144;
    bf16_t* XN = (bf16_t*)(ws + WS_XN); int* SEL = (int*)(ws + WS_SEL); float* WTS = (float*)(ws + WS_WTS); int* CNT = (int*)(ws + WS_CTL + CTL_CNT) + layer * 1024;     int* LIST = (int*)(ws + WS_LIST); int* RANK = (int*)(ws + WS_RANK);
    for (int i = tid; i < 1024 * 4; i += 512) { const int col = i >> 2, e4 = (i & 3) * 4; const float4 w = *(const float4*)(p.router_w + (size_t)col * 16 + e4);
        rwt[(e4 + 0) * 1024 + col] = w.x; rwt[(e4 + 1) * 1024 + col] = w.y; rwt[(e4 + 2) * 1024 + col] = w.z; rwt[(e4 + 3) * 1024 + col] = w.w; }
    const float rbias = p.router_bias[lane & 15];
    __syncthreads();
    for (int blk = bid; blk < T / 64; blk += (int)gridDim.x) {
        const int b = (blk * 64) / L;
        f32x4 xn[4];
#pragma unroll
        for (int j = 0; j < 4; ++j) xn[j] = *(const f32x4*)(x + (size_t)(blk * 64 + wave) * D + j * 256 + lane * 4);
#pragma unroll 1
        for (int it = 0; it < 8; ++it) {
            const int rl = it * 8 + wave, row = blk * 64 + rl;
            f32x4 v[4]; float ss = 0.f;
#pragma unroll
            for (int j = 0; j < 4; ++j) { v[j] = xn[j]; ss += v[j][0] * v[j][0] + v[j][1] * v[j][1] + v[j][2] * v[j][2] + v[j][3] * v[j][3]; }
            if (it < 7) {
#pragma unroll
                for (int j = 0; j < 4; ++j) xn[j] = *(const f32x4*)(x + (size_t)(row + 8) * D + j * 256 + lane * 4);
            }
            ss = wave_sum(ss, lane);
            const float rstd = rsqrtf(ss * (1.0f / D) + NORM_EPS);
#pragma unroll
            for (int j = 0; j < 4; ++j) { const int col = j * 256 + lane * 4;
                const f32x4 gv = *(const f32x4*)(g + col), sc = *(const f32x4*)(mod_l + b * 6144 + 4 * 1024 + col), sh = *(const f32x4*)(mod_l + b * 6144 + 3 * 1024 + col);
                v[j] = v[j] * rstd * gv * (sc + 1.f) + sh;
                u32x2 o; o.x = pg8::cvt_pk_bf16(v[j][0], v[j][1]); o.y = pg8::cvt_pk_bf16(v[j][2], v[j][3]);
                *(u32x2*)(XN + (size_t)row * D + col) = o; }
            float lg[16];
#pragma unroll
            for (int e = 0; e < 16; ++e) { float a = 0.f;
#pragma unroll
                for (int j = 0; j < 4; ++j) { const f32x4 w = *(const LAS f32x4*)(rwt + e * 1024 + j * 256 + lane * 4); a += v[j][0] * w[0] + v[j][1] * w[1] + v[j][2] * w[2] + v[j][3] * w[3]; }
                lg[e] = a; }
#pragma unroll
            for (int e = 0; e < 16; ++e) lg[e] = wave_sum(lg[e], lane);
            float mylg = lg[0];
#pragma unroll
            for (int e = 1; e < 16; ++e) mylg = ((lane & 15) == e) ? lg[e] : mylg;
            const float sc = 1.f / (1.f + expf(-mylg)), bi = sc + rbias;
            const float q1 = shx(bi, 1, lane), q2 = shx(bi, 2, lane), q3 = shx(bi, 3, lane);
            float m1 = fmaxf(fmaxf(bi, q1), fmaxf(q2, q3));
            const float gs = fmaxf(fmaxf(fmaxf(bi + q1, bi + q2), fmaxf(bi + q3, q1 + q2)), fmaxf(q1 + q3, q2 + q3)); (void)m1;
            const float g0 = rdlane(gs, 0), g1 = rdlane(gs, 4), g2 = rdlane(gs, 8), g3 = rdlane(gs, 12);
            int sel = 0; float best = g0; if (g1 > best) { best = g1; sel = 1; } if (g2 > best) { best = g2; sel = 2; } if (g3 > best) { best = g3; sel = 3; }
            sel = __builtin_amdgcn_readfirstlane(sel);
            float gv4[4], gs4[4];
#pragma unroll
            for (int i = 0; i < 4; ++i) { gv4[i] = rdlane(bi, sel * 4 + i); gs4[i] = rdlane(sc, sel * 4 + i); }
            int i1 = 0; float t1 = gv4[0];
#pragma unroll
            for (int i = 1; i < 4; ++i) { if (gv4[i] > t1) { t1 = gv4[i]; i1 = i; } }
            int i2 = 0; float t2 = -1e30f;
#pragma unroll
            for (int i = 0; i < 4; ++i) { if (i != i1 && gv4[i] > t2) { t2 = gv4[i]; i2 = i; } }
            float s1 = 0.f, s2 = 0.f;
#pragma unroll
            for (int i = 0; i < 4; ++i) { s1 = (i == i1) ? gs4[i] : s1; s2 = (i == i2) ? gs4[i] : s2; }
            if (lane == 0) { const int e1 = sel * 4 + i1, e2 = sel * 4 + i2; const float s = s1 + s2;
                SEL[row * 2] = e1; SEL[row * 2 + 1] = e2; WTS[row * 2] = s1 / s; WTS[row * 2 + 1] = s2 / s;
                sel_l[rl * 2] = e1; sel_l[rl * 2 + 1] = e2; }
        }
        __syncthreads();
        int my_e = 0, my_r = 0;
        if (tid < 128) { my_e = sel_l[tid];
#pragma unroll
            for (int q = 0; q < 16; ++q) { const unsigned long long m = __ballot(my_e == q); if (my_e == q) my_r = __popcll(m & ((1ull << lane) - 1ull)); if (lane == 0) cntw[wave * 16 + q] = __popcll(m); } }
        __syncthreads();
        if (tid < 16) { const int cnt = cntw[tid] + cntw[16 + tid]; base_l[tid] = cnt ? atomicAdd(CNT + tid * 64, cnt) : 0; }
        __syncthreads();
        if (tid < 128) { const int r = base_l[my_e] + my_r + (wave == 1 ? cntw[my_e] : 0), row = blk * 64 + (tid >> 1); LIST[my_e * 16384 + r] = row; RANK[row * 2 + (tid & 1)] = r; }
        __syncthreads();
    }
}
__device__ __forceinline__ void nv_moe_up(const int tid, const int bid, const bf16_t* XN, const int* SEL, const float* w1, const float* w3, bf16_t* ACT) {
    VLOOP(T * 2) { const int rs = vb; const int tok = rs >> 1; const int e = SEL[rs];
        const float* W1 = w1 + (size_t)e * D * DEXP; const float* W3 = w3 + (size_t)e * D * DEXP;
        const int f = VT_;
        float a1 = 0.f, a3 = 0.f, c1 = 0.f, c3 = 0.f;
        for (int k = 0; k < D; ++k) { const float h = bf2f(XN[(size_t)tok * D + k]); a1 += h * W1[(size_t)k * DEXP + f]; a3 += h * W3[(size_t)k * DEXP + f]; c1 += h * W1[(size_t)k * DEXP + 256 + f]; c3 += h * W3[(size_t)k * DEXP + 256 + f]; }
        ACT[(size_t)rs * DEXP + f] = f2bf(siluf_(a1) * a3); ACT[(size_t)rs * DEXP + 256 + f] = f2bf(siluf_(c1) * c3); }
}
__device__ __forceinline__ void nv_moe_down(const int tid, const int bid, const bf16_t* ACT, const int* SEL, const float* w2, bf16_t* YB) {
    VLOOP(T * 2) { const int rs = vb; const int e = SEL[rs];
        const float* W2 = w2 + (size_t)e * DEXP * D;
        float a[4] = {0.f, 0.f, 0.f, 0.f};
        for (int k = 0; k < DEXP; ++k) { const float h = bf2f(ACT[(size_t)rs * DEXP + k]);
#pragma unroll
            for (int j = 0; j < 4; ++j) a[j] += h * W2[(size_t)k * D + j * 256 + VT_]; }
#pragma unroll
        for (int j = 0; j < 4; ++j) YB[(size_t)rs * D + j * 256 + VT_] = f2bf(a[j]); }
}


__device__ __forceinline__ void cvt_item(const float* W, int ldw, int ncol0, bf16_t* WT, int ldk, int koff, int rowmap, int rowbase, int nblk, int item, LAS float* scr, int lane) {
    const int kb = item / nblk, nb = item % nblk, k0 = 64 * kb, n0 = 32 * nb;
#pragma unroll
    for (int i = 0; i < 8; ++i) { const int kk = 8 * i + (lane >> 3), nn = (lane & 7) * 4; const float4 w4 = *(const float4*)(W + (size_t)(k0 + kk) * ldw + ncol0 + n0 + nn);
        LAS float* d = scr + kk * 33 + nn; d[0] = w4.x; d[1] = w4.y; d[2] = w4.z; d[3] = w4.w; }
    asm volatile("s_waitcnt lgkmcnt(0)" ::: "memory");
    const int c = lane & 7;
#pragma unroll
    for (int j = 0; j < 4; ++j) { const int n = (lane >> 3) + 8 * j; const LAS float* s = scr + (8 * c) * 33 + n; const int nrel = n0 + n;
        const int row = rowbase + (rowmap == 0 ? nrel : (rowmap == 1 ? ((nrel & ~63) + permd(nrel & 63)) : ((nrel >> 7) * 256 + (nrel & 127))));
        u32x4 o; o.x = pg8::cvt_pk_bf16(s[0 * 33], s[1 * 33]); o.y = pg8::cvt_pk_bf16(s[2 * 33], s[3 * 33]); o.z = pg8::cvt_pk_bf16(s[4 * 33], s[5 * 33]); o.w = pg8::cvt_pk_bf16(s[6 * 33], s[7 * 33]);
        *(u32x4*)(WT + (size_t)row * ldk + koff + k0 + 8 * c) = o; }
    asm volatile("s_waitcnt lgkmcnt(0)" ::: "memory");
}
__device__ __forceinline__ void ph_convert(const int tid, const int slot, const int nslots, CP p, int layer, unsigned char* ws, LAS unsigned char* lds, int lo, int hi) {
    const int lane = tid & 63, wave = tid >> 6;
    LAS float* scr = (LAS float*)(lds + wave * 8704);
    const float* w_in = p.w_in + (size_t)layer * D * INC;
    bf16_t* WA = (bf16_t*)(ws + WS_WA); bf16_t* WB = (bf16_t*)(ws + WS_WB); bf16_t* WCAT = (bf16_t*)(ws + WS_WCAT); bf16_t* WOUT = (bf16_t*)(ws + WS_WOUT);
    bf16_t* W13 = (bf16_t*)(ws + WS_W13); bf16_t* W2 = (bf16_t*)(ws + WS_W2);
    for (int it = lo + slot; it < hi; it += nslots) {
        int r = it;
        if (r < 768) { cvt_item(w_in, INC, 2304, WA, 1024, 0, 1, 0, 48, r, scr, lane); continue; } r -= 768;
        if (r < 1024) { cvt_item(w_in, INC, 4608, WA, 1024, 0, 0, 1536, 64, r, scr, lane); continue; } r -= 1024;
        if (r < 1152) { cvt_item(w_in, INC, 0, WB, 1024, 0, 0, 0, 72, r, scr, lane); continue; } r -= 1152;
        if (r < 384) { cvt_item(w_in, INC, 3840, WB, 1024, 0, 0, 2304, 24, r, scr, lane); continue; } r -= 384;
        if (r < 384) { cvt_item(p.w_br_h + (size_t)layer * HYW * D, D, 0, WCAT, 1024, 0, 0, 0, 32, r, scr, lane); continue; } r -= 384;
        if (r < 128) { cvt_item(p.w_br_a + (size_t)layer * ATT_OUT * D, D, 0, WCAT, 1024, 768, 0, 0, 32, r, scr, lane); continue; } r -= 128;
        if (r < 512) { cvt_item(p.w_out + (size_t)layer * D * D, D, 0, WOUT, 1024, 0, 0, 0, 32, r, scr, lane); continue; } r -= 512;
        if (r < 8192) { const int e = r >> 9; r &= 511;
            if (r < 256) cvt_item(p.moe_w1 + ((size_t)layer * NE + e) * D * DEXP, DEXP, 0, W13 + (size_t)e * 1024 * 1024, 1024, 0, 2, 0, 16, r, scr, lane);
            else cvt_item(p.moe_w3 + ((size_t)layer * NE + e) * D * DEXP, DEXP, 0, W13 + (size_t)e * 1024 * 1024, 1024, 0, 2, 128, 16, r - 256, scr, lane);
            continue; } r -= 8192;
        { const int e = r >> 8; r &= 255; cvt_item(p.moe_w2 + ((size_t)layer * NE + e) * DEXP * D, D, 0, W2 + (size_t)e * 1024 * 512, 512, 0, 0, 0, 32, r, scr, lane); }
    }
}

struct SchedG1a {
    const char *XN, *WA; int G, c;
    __device__ __forceinline__ bool next(int i, Unit& u) const {
        const int id = i * G + c; if (id >= 896) return false;
        pg8::tile_of(id, 64, 14, u.pm, u.pn); u.kind = 0; u.bstride = 1; u.A = XN + (size_t)u.pm * 524288; u.B = WA + (size_t)u.pn * 524288; return true;
    }
    __device__ __forceinline__ void a_ready(const Unit&) const {}
    __device__ __forceinline__ void done(const Unit&) const {}
};
struct SchedG1b {
    const char *XN, *WB; int G, c;
    __device__ __forceinline__ bool next(int i, Unit& u) const {
        const int id = i * G + c; if (id >= 768) return false;
        pg8::tile_of(id, 12, 64, u.pm, u.pn); u.kind = 1; u.A = WB + (size_t)u.pm * 524288;
        if (u.pm < 9) { u.bstride = 1; u.B = XN + (size_t)u.pn * 524288; u.nvalid = 0; }
        else { const int lsh = u.pm == 9 ? 13 : (u.pm == 10 ? 11 : 9), d = 1 << (13 - lsh), b = u.pn >> 5, v0 = (u.pn & 31) * 256, r = v0 >> lsh, m0 = v0 & ((1 << lsh) - 1);
            u.bstride = d; u.nvalid = r; u.B = XN + (size_t)(b * L + m0 * d + r) * 2048; }
        return true;
    }
    __device__ __forceinline__ void a_ready(const Unit&) const {}
    __device__ __forceinline__ void done(const Unit&) const {}
};
struct SchedDense {
    const char *A, *B; int nM, nN, G, c; size_t tstep;
    __device__ __forceinline__ bool next(int i, Unit& u) const {
        const int id = i * G + c; if (id >= nM * nN) return false;
        pg8::tile_of(id, nM, nN, u.pm, u.pn); u.kind = 0; u.A = A + (size_t)u.pm * tstep; u.B = B + (size_t)u.pn * tstep; return true;
    }
    __device__ __forceinline__ void a_ready(const Unit&) const {}
    __device__ __forceinline__ void done(const Unit&) const {}
};
struct EpiG1a {
    static constexpr bool PERM = true, AFTER_DRAIN = false; static constexpr int MIDK = 0;
    unsigned char* ws;
    __device__ __forceinline__ void mid(f32x4 (&)[2][2][4][2], const Unit&, int, int, int, int) const {}
    __device__ __forceinline__ void operator()(const f32x4 (&acc)[2][2][4][2], const Unit& u, int wr, int wc, int fr, int fq) const {
        asm volatile("" : "+v"(fr), "+v"(fq));
        unsigned wlo_ = __builtin_amdgcn_readfirstlane((unsigned)(uintptr_t)ws), whi_ = __builtin_amdgcn_readfirstlane((unsigned)((uintptr_t)ws >> 32)); asm volatile("" : "+s"(wlo_), "+s"(whi_));
        unsigned char* w_ = (unsigned char*)(((uintptr_t)whi_ << 32) | wlo_);
        bf16_t *UT = (bf16_t*)(w_ + WS_UT), *QS = (bf16_t*)(w_ + WS_QS), *KS = (bf16_t*)(w_ + WS_KS), *VT = (bf16_t*)(w_ + WS_VT), *GATES = (bf16_t*)(w_ + WS_GATES); const float* rope = (const float*)(w_ + WS_ROPE);
        const int colt = u.pn * 256;
        if (colt < 1536) {
            const int isk = colt >= 768; const int pc = (wc * 32 + 8 * fq) & 63, j0 = pc >> 1; bf16_t* dstb = isk ? KS : QS;
            const int tok0 = u.pm * 256 + wr * 64 + fr;
            f32x4 rc[2][2];
            { const int t = tok0 & 8191; rc[0][0] = *(const f32x4*)(rope + ((size_t)t * 32 + j0) * 2); rc[0][1] = *(const f32x4*)(rope + ((size_t)t * 32 + j0 + 2) * 2); }
#pragma unroll
            for (int gi = 0; gi < 8; ++gi) { const int ai = gi >> 2, m = gi & 3; const int tok = tok0 + ai * 128 + m * 16; const int b = tok >> 13, t = tok & 8191;
                if (gi < 7) { const int tn = (tok0 + ((gi + 1) >> 2) * 128 + ((gi + 1) & 3) * 16) & 8191; rc[(gi + 1) & 1][0] = *(const f32x4*)(rope + ((size_t)tn * 32 + j0) * 2); rc[(gi + 1) & 1][1] = *(const f32x4*)(rope + ((size_t)tn * 32 + j0 + 2) * 2); }
                const f32x4 r0 = rc[gi & 1][0], r1 = rc[gi & 1][1];
#pragma unroll
                for (int bj = 0; bj < 2; ++bj) { const int cc = colt - isk * 768 + bj * 128 + wc * 32 + 8 * fq, h = cc >> 6;
                    const f32x4 v0 = acc[ai][bj][m][0], v1 = acc[ai][bj][m][1];
                    f32x4 o0, o1;
                    o0[0] = v0[0] * r0[0] - v0[1] * r0[1]; o0[1] = v0[1] * r0[0] + v0[0] * r0[1]; o0[2] = v0[2] * r0[2] - v0[3] * r0[3]; o0[3] = v0[3] * r0[2] + v0[2] * r0[3];
                    o1[0] = v1[0] * r1[0] - v1[1] * r1[1]; o1[1] = v1[1] * r1[0] + v1[0] * r1[1]; o1[2] = v1[2] * r1[2] - v1[3] * r1[3]; o1[3] = v1[3] * r1[2] + v1[2] * r1[3];
                    if (!isk) { o0 = o0 * QSCALE; o1 = o1 * QSCALE; }
                    *(u32x4*)(dstb + qk_row(b, h, t) * 64 + pc) = pack8(o0, o1); }
                asm volatile("" ::: "memory"); }
        } else {
#pragma unroll
            for (int ai = 0; ai < 2; ++ai)
#pragma unroll
                for (int m = 0; m < 4; ++m) { const int tok = u.pm * 256 + ai * 128 + wr * 64 + m * 16 + fr;
#pragma unroll
                    for (int bj = 0; bj < 2; ++bj) { const int c0 = colt + bj * 128 + wc * 32 + 8 * fq;
                        f32x4 s0, s1;
#pragma unroll
                        for (int i = 0; i < 4; ++i) { s0[i] = sigmoidf_(acc[ai][bj][m][0][i]); s1[i] = sigmoidf_(acc[ai][bj][m][1][i]); }
                        *(u32x4*)(GATES + (size_t)tok * 2048 + (c0 - 1536)) = pack8(s0, s1); } }
        }
    }
};
struct EpiG1b {
    static constexpr bool PERM = true, AFTER_DRAIN = false; static constexpr int MIDK = 0;
    unsigned char* ws;
    __device__ __forceinline__ void mid(f32x4 (&)[2][2][4][2], const Unit&, int, int, int, int) const {}
    __device__ __forceinline__ void operator()(const f32x4 (&acc)[2][2][4][2], const Unit& u, int wr, int wc, int fr, int fq) const {
        asm volatile("" : "+v"(fr), "+v"(fq));
        unsigned wlo_ = __builtin_amdgcn_readfirstlane((unsigned)(uintptr_t)ws), whi_ = __builtin_amdgcn_readfirstlane((unsigned)((uintptr_t)ws >> 32)); asm volatile("" : "+s"(wlo_), "+s"(whi_));
        unsigned char* w_ = (unsigned char*)(((uintptr_t)whi_ << 32) | wlo_);
        bf16_t *UT = (bf16_t*)(w_ + WS_UT), *QS = (bf16_t*)(w_ + WS_QS), *KS = (bf16_t*)(w_ + WS_KS), *VT = (bf16_t*)(w_ + WS_VT), *GATES = (bf16_t*)(w_ + WS_GATES); const float* rope = (const float*)(w_ + WS_ROPE);
        {
#pragma unroll
            for (int ai = 0; ai < 2; ++ai)
#pragma unroll
                for (int m = 0; m < 4; ++m) { const int row = u.pm * 256 + ai * 128 + wr * 64 + m * 16 + fr;
#pragma unroll
                    for (int bj = 0; bj < 2; ++bj) { const int vi = bj * 128 + wc * 32 + 8 * fq;
                        const u32x4 w = pack8(acc[ai][bj][m][0], acc[ai][bj][m][1]);
                        if (u.pm < 9) *(u32x4*)(UT + (size_t)row * T + u.pn * 256 + vi) = w;
                        else { const int lsh = u.pm == 9 ? 13 : (u.pm == 10 ? 11 : 9); const int cc = row - 2304, h = cc >> 6, dv = cc & 63, b = u.pn >> 5, m0 = ((u.pn & 31) * 256) & ((1 << lsh) - 1);
                            *(u32x4*)(VT + (size_t)(b * NH + h) * L * 64 + ((size_t)(u.nvalid * 64 + dv) << lsh) + m0 + vi) = w; } }
                    asm volatile("" ::: "memory"); }
        }
    }
};
struct EpiMerge {
    static constexpr bool PERM = true, AFTER_DRAIN = false; static constexpr int MIDK = 12;
    unsigned char* ws;
    __device__ __forceinline__ void mid(f32x4 (&acc)[2][2][4][2], const Unit& u, int wr, int wc, int fr, int fq) const {
        asm volatile("" : "+v"(fr), "+v"(fq));
        unsigned char* w_ = ws; asm volatile("" : "+s"(w_)); const bf16_t* GATES = (const bf16_t*)(w_ + WS_GATES);
        const bf16_t* gp = GATES + (size_t)(u.pm * 256 + wr * 64 + fr) * 2048 + u.pn * 256 + wc * 32 + 8 * fq;
        u32x4 gb[2][4];
#pragma unroll
        for (int bj = 0; bj < 2; ++bj) { gb[0][bj * 2] = *(const u32x4*)(gp + bj * 128); gb[0][bj * 2 + 1] = *(const u32x4*)(gp + 1024 + bj * 128); }
#pragma unroll
        for (int gi = 0; gi < 8; ++gi) { const int ai = gi >> 2, m = gi & 3;
            if (gi < 7) { const bf16_t* gn = gp + (size_t)(((gi + 1) >> 2) * 128 + ((gi + 1) & 3) * 16) * 2048;
#pragma unroll
                for (int bj = 0; bj < 2; ++bj) { gb[(gi + 1) & 1][bj * 2] = *(const u32x4*)(gn + bj * 128); gb[(gi + 1) & 1][bj * 2 + 1] = *(const u32x4*)(gn + 1024 + bj * 128); } }
#pragma unroll
            for (int bj = 0; bj < 2; ++bj) { const u32x4 g1 = gb[gi & 1][bj * 2], g2 = gb[gi & 1][bj * 2 + 1];
#pragma unroll
                for (int i = 0; i < 4; ++i) { const float rl = bflo(g1[i]) * __builtin_amdgcn_rcpf(fmaxf(bflo(g2[i]), 1e-20f)), rh = bfhi(g1[i]) * __builtin_amdgcn_rcpf(fmaxf(bfhi(g2[i]), 1e-20f));
                    acc[ai][bj][m][i >> 1][(i & 1) * 2] *= rl; acc[ai][bj][m][i >> 1][(i & 1) * 2 + 1] *= rh; } }
            asm volatile("" : "+v"(acc[ai][0][m][0]), "+v"(acc[ai][0][m][1]), "+v"(acc[ai][1][m][0]), "+v"(acc[ai][1][m][1]) :: "memory"); }
    }
    __device__ __forceinline__ void operator()(const f32x4 (&acc)[2][2][4][2], const Unit& u, int wr, int wc, int fr, int fq) const {
        asm volatile("" : "+v"(fr), "+v"(fq));
        unsigned char* w_ = ws; asm volatile("" : "+s"(w_)); const bf16_t* GATES = (const bf16_t*)(w_ + WS_GATES); bf16_t* MERGED = (bf16_t*)(w_ + WS_MERGED);
        const bf16_t* gp = GATES + (size_t)(u.pm * 256 + wr * 64 + fr) * 2048 + 1024 + u.pn * 256 + wc * 32 + 8 * fq;
        bf16_t* op = MERGED + (size_t)(u.pm * 256 + wr * 64 + fr) * D + u.pn * 256 + wc * 32 + 8 * fq;
        u32x4 gb[2][2];
#pragma unroll
        for (int bj = 0; bj < 2; ++bj) gb[0][bj] = *(const u32x4*)(gp + bj * 128);
#pragma unroll
        for (int gi = 0; gi < 8; ++gi) { const int ai = gi >> 2, m = gi & 3;
            if (gi < 7) { const bf16_t* gn = gp + (size_t)(((gi + 1) >> 2) * 128 + ((gi + 1) & 3) * 16) * 2048;
#pragma unroll
                for (int bj = 0; bj < 2; ++bj) gb[(gi + 1) & 1][bj] = *(const u32x4*)(gn + bj * 128); }
#pragma unroll
            for (int bj = 0; bj < 2; ++bj) { const u32x4 g2 = gb[gi & 1][bj];
                f32x4 o0 = acc[ai][bj][m][0], o1 = acc[ai][bj][m][1];
                o0[0] *= fmaxf(bflo(g2[0]), 1e-20f); o0[1] *= fmaxf(bfhi(g2[0]), 1e-20f); o0[2] *= fmaxf(bflo(g2[1]), 1e-20f); o0[3] *= fmaxf(bfhi(g2[1]), 1e-20f);
                o1[0] *= fmaxf(bflo(g2[2]), 1e-20f); o1[1] *= fmaxf(bfhi(g2[2]), 1e-20f); o1[2] *= fmaxf(bflo(g2[3]), 1e-20f); o1[3] *= fmaxf(bfhi(g2[3]), 1e-20f);
                *(u32x4*)(op + (size_t)(ai * 128 + m * 16) * D + bj * 128) = pack8(o0, o1); }
            asm volatile("" ::: "memory"); }
    }
};
struct EpiOut {
    static constexpr bool PERM = true, AFTER_DRAIN = false; static constexpr int MIDK = 0;
    float* xo; unsigned char* ws; int layer;
    __device__ __forceinline__ void mid(f32x4 (&)[2][2][4][2], const Unit&, int, int, int, int) const {}
    __device__ __forceinline__ void operator()(const f32x4 (&acc)[2][2][4][2], const Unit& u, int wr, int wc, int fr, int fq) const {
        asm volatile("" : "+v"(fr), "+v"(fq));
        unsigned char* w_ = ws; float* x = xo; asm volatile("" : "+s"(w_), "+s"(x)); const float* mod_l = (const float*)(w_ + WS_MOD) + (size_t)layer * NB * 6144;
        const int tok0 = u.pm * 256 + wr * 64 + fr, c0 = u.pn * 256 + wc * 32 + 8 * fq; const int b = tok0 >> 13;
        f32x4 gg[2][2];
#pragma unroll
        for (int bj = 0; bj < 2; ++bj) { gg[bj][0] = *(const f32x4*)(mod_l + b * 6144 + 2048 + c0 + bj * 128); gg[bj][1] = *(const f32x4*)(mod_l + b * 6144 + 2048 + c0 + bj * 128 + 4); }
        float* xp0 = x + (size_t)tok0 * D + c0;
        f32x4 xb[2][4];
#pragma unroll
        for (int bj = 0; bj < 2; ++bj) { xb[0][bj * 2] = *(const f32x4*)(xp0 + bj * 128); xb[0][bj * 2 + 1] = *(const f32x4*)(xp0 + bj * 128 + 4); }
#pragma unroll
        for (int gi = 0; gi < 8; ++gi) { const int ai = gi >> 2, m = gi & 3;
            if (gi < 7) { const float* xn = xp0 + (size_t)(((gi + 1) >> 2) * 128 + ((gi + 1) & 3) * 16) * D;
#pragma unroll
                for (int bj = 0; bj < 2; ++bj) { xb[(gi + 1) & 1][bj * 2] = *(const f32x4*)(xn + bj * 128); xb[(gi + 1) & 1][bj * 2 + 1] = *(const f32x4*)(xn + bj * 128 + 4); } }
            float* xp = xp0 + (size_t)(ai * 128 + m * 16) * D;
#pragma unroll
            for (int bj = 0; bj < 2; ++bj) { *(f32x4*)(xp + bj * 128) = xb[gi & 1][bj * 2] + gg[bj][0] * acc[ai][bj][m][0]; *(f32x4*)(xp + bj * 128 + 4) = xb[gi & 1][bj * 2 + 1] + gg[bj][1] * acc[ai][bj][m][1]; }
            asm volatile("" ::: "memory"); }
    }
};


__device__ __forceinline__ void ph_w4t(const int tid, const int bid, CP p, _Float16* W4T) {
    for (int idx = bid * 512 + tid; idx < DEPTH * 1536 * 256; idx += (int)gridDim.x * 512) { const int kq = idx & 255, n = (idx >> 8) % 1536, l = idx / (1536 * 256);
        W4T[idx] = (_Float16)(kq < 64 ? p.hf_w4[((size_t)l * 64 + kq) * 1536 + n] : 0.f); }
}
struct SchedTaps {
    const char *A, *B; int G, c;
    __device__ __forceinline__ bool next(int i, Unit& u) const {
        const int h = G >> 1; if (c < h) return false; const int id = i * (G - h) + (c - h); if (id >= 192) return false;
        u.pm = id % 6; u.pn = id / 6; u.kind = 0; u.bstride = 1; u.A = A + (size_t)u.pm * 131072; u.B = B + (size_t)u.pn * 131072; return true;
    }
    __device__ __forceinline__ void a_ready(const Unit&) const {}
    __device__ __forceinline__ void done(const Unit&) const {}
};
struct EpiTaps {
    static constexpr bool PERM = true, AFTER_DRAIN = false; static constexpr int MIDK = 0;
    unsigned char* ws;
    __device__ __forceinline__ void mid(f32x4 (&)[2][2][4][2], const Unit&, int, int, int, int) const {}
    __device__ __forceinline__ void operator()(const f32x4 (&acc)[2][2][4][2], const Unit& u, int wr, int wc, int fr, int fq) const {
        asm volatile("" : "+v"(fr), "+v"(fq));
        unsigned char* w_ = ws; asm volatile("" : "+s"(w_)); _Float16* FILT = (_Float16*)(w_ + WS_FILT);
#pragma unroll
        for (int ai = 0; ai < 2; ++ai)
#pragma unroll
            for (int m = 0; m < 4; ++m) { const int row = u.pm * 256 + ai * 128 + wr * 64 + m * 16 + fr; const int dir = row >= 768 ? 1 : 0, c = row - dir * 768;
                const float kc = -(3.0701134573253945f + (15.350567286626972f - 3.0701134573253945f) * (float)c * (1.0f / 767.0f)) * (1.4426950408889634f / 8191.0f);
#pragma unroll
                for (int bj = 0; bj < 2; ++bj) { const int l0 = u.pn * 256 + bj * 128 + wc * 32 + 8 * fq;
                    pg8::f16x8 o;
#pragma unroll
                    for (int i = 0; i < 8; ++i) o[i] = (_Float16)(acc[ai][bj][m][i >> 2][i & 3] * exp2f(kc * (float)(l0 + i)));
                    *(pg8::f16x8*)(FILT + (size_t)c * 16384 + dir * 8192 + l0) = o; } }
    }
};

__device__ __forceinline__ void ph_moe_prep(const int tid, const int bid, unsigned char* ws, int layer) {
    const int* CNT = (const int*)(ws + WS_CTL + CTL_CNT) + layer * 1024; const int* SEL = (const int*)(ws + WS_SEL); const int* RANK = (const int*)(ws + WS_RANK); int* POS = (int*)(ws + WS_POS);
    int base[16]; int acc = 0;
#pragma unroll
    for (int e = 0; e < 16; ++e) { base[e] = acc; acc += (__hip_atomic_load(CNT + e * 64, __ATOMIC_RELAXED, __HIP_MEMORY_SCOPE_AGENT) + 255) & ~255; }
    for (int idx = bid * 512 + tid; idx < T * 2; idx += (int)gridDim.x * 512) { const int e = SEL[idx]; int b = 0;
#pragma unroll
        for (int k = 0; k < 16; ++k) b = (k == e) ? base[k] : b;
        POS[idx] = b + RANK[idx]; }
}
__device__ __forceinline__ int moe_busy_blocks(unsigned char* ws, int layer, int G) {
    const int* CNT = (const int*)(ws + WS_CTL + CTL_CNT) + layer * 1024; int U = 0;
#pragma unroll
    for (int e = 0; e < 16; ++e) U += ((__hip_atomic_load(CNT + e * 64, __ATOMIC_RELAXED, __HIP_MEMORY_SCOPE_AGENT) + 255) >> 8) * 4;
    int busy = U - 2 * G; busy = busy < 0 ? 0 : (busy > G - 32 ? G - 32 : busy); return __builtin_amdgcn_readfirstlane(busy);
}
struct SchedMoe {
    const int* CNT; const char* A; const char* B; const int* LIST; size_t bstrideE, tstepA, tstepB; int gather, G, c;
    __device__ __forceinline__ bool next(int i, Unit& u) const {
        const int id = i * G + c; int q = id >> 2; const int ct = id & 3; int e = 0, tile0 = 0, ce = 0;
        for (; e < 16; ++e) { ce = __builtin_amdgcn_readfirstlane(__hip_atomic_load(CNT + e * 64, __ATOMIC_RELAXED, __HIP_MEMORY_SCOPE_AGENT));   const int n = (ce + 255) >> 8; if (q < n) break; q -= n; tile0 += n; }
        if (e == 16) return false;
        u.pm = tile0 + q; u.pn = ct; u.kind = e; u.nvalid = ce - q * 256 < 256 ? ce - q * 256 : 256;
        u.B = B + (size_t)e * bstrideE + (size_t)ct * tstepB;
        if (gather) { u.A = A; u.rows = LIST + e * 16384 + q * 256; } else { u.A = A + (size_t)u.pm * tstepA; u.rows = nullptr; }
        return true;
    }
    __device__ __forceinline__ void a_ready(const Unit&) const {}
    __device__ __forceinline__ void done(const Unit&) const {}
};
struct EpiMoeUp {
    static constexpr bool PERM = true, AFTER_DRAIN = false; static constexpr int MIDK = 0;
    unsigned char* ws;
    __device__ __forceinline__ void mid(f32x4 (&)[2][2][4][2], const Unit&, int, int, int, int) const {}
    __device__ __forceinline__ void operator()(const f32x4 (&acc)[2][2][4][2], const Unit& u, int wr, int wc, int fr, int fq) const {
        asm volatile("" : "+v"(fr), "+v"(fq));
        unsigned char* w_ = ws; asm volatile("" : "+s"(w_)); bf16_t* ACT = (bf16_t*)(w_ + WS_ACT);
#pragma unroll
        for (int ai = 0; ai < 2; ++ai)
#pragma unroll
            for (int m = 0; m < 4; ++m) { const int row = u.pm * 256 + ai * 128 + wr * 64 + m * 16 + fr;
                f32x4 o0, o1;
#pragma unroll
                for (int i = 0; i < 4; ++i) { o0[i] = siluf_(acc[ai][0][m][0][i]) * acc[ai][1][m][0][i]; o1[i] = siluf_(acc[ai][0][m][1][i]) * acc[ai][1][m][1][i]; }
                *(u32x4*)(ACT + (size_t)row * DEXP + u.pn * 128 + wc * 32 + 8 * fq) = pack8(o0, o1); }
    }
};
struct EpiMoeDown {
    static constexpr bool PERM = true, AFTER_DRAIN = false; static constexpr int MIDK = 0;
    unsigned char* ws;
    __device__ __forceinline__ void mid(f32x4 (&)[2][2][4][2], const Unit&, int, int, int, int) const {}
    __device__ __forceinline__ void operator()(const f32x4 (&acc)[2][2][4][2], const Unit& u, int wr, int wc, int fr, int fq) const {
        asm volatile("" : "+v"(fr), "+v"(fq));
        unsigned char* w_ = ws; asm volatile("" : "+s"(w_)); bf16_t* YB = (bf16_t*)(w_ + WS_YB);
#pragma unroll
        for (int ai = 0; ai < 2; ++ai)
#pragma unroll
            for (int m = 0; m < 4; ++m) { const int row = u.pm * 256 + ai * 128 + wr * 64 + m * 16 + fr;
#pragma unroll
                for (int bj = 0; bj < 2; ++bj) *(u32x4*)(YB + (size_t)row * D + u.pn * 256 + bj * 128 + wc * 32 + 8 * fq) = pack8(acc[ai][bj][m][0], acc[ai][bj][m][1]); }
    }
};


typedef float f32x16 __attribute__((ext_vector_type(16)));
__device__ __forceinline__ void ph_attn(const int tid, const int bid, unsigned char* ws) {
    const bf16_t* QS = (const bf16_t*)(ws + WS_QS); const bf16_t* KS = (const bf16_t*)(ws + WS_KS); const bf16_t* VT = (const bf16_t*)(ws + WS_VT);
    bf16_t* OG = (bf16_t*)(ws + WS_OG); float* LSE = (float*)(ws + WS_LSE);
    const int lane = tid & 63, q = lane & 31, hi = lane >> 5, wave = tid >> 6;
    const float NEG = -1e30f;
    for (int it = bid * 8 + wave; it < NB * NH * (L / 32); it += (int)gridDim.x * 8) {
        const int bh = it >> 8, tile = it & 255; const int h = bh % NH, b = bh / NH, g = h >> 2, hh = h & 3;
        const int lsh = g == 0 ? 13 : (g == 1 ? 11 : 9), Ls = 1 << lsh, dsh = 13 - lsh;
        const int row0 = tile * 32, r = row0 >> lsh, m0 = row0 & (Ls - 1);
        const size_t rb = (size_t)bh * L + (size_t)r * Ls;
        bool ok[5];
#pragma unroll
        for (int i = 0; i < 5; ++i) { const int t0 = m0 - 64 + 32 * i; ok[i] = (t0 >= 0) && (t0 < Ls); }
        pg8::bf16x8 qf[4], kfr[5][4];
#pragma unroll
        for (int s = 0; s < 4; ++s) qf[s] = *(const pg8::bf16x8*)(QS + (rb + m0 + q) * 64 + 16 * s + 8 * hi);
#pragma unroll
        for (int i = 0; i < 5; ++i) { const int t0 = m0 - 64 + 32 * i; const int tc = ok[i] ? t0 : m0;
#pragma unroll
            for (int s = 0; s < 4; ++s) kfr[i][s] = *(const pg8::bf16x8*)(KS + (rb + tc + q) * 64 + 16 * s + 8 * hi); }
        f32x16 S[5]; float mx = NEG;
#pragma unroll
        for (int i = 0; i < 5; ++i) {
            f32x16 a;
#pragma unroll
            for (int e = 0; e < 16; ++e) a[e] = 0.f;
#pragma unroll
            for (int s = 0; s < 4; ++s) a = __builtin_amdgcn_mfma_f32_32x32x16_bf16(kfr[i][s], qf[s], a, 0, 0, 0);
            S[i] = a;
        }
        const bf16_t* vrow0 = VT + (size_t)bh * L * 64 + (size_t)(r * 64 + q) * Ls + 4 * hi;
        u32x2 vfr[5][2][2][2];
#pragma unroll
        for (int i = 0; i < 5; ++i) { const int t0 = m0 - 64 + 32 * i; const int tc = ok[i] ? t0 : m0;
#pragma unroll
            for (int s2 = 0; s2 < 2; ++s2)
#pragma unroll
                for (int dvb = 0; dvb < 2; ++dvb) { const bf16_t* vp = vrow0 + (size_t)(dvb * 32) * Ls + tc + 16 * s2; vfr[i][s2][dvb][0] = *(const u32x2*)vp; vfr[i][s2][dvb][1] = *(const u32x2*)(vp + 8); } }
#pragma unroll
        for (int i = 0; i < 5; ++i) {
#pragma unroll
            for (int e = 0; e < 16; ++e) { const int kk = (e & 3) + 8 * (e >> 2) + 4 * hi;
                if (!ok[i]) S[i][e] = NEG;
                if (i == 0 && kk < q) S[i][e] = NEG;
                if (i == 4 && kk > q) S[i][e] = NEG;
                mx = fmaxf(mx, S[i][e]); }
        }
        mx = fmaxf(mx, shx(mx, 32, lane));
        float l = 0.f;
#pragma unroll
        for (int i = 0; i < 5; ++i)
#pragma unroll
            for (int e = 0; e < 16; ++e) { const float pv = exp2f(S[i][e] - mx); S[i][e] = pv; l += pv; }
        l += shx(l, 32, lane);
        f32x16 o[2];
#pragma unroll
        for (int dvb = 0; dvb < 2; ++dvb) {
#pragma unroll
            for (int e = 0; e < 16; ++e) o[dvb][e] = 0.f;
        }
#pragma unroll
        for (int i = 0; i < 5; ++i) {
#pragma unroll
            for (int s2 = 0; s2 < 2; ++s2) {
                u32x4 pf; pf.x = pg8::cvt_pk_bf16(S[i][8 * s2 + 0], S[i][8 * s2 + 1]); pf.y = pg8::cvt_pk_bf16(S[i][8 * s2 + 2], S[i][8 * s2 + 3]);
                pf.z = pg8::cvt_pk_bf16(S[i][8 * s2 + 4], S[i][8 * s2 + 5]); pf.w = pg8::cvt_pk_bf16(S[i][8 * s2 + 6], S[i][8 * s2 + 7]);
                const pg8::bf16x8 pb = __builtin_bit_cast(pg8::bf16x8, pf);
#pragma unroll
                for (int dvb = 0; dvb < 2; ++dvb) {
                    u32x4 vv; vv.x = vfr[i][s2][dvb][0].x; vv.y = vfr[i][s2][dvb][0].y; vv.z = vfr[i][s2][dvb][1].x; vv.w = vfr[i][s2][dvb][1].y;
                    o[dvb] = __builtin_amdgcn_mfma_f32_32x32x16_bf16(__builtin_bit_cast(pg8::bf16x8, vv), pb, o[dvb], 0, 0, 0);
                }
            }
        }
        const float il = 1.f / l; const int t = ((m0 + q) << dsh) + r; const size_t tt = (size_t)b * L + t;
        bf16_t* op = OG + ((size_t)g * T + tt) * 256 + hh * 64 + 4 * hi;
#pragma unroll
        for (int dvb = 0; dvb < 2; ++dvb)
#pragma unroll
            for (int g4 = 0; g4 < 4; ++g4) { u32x2 w; w.x = pg8::cvt_pk_bf16(o[dvb][4 * g4] * il, o[dvb][4 * g4 + 1] * il); w.y = pg8::cvt_pk_bf16(o[dvb][4 * g4 + 2] * il, o[dvb][4 * g4 + 3] * il);
                *(u32x2*)(op + dvb * 32 + 8 * g4) = w; }
        if (hi == 0) LSE[((size_t)g * T + tt) * 4 + hh] = mx + log2f(l);
    }
}

#define FFT_HD __device__ __forceinline__
#define FFT_LDS __attribute__((address_space(3)))
#define FFT_ORDER(a, b) asm volatile("" : "+v"(a) : "v"(b))
#define FFT_LAUNDER(x) asm volatile("" : "+v"(x))
#define FFT_SCONST(dst, val, bits) asm volatile("s_mov_b32 %0, " #bits : "=s"(dst))
typedef float cpx __attribute__((ext_vector_type(2)));
FFT_HD inline cpx cmul(cpx a, cpx b) { cpx r; r.x = a.x * b.x - a.y * b.y; r.y = a.x * b.y + a.y * b.x; return r; }
FFT_HD inline cpx cmulc(cpx a, cpx b) { cpx r; r.x = a.x * b.x + a.y * b.y; r.y = a.y * b.x - a.x * b.y; return r; }
FFT_HD inline int FPHYS(int p) { return p + (p >> 4) + 16 * (p >> 9); }
constexpr int FFT_LDS_ELEMS = 16384 + 1024 + 512;
#define FFT_C1 0.98078528040323043f
#define FFT_S1 0.19509032201612825f
#define FFT_C2 0.92387953251128674f
#define FFT_S2 0.38268343236508978f
#define FFT_C3 0.83146961230254524f
#define FFT_S3 0.55557023301960218f
#define FFT_C4 0.70710678118654752f
struct W32C { float c1, c2, c3, c4, s1, s2, s3; };
FFT_HD inline W32C w32_consts() {
    W32C k;
    FFT_SCONST(k.c1, FFT_C1, 0x3f7b14be); FFT_SCONST(k.c2, FFT_C2, 0x3f6c835e); FFT_SCONST(k.c3, FFT_C3, 0x3f54db31); FFT_SCONST(k.c4, FFT_C4, 0x3f3504f3);
    FFT_SCONST(k.s1, FFT_S1, 0x3e47c5c2); FFT_SCONST(k.s2, FFT_S2, 0x3ec3ef15); FFT_SCONST(k.s3, FFT_S3, 0x3f0e39da);
    return k;
}
FFT_HD inline cpx w32(int m, const W32C& k) {
#define FFT_CT(q) ((q) == 0 ? 1.f : (q) == 1 ? k.c1 : (q) == 2 ? k.c2 : (q) == 3 ? k.c3 : (q) == 4 ? k.c4 : (q) == 5 ? k.s3 : (q) == 6 ? k.s2 : (q) == 7 ? k.s1 : 0.f)
    cpx r; if (m <= 8) { r.x = FFT_CT(m); r.y = -FFT_CT(8 - m); } else { r.x = -FFT_CT(16 - m); r.y = -FFT_CT(m - 8); } return r;
}
template <int R, bool INV> FFT_HD inline void dft_regs(cpx (&v)[R]) {
    const W32C kc = w32_consts();
#pragma unroll
    for (int s = R / 2; s >= 1; s >>= 1) {
#pragma unroll
        for (int g = 0; g < R; g += 2 * s) {
#pragma unroll
            for (int k = 0; k < s; ++k) {
                const cpx a = v[g + k], b = v[g + k + s];
                cpx d; d.x = a.x - b.x; d.y = a.y - b.y;
                v[g + k].x = a.x + b.x; v[g + k].y = a.y + b.y;
                const int m = k * (16 / s);
                if (m == 0) v[g + k + s] = d;
                else if (m == 8) { cpx t; if (INV) { t.x = -d.y; t.y = d.x; } else { t.x = d.y; t.y = -d.x; } v[g + k + s] = t; }
                else { const cpx w = w32(m, kc); v[g + k + s] = INV ? cmulc(d, w) : cmul(d, w); }
            }
        }
    }
}
FFT_HD constexpr int brev(int i, int bits) { int r = 0; for (int b = 0; b < bits; ++b) r |= ((i >> b) & 1) << (bits - 1 - b); return r; }
FFT_HD inline cpx small_twiddle(float th) {
    const float t2 = th * th;
    cpx r;
    r.x = 1.f + t2 * (-0.5f + t2 * (4.1666666666666664e-2f + t2 * (-1.3888888888888889e-3f + t2 * 2.48015873015873e-5f)));
    r.y = -th * (1.f + t2 * (-1.6666666666666666e-1f + t2 * (8.3333333333333332e-3f + t2 * (-1.984126984126984e-4f))));
    return r;
}
template <int R, int BITS, bool BREV_IDX, bool INV> FFT_HD inline void apply_twiddles(cpx (&v)[R], cpx w1) {
    const cpx w2 = cmul(w1, w1), w3 = cmul(w2, w1), w4 = cmul(w2, w2);
    cpx cur[4]; cur[0].x = 1.f; cur[0].y = 0.f; cur[1] = w1; cur[2] = w2; cur[3] = w3;
#pragma unroll
    for (int q = 0; q < R; ++q) {
        const int idx = BREV_IDX ? brev(q, BITS) : q;
        if (q > 0) v[idx] = INV ? cmulc(v[idx], cur[q & 3]) : cmul(v[idx], cur[q & 3]);
        if (q + 4 < R) { cur[q & 3] = cmul(cur[q & 3], w4); FFT_ORDER(cur[q & 3], v[idx]); }
    }
}
template <bool ZERO_UPPER> FFT_HD inline void fft_f1(int tid, FFT_LDS cpx* lds) {
    FFT_LAUNDER(tid);
    cpx v[32];
    FFT_LDS cpx* b1 = lds + (tid + (tid >> 4));
#pragma unroll
    for (int j = 0; j < 32; ++j) { if (ZERO_UPPER && j >= 16) { v[j].x = 0.f; v[j].y = 0.f; } else v[j] = b1[560 * j]; }
    dft_regs<32, false>(v);
    apply_twiddles<32, 5, true, false>(v, small_twiddle(6.283185307179586f * (float)tid * (1.0f / 16384.0f)));
#pragma unroll
    for (int q = 0; q < 32; ++q) b1[560 * q] = v[brev(q, 5)];
}
FFT_HD inline void fft_f2(int tid, FFT_LDS cpx* lds) {
    FFT_LAUNDER(tid);
    const int q1 = tid >> 4, a = tid & 15; cpx v[32];
    FFT_LDS cpx* b2 = lds + (560 * q1 + a);
#pragma unroll
    for (int b = 0; b < 32; ++b) v[b] = b2[17 * b];
    dft_regs<32, false>(v);
    apply_twiddles<32, 5, true, false>(v, small_twiddle(6.283185307179586f * (float)a * (1.0f / 512.0f)));
#pragma unroll
    for (int q = 0; q < 32; ++q) b2[17 * q] = v[brev(q, 5)];
}
FFT_HD inline void fft_f3(int tid, FFT_LDS const cpx* lds, cpx (&out)[2][16]) {
    FFT_LAUNDER(tid);
#pragma unroll
    for (int h = 0; h < 2; ++h) { FFT_LDS const cpx* b3 = lds + (17 * tid + 16 * (tid >> 5) + 8960 * h); cpx v[16];
#pragma unroll
        for (int i = 0; i < 16; ++i) v[i] = b3[i];
        dft_regs<16, false>(v);
#pragma unroll
        for (int k = 0; k < 16; ++k) out[h][k] = v[brev(k, 4)]; }
}
FFT_HD inline void fft_i3(int tid, cpx (&in)[2][16], FFT_LDS cpx* lds) {
    FFT_LAUNDER(tid);
#pragma unroll
    for (int h = 0; h < 2; ++h) { FFT_LDS cpx* b3 = lds + (17 * tid + 16 * (tid >> 5) + 8960 * h); cpx v[16];
#pragma unroll
        for (int k = 0; k < 16; ++k) v[k] = in[h][k];
        dft_regs<16, true>(v);
#pragma unroll
        for (int i = 0; i < 16; ++i) b3[i] = v[brev(i, 4)]; }
}
FFT_HD inline void fft_i2(int tid, FFT_LDS cpx* lds) {
    FFT_LAUNDER(tid);
    const int q1 = tid >> 4, a = tid & 15; cpx v[32];
    FFT_LDS cpx* b2 = lds + (560 * q1 + a);
#pragma unroll
    for (int q = 0; q < 32; ++q) v[q] = b2[17 * q];
    apply_twiddles<32, 5, false, true>(v, small_twiddle(6.283185307179586f * (float)a * (1.0f / 512.0f)));
    dft_regs<32, true>(v);
#pragma unroll
    for (int b = 0; b < 32; ++b) b2[17 * b] = v[brev(b, 5)];
}
FFT_HD inline void fft_i1(int tid, FFT_LDS const cpx* lds, cpx (&v)[32]) {
    FFT_LAUNDER(tid);
    FFT_LDS const cpx* b1 = lds + (tid + (tid >> 4));
#pragma unroll
    for (int q = 0; q < 32; ++q) v[q] = b1[560 * q];
    apply_twiddles<32, 5, false, true>(v, small_twiddle(6.283185307179586f * (float)tid * (1.0f / 16384.0f)));
    dft_regs<32, true>(v);
}
FFT_HD inline void fft_i1_store(int tid, FFT_LDS cpx* lds) {
    cpx v[32]; fft_i1(tid, lds, v);
    FFT_LAUNDER(tid);
    FFT_LDS cpx* b1 = lds + (tid + (tid >> 4));
#pragma unroll
    for (int j = 0; j < 16; ++j) b1[560 * j] = v[brev(j, 5)];
}

typedef _Float16 h2_t __attribute__((ext_vector_type(2)));
#define OPAQUE_PTR(T, name, expr) T name; { unsigned lo_ = __builtin_amdgcn_readfirstlane((unsigned)(uintptr_t)(expr)), hi_ = __builtin_amdgcn_readfirstlane((unsigned)((uintptr_t)(expr) >> 32)); asm volatile("" : "+s"(lo_), "+s"(hi_)); name = (T)(((uintptr_t)hi_ << 32) | lo_); }
typedef const bf16_t __attribute__((address_space(1)))* gbf_cp;
__device__ __forceinline__ float conv3(gbf_cp u, int t, float w0, float w1, float w2, float bb) {
    const float um = bf2f(u[t > 0 ? -1 : 0]), u0 = bf2f(u[0]), up = bf2f(u[t < L - 1 ? 1 : 0]);
    return (t > 0 ? um : 0.f) * w0 + u0 * w1 + (t < L - 1 ? up : 0.f) * w2 + bb;
}
__device__ __forceinline__ float conv3l(const LAS bf16_t* u, int t, float w0, float w1, float w2, float bb) {
    const float um = bf2f(u[t > 0 ? -1 : 0]), u0 = bf2f(u[0]), up = bf2f(u[t < L - 1 ? 1 : 0]);
    return (t > 0 ? um : 0.f) * w0 + u0 * w1 + (t < L - 1 ? up : 0.f) * w2 + bb;
}
constexpr int FFT_RAW_OFF = 8960 * 8;
__device__ __forceinline__ void ph_fftconv(const int tid, const int bid, CP p, int layer, unsigned char* ws, LAS unsigned char* ldsraw) {
    LAS cpx* lds = (LAS cpx*)ldsraw;
    const float* w_sc_ = p.w_sc + (size_t)layer * 3 * C3; const float* b_sc_ = p.b_sc + (size_t)layer * C3; const float* hy_bias_ = p.hy_bias + layer * HYW;
    for (int c = bid; c < HYW; c += (int)gridDim.x) {
        OPAQUE_PTR(unsigned char*, wsl, ws)
        const _Float16* FILT = (const _Float16*)(wsl + WS_FILT); const bf16_t* UT = (const bf16_t*)(wsl + WS_UT); bf16_t* YT = (bf16_t*)(wsl + WS_YT);
        h2_t KF[2][16];
        { int tl = tid; asm volatile("" : "+v"(tl)); LAS cpx* b1 = lds + (tl + (tl >> 4));
          OPAQUE_PTR(const _Float16 __attribute__((address_space(1)))*, kf, FILT + (size_t)c * 16384) OPAQUE_PTR(const float*, hy_bias, hy_bias_)
          _Float16 tp[32];
#pragma unroll
          for (int j = 0; j < 32; ++j) { const int n = tl + 512 * j; tp[j] = kf[j < 16 ? n : (n == 8192 ? 8192 : 24576 - n)]; }
#pragma unroll
          for (int j = 0; j < 32; ++j) { const int n = tl + 512 * j; cpx t; t.y = 0.f; t.x = (float)tp[j]; if (n == 8192) t.x = 0.f; if (n == 0) t.x += hy_bias[c]; b1[560 * j] = t; } }
        asm volatile("" ::: "memory");
        fft_f1<false>(tid, lds); __syncthreads(); fft_f2(tid, lds); __syncthreads();
        { cpx W[2][16]; fft_f3(tid, lds, W);
#pragma unroll
          for (int h = 0; h < 2; ++h)
#pragma unroll
              for (int kq = 0; kq < 16; ++kq) { h2_t t; t.x = (_Float16)W[h][kq].x; t.y = (_Float16)W[h][kq].y; KF[h][kq] = t; } }
        { const int c1 = HYW + c, c2 = 2 * HYW + c; int tl = tid; asm volatile("" : "+v"(tl));
          OPAQUE_PTR(const u32x4 __attribute__((address_space(1)))*, r1, UT + (size_t)c1 * T) OPAQUE_PTR(const u32x4 __attribute__((address_space(1)))*, r2, UT + (size_t)c2 * T)
          u32x4 raw[8];
#pragma unroll
          for (int m = 0; m < 4; ++m) { raw[m] = r1[tl + 512 * m]; raw[4 + m] = r2[tl + 512 * m]; }
          __syncthreads();
          LAS u32x4* rw = (LAS u32x4*)(ldsraw + FFT_RAW_OFF) + tl;
#pragma unroll
          for (int m = 0; m < 8; ++m) rw[512 * m] = raw[m];
          __syncthreads();
          OPAQUE_PTR(const float*, w_sc, w_sc_) OPAQUE_PTR(const float*, b_sc, b_sc_)
          const float a0 = w_sc[c1], a1 = w_sc[C3 + c1], a2 = w_sc[2 * C3 + c1], ab = b_sc[c1], v0 = w_sc[c2], v1 = w_sc[C3 + c2], v2 = w_sc[2 * C3 + c2], vb = b_sc[c2];
          const LAS bf16_t* u1 = (const LAS bf16_t*)(ldsraw + FFT_RAW_OFF); const LAS bf16_t* u2 = u1 + 2 * L; LAS cpx* b1 = lds + (tl + (tl >> 4));
#pragma unroll 4
          for (int j = 0; j < 16; ++j) { const int t = tl + 512 * j; cpx z;
              z.x = conv3l(u1 + t, t, a0, a1, a2, ab) * conv3l(u2 + t, t, v0, v1, v2, vb);
              z.y = conv3l(u1 + L + t, t, a0, a1, a2, ab) * conv3l(u2 + L + t, t, v0, v1, v2, vb);
              b1[560 * j] = z; } }
        __syncthreads();
        fft_f1<true>(tid, lds); __syncthreads(); fft_f2(tid, lds); __syncthreads();
        { cpx W[2][16]; fft_f3(tid, lds, W);
#pragma unroll
          for (int h = 0; h < 2; ++h)
#pragma unroll
              for (int k = 0; k < 16; ++k) { cpx kf; kf.x = (float)KF[h][k].x; kf.y = (float)KF[h][k].y; W[h][k] = cmul(W[h][k], kf); }
          fft_i3(tid, W, lds); }
        __syncthreads(); fft_i2(tid, lds); __syncthreads();
        { int tl = tid; asm volatile("" : "+v"(tl));
          OPAQUE_PTR(const u32x4 __attribute__((address_space(1)))*, r0, UT + (size_t)c * T)
          u32x4 raw[4];
#pragma unroll
          for (int m = 0; m < 4; ++m) raw[m] = r0[tl + 512 * m];
          fft_i1_store(tid, lds);
          __syncthreads();
          LAS u32x4* rw = (LAS u32x4*)(ldsraw + FFT_RAW_OFF) + tl;
#pragma unroll
          for (int m = 0; m < 4; ++m) rw[512 * m] = raw[m];
          __syncthreads();
          OPAQUE_PTR(const float*, w_sc, w_sc_) OPAQUE_PTR(const float*, b_sc, b_sc_) const float x0w = w_sc[c], x1w = w_sc[C3 + c], x2w = w_sc[2 * C3 + c], xb = b_sc[c];
          OPAQUE_PTR(bf16_t __attribute__((address_space(1)))*, yo, YT + (size_t)c * T)
          const LAS bf16_t* u0 = (const LAS bf16_t*)(ldsraw + FFT_RAW_OFF); LAS const cpx* b1 = lds + (tl + (tl >> 4));
#pragma unroll 4
          for (int j = 0; j < 16; ++j) { const int t = tl + 512 * j; const cpx u = b1[560 * j];
              yo[t] = f2bf(u.x * (1.0f / 16384.0f) * conv3l(u0 + t, t, x0w, x1w, x2w, xb));
              yo[L + t] = f2bf(u.y * (1.0f / 16384.0f) * conv3l(u0 + L + t, t, x0w, x1w, x2w, xb)); } }
        __syncthreads();
    }
}

#define XB_TMO      128
#define XB_XCNT(j)  (256  + 64 * (j))
#define XB_XSUB(j)  (1280 + 64 * (j))
#define XB_XGEN(j)  (2304 + 64 * (j))
#define XB_TOP      3328
#define XB_TOPGEN   3392
#define XCD_BAR_WORDS 3456
#define XB_SPIN_CAP (1u << 18)

__device__ __forceinline__ unsigned xb_ld(unsigned* p)              { return __hip_atomic_load(p, __ATOMIC_RELAXED, __HIP_MEMORY_SCOPE_AGENT); }
__device__ __forceinline__ unsigned xb_add(unsigned* p, unsigned v) { return __hip_atomic_fetch_add(p, v, __ATOMIC_RELAXED, __HIP_MEMORY_SCOPE_AGENT); }
__device__ __forceinline__ unsigned xb_xcc_id() { return (unsigned)__builtin_amdgcn_s_getreg((3 << 11) | 20) & 0xFu; }
#define XB_SPIN(cond, bar) do { unsigned _sp = 0; while (cond) { __builtin_amdgcn_s_sleep(1); \
    if ((++_sp & 255u) == 0u) { if (xb_ld(&(bar)[XB_TMO])) break; if (_sp > XB_SPIN_CAP) { atomicAdd(&(bar)[XB_TMO], 1u); break; } } } } while (0)

struct XcdBarrier {
    unsigned* bar; unsigned x;
    volatile LAS unsigned* st;
};

__device__ __forceinline__ XcdBarrier xcd_barrier_post(unsigned* bar, volatile LAS unsigned* st) {
    XcdBarrier b; b.bar = bar; b.x = xb_xcc_id(); b.st = st;
    if (threadIdx.x == 0) (void)xb_add(&bar[XB_XCNT(b.x)], 1u);
    return b;
}
__device__ __forceinline__ void xcd_barrier_complete(unsigned* bar, unsigned x, unsigned& nloc, unsigned& nx) {
    const unsigned G = gridDim.x * gridDim.y * gridDim.z;
    unsigned sum, cnt, mine, sp = 0u;
    for (;;) {
        sum = 0u; cnt = 0u; mine = 0u;
#pragma unroll
        for (unsigned j = 0; j < 16; ++j) { const unsigned c = xb_ld(&bar[XB_XCNT(j)]); sum += c; cnt += (c > 0u) ? 1u : 0u; mine = (j == x) ? c : mine; }
        if (sum == G) break;
        __builtin_amdgcn_s_sleep(1);
        if ((++sp & 255u) == 0u) { if (xb_ld(&bar[XB_TMO])) break; if (sp > XB_SPIN_CAP) { atomicAdd(&bar[XB_TMO], 1u); break; } }
    }
    nloc = mine > 0u ? mine : 1u; nx = cnt > 0u ? cnt : 1u;
}

__device__ __forceinline__ void xcd_barrier(const XcdBarrier& b) {
    asm volatile("s_waitcnt vmcnt(0)" ::: "memory");
    __syncthreads();
    if (threadIdx.x == 0) {
        unsigned* bar = b.bar;
        __builtin_amdgcn_s_waitcnt(0);
        unsigned nloc = b.st[0], nx = b.st[1];
        if (nloc == 0u) { xcd_barrier_complete(bar, b.x, nloc, nx); b.st[0] = nloc; b.st[1] = nx; }
        const unsigned old = xb_add(&bar[XB_XSUB(b.x)], 1u);
        const unsigned gen = old / nloc;
        if (old + 1u == (gen + 1u) * nloc) {
            __builtin_amdgcn_fence(__ATOMIC_RELEASE, "agent");
            asm volatile("s_waitcnt vmcnt(0)" ::: "memory");
            const unsigned og = xb_add(&bar[XB_TOP], 1u);
            const unsigned tg = og / nx;
            if (og + 1u == (tg + 1u) * nx) xb_add(&bar[XB_TOPGEN], 1u);
            else XB_SPIN(xb_ld(&bar[XB_TOPGEN]) == tg, bar);
            __builtin_amdgcn_fence(__ATOMIC_ACQUIRE, "agent");
            xb_add(&bar[XB_XGEN(b.x)], 1u);
            asm volatile("s_waitcnt vmcnt(0)" ::: "memory");
        } else {
            XB_SPIN(xb_ld(&bar[XB_XGEN(b.x)]) == gen, bar);
            __builtin_amdgcn_fence(__ATOMIC_ACQUIRE, "agent");
            asm volatile("s_waitcnt vmcnt(0)" ::: "memory");
        }
    }
    __syncthreads();
}

__device__ __forceinline__ void ph_ycat(const int tid, const int bid, unsigned char* ws, LAS unsigned char* lds) {
    const bf16_t* YT = (const bf16_t*)(ws + WS_YT); const bf16_t* OG = (const bf16_t*)(ws + WS_OG); const float* LSE = (const float*)(ws + WS_LSE); bf16_t* YCAT = (bf16_t*)(ws + WS_YCAT);
    const int lane = tid & 63, wave = tid >> 6;
    LAS bf16_t* tile = (LAS bf16_t*)(lds + wave * 8704);
    for (int it = bid * 8 + wave; it < 12 * 256; it += (int)gridDim.x * 8) {
        const int ch0 = (it % 12) * 64, tt0 = (it / 12) * 64;
#pragma unroll
        for (int i = 0; i < 8; ++i) { const int row = i * 8 + (lane >> 3), ck = lane & 7;
            const u32x4 v = *(const u32x4*)(YT + (size_t)(ch0 + row) * T + tt0 + ck * 8);
            LAS u32x2* d = (LAS u32x2*)(tile + row * 68 + ck * 8); u32x2 a; a.x = v.x; a.y = v.y; u32x2 b; b.x = v.z; b.y = v.w; d[0] = a; d[1] = b; }
        asm volatile("s_waitcnt lgkmcnt(0)" ::: "memory");
#pragma unroll
        for (int i = 0; i < 8; ++i) { const int tok = i * 8 + (lane >> 3), cc = lane & 7; unsigned short e[8];
#pragma unroll
            for (int q = 0; q < 8; ++q) e[q] = tile[(cc * 8 + q) * 68 + tok];
            u32x4 o; o.x = e[0] | ((unsigned)e[1] << 16); o.y = e[2] | ((unsigned)e[3] << 16); o.z = e[4] | ((unsigned)e[5] << 16); o.w = e[6] | ((unsigned)e[7] << 16);
            *(u32x4*)(YCAT + (size_t)(tt0 + tok) * D + ch0 + cc * 8) = o; }
        asm volatile("s_waitcnt lgkmcnt(0)" ::: "memory");
    }
    for (int idx = bid * 512 + tid; idx < T * 32; idx += (int)gridDim.x * 512) {
        const int tt = idx >> 5, cc0 = (idx & 31) * 8, hh = cc0 >> 6;
        const float l0 = LSE[((size_t)0 * T + tt) * 4 + hh], l1 = LSE[((size_t)1 * T + tt) * 4 + hh], l2 = LSE[((size_t)2 * T + tt) * 4 + hh];
        const float mx = fmaxf(l0, fmaxf(l1, l2)); float e0 = exp2f(l0 - mx), e1 = exp2f(l1 - mx), e2 = exp2f(l2 - mx); const float inv = 1.f / (e0 + e1 + e2); e0 *= inv; e1 *= inv; e2 *= inv;
        const u32x4 a = *(const u32x4*)(OG + ((size_t)0 * T + tt) * 256 + cc0), b = *(const u32x4*)(OG + ((size_t)1 * T + tt) * 256 + cc0), c = *(const u32x4*)(OG + ((size_t)2 * T + tt) * 256 + cc0);
        u32x4 o;
#pragma unroll
        for (int q = 0; q < 4; ++q) o[q] = pg8::cvt_pk_bf16(e0 * bflo(a[q]) + e1 * bflo(b[q]) + e2 * bflo(c[q]), e0 * bfhi(a[q]) + e1 * bfhi(b[q]) + e2 * bfhi(c[q]));
        *(u32x4*)(YCAT + (size_t)tt * D + 768 + cc0) = o;
    }
}
__device__ __forceinline__ void ph_mod(const int tid, const int bid, CP p, float* mod, LAS unsigned char* lds) {
    const int lane = tid & 63, wave = tid >> 6; LAS float* red = (LAS float*)lds;
    for (int task = bid; task < DEPTH * 96; task += (int)gridDim.x) {
        const int l = task / 96, n0 = (task % 96) * 64;
        const float* w = p.w_ada + ((size_t)l * 1024 + wave * 128) * 6144 + n0 + lane; const float* c0 = p.c + wave * 128; const float* c1 = p.c + 1024 + wave * 128;
        float a0 = 0.f, a1 = 0.f;
#pragma unroll 16
        for (int kq = 0; kq < 128; ++kq) { const float wv = w[(size_t)kq * 6144]; a0 += siluf_(c0[kq]) * wv; a1 += siluf_(c1[kq]) * wv; }
        __syncthreads();
        red[(wave * 2 + 0) * 64 + lane] = a0; red[(wave * 2 + 1) * 64 + lane] = a1;
        __syncthreads();
        if (tid < 128) { const int b = tid >> 6, n = tid & 63; float s = p.b_ada[l * 6144 + n0 + n];
#pragma unroll
            for (int wv = 0; wv < 8; ++wv) s += red[(wv * 2 + b) * 64 + n];
            mod[((size_t)l * NB + b) * 6144 + n0 + n] = s; }
    }
    __syncthreads();
}

namespace cg = cooperative_groups;
constexpr int NPHASE = 1 + 9 * DEPTH + 1;
#ifndef REPEAT_PH
#define REPEAT_PH (-1)
#endif
#ifndef PROBE_PH
#define PROBE_PH (-1)
#endif
#ifndef PROBE_DIV
#define PROBE_DIV 10.0f
#endif
constexpr int MEGA_LDS = 147456;
constexpr int XB_ST_OFF = MEGA_LDS - 64;
__global__ void __launch_bounds__(512, 2) mega(P p_unused) {
    extern __shared__ __attribute__((aligned(16))) unsigned char lds[];
    typedef const __attribute__((address_space(4))) P* KP;
    KP kp0 = (KP)__builtin_amdgcn_kernarg_segment_ptr();
    cg::grid_group grid = cg::this_grid();
    const int ph_lo = kp0->ph_lo, ph_hi = kp0->ph_hi;
    const int wave0 = __builtin_amdgcn_readfirstlane((int)(threadIdx.x >> 6));
    { volatile LAS unsigned* st0 = (volatile LAS unsigned*)((LAS unsigned char*)lds + XB_ST_OFF); if (threadIdx.x < 16) st0[threadIdx.x] = 0u; }
    __syncthreads();
    const XcdBarrier xbar = xcd_barrier_post((unsigned*)(kp0->ws + WS_CTL) + 4096, (volatile LAS unsigned*)((LAS unsigned char*)lds + XB_ST_OFF));
#define PHASE_VARS const __attribute__((address_space(4))) P& p = *pp; unsigned char* ws = p.ws; float* out = p.out; float* MOD = (float*)(ws + WS_MOD); float* ROPE = (float*)(ws + WS_ROPE); _Float16* H3 = (_Float16*)(ws + WS_H3); _Float16* W4T = (_Float16*)(ws + WS_W4T); int* SEL = (int*)(ws + WS_SEL); float* WTS = (float*)(ws + WS_WTS); int* POS = (int*)(ws + WS_POS); _Float16* FILT = (_Float16*)(ws + WS_FILT); bf16_t* XN = (bf16_t*)(ws + WS_XN); bf16_t* UT = (bf16_t*)(ws + WS_UT); bf16_t* QS = (bf16_t*)(ws + WS_QS); bf16_t* KS = (bf16_t*)(ws + WS_KS); bf16_t* VT = (bf16_t*)(ws + WS_VT); bf16_t* GATES = (bf16_t*)(ws + WS_GATES); bf16_t* YT = (bf16_t*)(ws + WS_YT); bf16_t* OG = (bf16_t*)(ws + WS_OG); float* LSE = (float*)(ws + WS_LSE); bf16_t* YCAT = (bf16_t*)(ws + WS_YCAT); bf16_t* MERGED = (bf16_t*)(ws + WS_MERGED); float* Z = (float*)(ws + WS_Z); bf16_t* X0 = (bf16_t*)(ws + WS_X0); bf16_t* ACT = (bf16_t*)(ws + WS_ACT); bf16_t* YB = (bf16_t*)(ws + WS_YB); unsigned char* sm = lds + (tid >> 8) * 8192; LAS unsigned char* ldsp = (LAS unsigned char*)lds; bf16_t* WA = (bf16_t*)(ws + WS_WA); bf16_t* WB = (bf16_t*)(ws + WS_WB); bf16_t* WCAT = (bf16_t*)(ws + WS_WCAT); bf16_t* WOUT = (bf16_t*)(ws + WS_WOUT);
    int ph = 0;
#define PHASE(...) do { if (PROBE_PH >= 0 && ph == PROBE_PH) { if (wave0 == 0) ((volatile LAS unsigned long long*)((LAS unsigned char*)lds + XB_ST_OFF + 16))[0] = __builtin_amdgcn_s_memrealtime(); } if (ph >= ph_lo && ph < ph_hi) { int tid, bid = blockIdx.x; KP pp = kp0; asm volatile("v_mbcnt_lo_u32_b32 %0, -1, 0\n\tv_mbcnt_hi_u32_b32 %0, -1, %0" : "=v"(tid)); tid += wave0 * 64; asm volatile("" : "+v"(tid), "+s"(bid), "+s"(pp)); PHASE_VARS; __VA_ARGS__; if (ph == REPEAT_PH) { xcd_barrier(xbar); __VA_ARGS__; } if (ph + 1 < ph_hi) { if (ph_hi < 0) grid.sync(); else xcd_barrier(xbar); } } if (PROBE_PH >= 0 && ph == PROBE_PH) { if (wave0 == 0) ((volatile LAS unsigned long long*)((LAS unsigned char*)lds + XB_ST_OFF + 16))[1] = __builtin_amdgcn_s_memrealtime(); } ++ph; } while (0)
    PHASE({ ph_mod(tid, bid, p, MOD, ldsp); nv_rope(tid, bid, p, ROPE); nv_h3(tid, bid, p, H3, sm); ph_w4t(tid, bid, p, W4T); __syncthreads(); ph_convert(tid, bid * 8 + (tid >> 6), (int)gridDim.x * 8, p, 0, ws, ldsp, 0, 13670);
            if (bid >= 192) ph_convert(tid, (bid - 192) * 8 + (tid >> 6), ((int)gridDim.x - 192) * 8, p, 0, ws, ldsp, 13670, 16640); });
    for (int l = 0; l < DEPTH; ++l) {
#define mod_l (MOD + (size_t)l * NB * 6144)
        PHASE({ if (l > 0) ph_convert(tid, bid * 8 + (tid >> 6), (int)gridDim.x * 8, p, l, ws, ldsp, 12544, 16640);
                if (l == 0) ph_norm<false, false>(tid, bid, p.x, out, p.norm1_g, mod_l, XN, YB, POS, WTS, mod_l);
                else ph_norm<true, false>(tid, bid, out, out, p.norm1_g + l * D, mod_l, XN, YB, POS, WTS, mod_l - NB * 6144); });
        PHASE({ { SchedG1a S{(const char*)XN, (const char*)WA, (int)gridDim.x, bid}; EpiG1a E{ws};
                  pg8::gemm_phase<EpiG1a, SchedG1a, true, true>(tid, ldsp, 1024, S, E); }
                asm volatile("v_mbcnt_lo_u32_b32 %0, -1, 0\n\tv_mbcnt_hi_u32_b32 %0, -1, %0" : "=v"(tid)); tid += wave0 * 64;
                { SchedG1b S{(const char*)XN, (const char*)WB, (int)gridDim.x, bid}; EpiG1b E{ws};
                  pg8::gemm_phase<EpiG1b, SchedG1b, true, true, false, false, true>(tid, ldsp, 1024, S, E); }
                asm volatile("v_mbcnt_lo_u32_b32 %0, -1, 0\n\tv_mbcnt_hi_u32_b32 %0, -1, %0" : "=v"(tid)); tid += wave0 * 64;
                { SchedTaps S{(const char*)(W4T + (size_t)l * 1536 * 256), (const char*)(H3 + (size_t)l * L * 256), (int)gridDim.x, bid}; EpiTaps E{ws};
                  pg8::gemm_phase<EpiTaps, SchedTaps, true, true, false, true>(tid, ldsp, 256, S, E); } });
        PHASE({ ph_fftconv(tid, bid, p, l, ws, ldsp); ph_attn(tid, bid, ws); });
        PHASE({ ph_ycat(tid, bid, ws, ldsp); });
        PHASE({ SchedDense S{(const char*)YCAT, (const char*)WCAT, 64, 4, (int)gridDim.x, bid, 524288}; EpiMerge E{ws};
                pg8::gemm_phase<EpiMerge, SchedDense, true, true>(tid, ldsp, 1024, S, E); });
        PHASE({ SchedDense S{(const char*)MERGED, (const char*)WOUT, 64, 4, (int)gridDim.x, bid, 524288}; EpiOut E{out, ws, l};
                pg8::gemm_phase<EpiOut, SchedDense, true, true>(tid, ldsp, 1024, S, E); });
        PHASE({ ph_route(tid, bid, p, l, ws, out, ldsp); });
        PHASE({ ph_moe_prep(tid, bid, ws, l);
                SchedMoe S{(const int*)(ws + WS_CTL + CTL_CNT) + l * 1024, (const char*)XN, (const char*)(ws + WS_W13), (const int*)(ws + WS_LIST), (size_t)1024 * 1024 * 2, 0, (size_t)256 * 1024 * 2, 1, (int)gridDim.x, bid}; EpiMoeUp E{ws};
                pg8::gemm_phase<EpiMoeUp, SchedMoe, true, true, true>(tid, ldsp, 1024, S, E);
                if (l + 1 < DEPTH) { asm volatile("v_mbcnt_lo_u32_b32 %0, -1, 0\n\tv_mbcnt_hi_u32_b32 %0, -1, %0" : "=v"(tid)); tid += wave0 * 64; __syncthreads();
                    const int busy = moe_busy_blocks(ws, l, (int)gridDim.x); if (bid >= busy) ph_convert(tid, (bid - busy) * 8 + (tid >> 6), ((int)gridDim.x - busy) * 8, p, l + 1, ws, ldsp, 0, 4352); } });
        PHASE({ SchedMoe S{(const int*)(ws + WS_CTL + CTL_CNT) + l * 1024, (const char*)ACT, (const char*)(ws + WS_W2), nullptr, (size_t)1024 * 512 * 2, (size_t)256 * 512 * 2, (size_t)256 * 512 * 2, 0, (int)gridDim.x, bid}; EpiMoeDown E{ws};
                pg8::gemm_phase<EpiMoeDown, SchedMoe, true, true, false>(tid, ldsp, 512, S, E);
                if (l + 1 < DEPTH) { asm volatile("v_mbcnt_lo_u32_b32 %0, -1, 0\n\tv_mbcnt_hi_u32_b32 %0, -1, %0" : "=v"(tid)); tid += wave0 * 64; __syncthreads();
                    const int busy = moe_busy_blocks(ws, l, (int)gridDim.x); if (bid >= busy) ph_convert(tid, (bid - busy) * 8 + (tid >> 6), ((int)gridDim.x - busy) * 8, p, l + 1, ws, ldsp, 4352, 12544); } });
    }
    PHASE({ ph_norm<true, true>(tid, bid, out, out, p.final_g, MOD, nullptr, YB, POS, WTS, MOD + (size_t)(DEPTH - 1) * NB * 6144); });
    if (PROBE_PH >= 0) { xcd_barrier(xbar); if (blockIdx.x == 0 && wave0 == 0 && __builtin_amdgcn_mbcnt_lo(~0u, 0u) == 0u) { volatile LAS unsigned long long* pt = (volatile LAS unsigned long long*)((LAS unsigned char*)lds + XB_ST_OFF + 16); kp0->out[0] += (float)(pt[1] - pt[0]) * (0.01f / PROBE_DIV); } }
}
}

extern "C" void kernel_launch(void* const* d_in, const int* in_sizes, int n_in, void* d_out, int out_size, void* d_ws, size_t ws_size, hipStream_t stream) {
    if (n_in != 27 || in_sizes[0] != T * D || out_size != T * D || ws_size < WS_END) {
        fprintf(stderr, "kernel_launch: unexpected shapes / workspace (n_in %d, in0 %d, out %d, ws %zu need %zu); nothing launched\n", n_in, n_in > 0 ? in_sizes[0] : -1, out_size, ws_size, (size_t)WS_END);
        return;
    }
    static int grid_blocks = 0;
    if (!grid_blocks) {
        int dev = 0, cus = 0, per_cu = 0;
        (void)hipGetDevice(&dev); (void)hipDeviceGetAttribute(&cus, hipDeviceAttributeMultiprocessorCount, dev);
        (void)hipFuncSetAttribute((const void*)mega, hipFuncAttributeMaxDynamicSharedMemorySize, MEGA_LDS);
        if (hipOccupancyMaxActiveBlocksPerMultiprocessor(&per_cu, (const void*)mega, 512, MEGA_LDS) != hipSuccess || per_cu < 1) per_cu = 1;
        grid_blocks = cus;
        fprintf(stderr, "kernel_launch: %d CUs x %d blocks\n", cus, per_cu);
    }
    P p{};
    const float** dst = (const float**)&p;
    for (int i = 0; i < 27; ++i) dst[i] = (const float*)d_in[i];
    p.out = (float*)d_out; p.ws = (unsigned char*)d_ws;
    for (int j = 0; j < 32; ++j) p.ri.inv[j] = pow(10000.0, -(double)j / 32.0);
    p.ph_lo = 0; p.ph_hi = NPHASE;
    (void)hipMemsetAsync((unsigned char*)d_ws + WS_CTL, 0, 1 * MiB, stream);
    void* args[] = {&p};
    hipError_t e = hipLaunchCooperativeKernel((const void*)mega, dim3(grid_blocks), dim3(512), args, MEGA_LDS, stream);
    if (e != hipSuccess) fprintf(stderr, "cooperative launch failed: %s (grid %d)\n", hipGetErrorString(e), grid_blocks);
}
```
